# Optimizing an MI355X kernel written in HIP

```python
import math
import jax, jax.numpy as jnp
from jax import lax
import numpy as np

D_MODEL = 1024
BATCH = 2
SEQ = 8192
DEPTH = 1

CHUNK = 64
Q_BLOCK = 128
N_MEM = 256
ROPE_THETA = 10000.0
EPS = 1e-5

DA_HEADS = 4
DA_HEAD_DIM = 64
DA_V_DIM = 2 * DA_HEAD_DIM
DA_WIDTH = DA_HEADS * DA_V_DIM

CONV_CH = 256
CONV_WIDTH = 31

MEM_HEADS = 4
MEM_HEAD_DIM = 64
MEM_WIDTH = MEM_HEADS * MEM_HEAD_DIM

MIX_WIDTH = DA_WIDTH + CONV_CH + MEM_WIDTH
IN_Q = DA_HEADS * 2 * DA_HEAD_DIM
IN_K = DA_HEADS * 2 * DA_HEAD_DIM
IN_V = DA_WIDTH
IN_CONV = 2 * CONV_CH
IN_MEMQ = MEM_WIDTH
IN_WIDTH = IN_Q + IN_K + IN_V + IN_CONV + IN_MEMQ

D_FF = 2816

kernel_name = "hybrid_diffattn_conformer_conv_memxattn_macaron"


def rmsnorm(x, g):
    xf = x.astype(jnp.float32)
    y = xf * lax.rsqrt(jnp.mean(xf * xf, axis=-1, keepdims=True) + EPS)
    return (y * g.astype(jnp.float32)).astype(x.dtype)


def layernorm(x, g, b):
    xf = x.astype(jnp.float32)
    mu = jnp.mean(xf, axis=-1, keepdims=True)
    var = jnp.mean(jnp.square(xf - mu), axis=-1, keepdims=True)
    y = (xf - mu) * lax.rsqrt(var + EPS)
    return (y * g.astype(jnp.float32) + b.astype(jnp.float32)).astype(x.dtype)


def swiglu(x, w_gate, w_up, w_down):
    return (jax.nn.silu(x @ w_gate) * (x @ w_up)) @ w_down


def rope_tables(seq, dim):
    inv_freq = 1.0 / (ROPE_THETA ** (jnp.arange(0, dim, 2, dtype=jnp.float32) / dim))
    ang = jnp.arange(seq, dtype=jnp.float32)[:, None] * inv_freq[None, :]
    return jnp.cos(ang), jnp.sin(ang)


def apply_rope(x, cos, sin):
    c = cos[None, :, None, None, :].astype(x.dtype)
    s = sin[None, :, None, None, :].astype(x.dtype)
    x1, x2 = jnp.split(x, 2, axis=-1)
    return jnp.concatenate([x1 * c - x2 * s, x2 * c + x1 * s], axis=-1)


def differential_attention(q, k, v, lam, subln_g, lam_init):
    b, s, h, _, d = q.shape
    nb = s // Q_BLOCK
    scale = d ** -0.5
    kf = k.astype(jnp.float32)
    vf = v.astype(jnp.float32)
    key_chunk = jnp.arange(s) // CHUNK
    qb = q.reshape(b, nb, Q_BLOCK, h, 2, d).transpose(1, 0, 2, 3, 4, 5)

    def block(args):
        q_blk, bi = args
        q_chunk = (bi * Q_BLOCK + jnp.arange(Q_BLOCK)) // CHUNK
        mask = key_chunk[None, :] <= q_chunk[:, None]
        sc = jnp.einsum('bqhcd,bkhcd->bhcqk', q_blk.astype(jnp.float32), kf) * scale
        sc = jnp.where(mask[None, None, None], sc, -jnp.inf)
        p = jax.nn.softmax(sc, axis=-1)
        a = p[:, :, 0] - lam * p[:, :, 1]
        return jnp.einsum('bhqk,bkhe->bqhe', a, vf)

    o = lax.map(block, (qb, jnp.arange(nb)))
    o = o.transpose(1, 0, 2, 3, 4).reshape(b, s, h, 2 * d)
    o = o * lax.rsqrt(jnp.mean(o * o, axis=-1, keepdims=True) + EPS)
    o = o * subln_g.astype(jnp.float32) * (1.0 - lam_init)
    return o.reshape(b, s, h * 2 * d).astype(q.dtype)


def conformer_conv(u, dw_w, dw_b, ln_g, ln_b):
    a, gate = jnp.split(u, 2, axis=-1)
    g = a * jax.nn.sigmoid(gate)
    c = g.shape[-1]
    y = lax.conv_general_dilated(
        g, dw_w[:, None, :].astype(g.dtype), window_strides=(1,),
        padding=[(CONV_WIDTH - 1, 0)], dimension_numbers=('NWC', 'WIO', 'NWC'),
        feature_group_count=c)
    y = y + dw_b
    y = layernorm(y, ln_g, ln_b)
    return jax.nn.silu(y)


def memory_cross_attention(q, mem_n, w_mem_kv):
    b, s, _ = q.shape
    kv = mem_n @ w_mem_kv
    mk, mv = jnp.split(kv, 2, axis=-1)
    qh = q.reshape(b, s, MEM_HEADS, MEM_HEAD_DIM).astype(jnp.float32)
    mk = mk.reshape(b, -1, MEM_HEADS, MEM_HEAD_DIM).astype(jnp.float32)
    mv = mv.reshape(b, -1, MEM_HEADS, MEM_HEAD_DIM).astype(jnp.float32)
    sc = jnp.einsum('bshd,bmhd->bhsm', qh, mk) * (MEM_HEAD_DIM ** -0.5)
    p = jax.nn.softmax(sc, axis=-1)
    o = jnp.einsum('bhsm,bmhd->bshd', p, mv)
    return o.reshape(b, s, MEM_WIDTH).astype(q.dtype)


def setup_inputs(seed: int = 0) -> dict:
    key = jax.random.key(seed)
    ks = jax.random.split(key, 32)
    L, D, F = DEPTH, D_MODEL, D_FF
    f32 = jnp.float32

    def nrm(k, shape, fan_in):
        return jax.random.normal(k, shape, f32) * (fan_in ** -0.5)

    def gain(k, shape):
        return 1.0 + 0.02 * jax.random.normal(k, shape, f32)

    def small(k, shape, s=0.02):
        return s * jax.random.normal(k, shape, f32)

    return {
        "x": jax.random.normal(ks[0], (BATCH, SEQ, D), f32),
        "mem": jax.random.normal(ks[1], (BATCH, N_MEM, D), f32),
        "ffn1_norm_g": gain(ks[2], (L, D)),
        "ffn1_w_gate": nrm(ks[3], (L, D, F), D),
        "ffn1_w_up": nrm(ks[4], (L, D, F), D),
        "ffn1_w_down": nrm(ks[5], (L, F, D), F),
        "mix_norm_g": gain(ks[6], (L, D)),
        "mem_norm_g": gain(ks[7], (L, D)),
        "w_in": nrm(ks[8], (L, D, IN_WIDTH), D),
        "lambda_q1": 0.1 * jax.random.normal(ks[9], (L, DA_HEAD_DIM), f32),
        "lambda_k1": 0.1 * jax.random.normal(ks[10], (L, DA_HEAD_DIM), f32),
        "lambda_q2": 0.1 * jax.random.normal(ks[11], (L, DA_HEAD_DIM), f32),
        "lambda_k2": 0.1 * jax.random.normal(ks[12], (L, DA_HEAD_DIM), f32),
        "subln_g": gain(ks[13], (L, DA_V_DIM)),
        "conv_dw_w": nrm(ks[14], (L, CONV_WIDTH, CONV_CH), CONV_WIDTH),
        "conv_dw_b": small(ks[15], (L, CONV_CH)),
        "conv_ln_g": gain(ks[16], (L, CONV_CH)),
        "conv_ln_b": small(ks[17], (L, CONV_CH)),
        "w_mem_kv": nrm(ks[18], (L, D, 2 * MEM_WIDTH), D),
        "w_out": nrm(ks[19], (L, MIX_WIDTH, D), MIX_WIDTH),
        "ffn2_norm_g": gain(ks[20], (L, D)),
        "ffn2_w_gate": nrm(ks[21], (L, D, F), D),
        "ffn2_w_up": nrm(ks[22], (L, D, F), D),
        "ffn2_w_down": nrm(ks[23], (L, F, D), F),
        "final_norm_g": gain(ks[24], (D,)),
    }


def reference(x, mem, ffn1_norm_g, ffn1_w_gate, ffn1_w_up, ffn1_w_down,
              mix_norm_g, mem_norm_g, w_in, lambda_q1, lambda_k1, lambda_q2, lambda_k2,
              subln_g, conv_dw_w, conv_dw_b, conv_ln_g, conv_ln_b, w_mem_kv, w_out,
              ffn2_norm_g, ffn2_w_gate, ffn2_w_up, ffn2_w_down, final_norm_g):
    b, s, _ = x.shape
    cos, sin = rope_tables(s, DA_HEAD_DIM)
    split_idx = np.cumsum([IN_Q, IN_K, IN_V, IN_CONV]).tolist()
    h = x
    for l in range(DEPTH):
        h = h + 0.5 * swiglu(rmsnorm(h, ffn1_norm_g[l]), ffn1_w_gate[l], ffn1_w_up[l], ffn1_w_down[l])

        n = rmsnorm(h, mix_norm_g[l])
        proj = n @ w_in[l]
        q, k, v, u_conv, q_mem = jnp.split(proj, split_idx, axis=-1)

        q = apply_rope(q.reshape(b, s, DA_HEADS, 2, DA_HEAD_DIM), cos, sin)
        k = apply_rope(k.reshape(b, s, DA_HEADS, 2, DA_HEAD_DIM), cos, sin)
        v = v.reshape(b, s, DA_HEADS, DA_V_DIM)
        lam_init = 0.8 - 0.6 * math.exp(-0.3 * l)
        lam = (jnp.exp(jnp.sum(lambda_q1[l] * lambda_k1[l]).astype(jnp.float32))
               - jnp.exp(jnp.sum(lambda_q2[l] * lambda_k2[l]).astype(jnp.float32)) + lam_init)
        o_da = differential_attention(q, k, v, lam, subln_g[l], lam_init)

        o_conv = conformer_conv(u_conv, conv_dw_w[l], conv_dw_b[l], conv_ln_g[l], conv_ln_b[l])

        o_mem = memory_cross_attention(q_mem, rmsnorm(mem, mem_norm_g[l]), w_mem_kv[l])

        mixed = jnp.concatenate([o_da, o_conv.astype(o_da.dtype), o_mem], axis=-1)
        h = h + mixed @ w_out[l]

        h = h + 0.5 * swiglu(rmsnorm(h, ffn2_norm_g[l]), ffn2_w_gate[l], ffn2_w_up[l], ffn2_w_down[l])
    return rmsnorm(h, final_norm_g)
```

```cpp
#include <hip/hip_runtime.h>
#include <hip/hip_cooperative_groups.h>
#include <cstdio>
#include <cstdint>
namespace cg = cooperative_groups;
namespace pg8 {
#define PG8_LAS __attribute__((address_space(3)))
typedef unsigned short bf16_t;
typedef short bf16x8 __attribute__((ext_vector_type(8)));
typedef float f32x4 __attribute__((ext_vector_type(4)));
typedef unsigned u32x4 __attribute__((ext_vector_type(4)));
constexpr int BM = 256, BK = 64, HALF = 128, HTB = HALF * BK * 2  , STAGE_BYTES = 8 * HTB, NXCD = 8, WGM = 8;

__host__ __device__ __forceinline__ int lds_byte(int r, int c) { const int st = (r >> 4) * 2 + (c >> 5), rr = r & 15, cc = c & 31, ob = rr * 64 + cc * 2; return st * 1024 + (ob ^ (((ob >> 9) & 1) << 5)); }
__host__ __device__ __forceinline__ void stage_rc(int b, int& R, int& C) { const int st = b / 1024, sb = b % 1024, swz = sb ^ (((sb >> 9) & 1) << 5); R = (st >> 1) * 16 + swz / 64; C = (st & 1) * 32 + (swz % 64) / 2; }
__host__ __device__ __forceinline__ int perm32(int rho) { const int n = rho >> 4, i = rho & 15; return 8 * (i >> 2) + 4 * n + (i & 3); }

struct Unit { int pm, pn; };
struct Gemm { const bf16_t* A; const bf16_t* Bt; int M, N, K; };

struct StaticOrder {
    int nM, nN, nwg, G, c;
    __host__ __device__ void init(int M, int N, int G_, int c_) { nM = M / BM; nN = N / BM; nwg = nM * nN; G = G_; c = c_; }
    __host__ __device__ bool next(int i, Unit& u) const {
        const long L = (long)i * G + c; if (L >= nwg) return false;
        int wgid = (int)L; { const int q = nwg / NXCD, r = nwg % NXCD, xcd = wgid % NXCD, off = wgid / NXCD; wgid = (xcd < r ? xcd * (q + 1) : r * (q + 1) + (xcd - r) * q) + off; }
        const int nig = WGM * nN, gid = wgid / nig, fm = gid * WGM, gsz = (nM - fm) < WGM ? (nM - fm) : WGM;
        u.pm = fm + ((wgid % nig) % gsz); u.pn = (wgid % nig) / gsz; return true;
    }
    __device__ __forceinline__ void a_ready(const Unit&) const {}
    __device__ __forceinline__ void done(const Unit&) const {}
};

__device__ __forceinline__ unsigned cvt_pk_bf16(float lo, float hi) { unsigned r; asm volatile("v_cvt_pk_bf16_f32 %0, %1, %2" : "=v"(r) : "v"(lo), "v"(hi)); return r; }
typedef float f32x2 __attribute__((ext_vector_type(2)));
template <class Epi, class Sched, bool ALIGN_EPI = false, bool SP2 = false>
__device__ __forceinline__ void gemm_phase(PG8_LAS unsigned char* lds, const Gemm g, const Sched& S, const Epi& E, int wave_id) {
    int tid_; asm volatile("v_mbcnt_lo_u32_b32 %0, -1, 0\n\tv_mbcnt_hi_u32_b32 %0, -1, %0" : "=v"(tid_)); tid_ += wave_id * 64;
    const int tid = tid_, wid = __builtin_amdgcn_readfirstlane(tid >> 6), lane = tid & 63, wr = wid >> 2, wc = wid & 3, fr = lane & 15, fq = lane >> 4;
    const int K = g.K, nt = K / BK;
    unsigned voffA[2], voffB[2];
#pragma unroll
    for (int i = 0; i < 2; ++i) { int R, C; stage_rc(tid * 16 + i * 8192, R, C); const int Rb = Epi::PERM ? ((R & ~31) + perm32(R & 31)) : R;
        voffA[i] = (unsigned)(R * K + C) * 2u; voffB[i] = (unsigned)(Rb * K + C) * 2u; }
    const size_t kstep = (size_t)(BK * 2);
    const size_t hstep = (size_t)HALF * K * 2;
    const size_t tstep = 2 * hstep;
    const unsigned ldsw = (unsigned)wid * 1024u;
    const int aoff = lds_byte(wr * 64 + fr, fq * 8), boff = lds_byte(wc * 32 + fr, fq * 8);
#define PG8_SA(b, h) (((b) * 2 + (h)) * HTB)
#define PG8_SB(b, h) ((4 + (b) * 2 + (h)) * HTB)
#define PG8_STAGE(bufoff, gbase, voff) do { _Pragma("unroll") for (int _i = 0; _i < 2; ++_i) \
        __builtin_amdgcn_global_load_lds((const unsigned*)((const char*)(gbase) + (voff)[_i]), (PG8_LAS unsigned*)(lds + (bufoff) + ldsw + _i * 8192), 16, 0, 0); } while (0)
#define PG8_LDA(dst, b, h) do { _Pragma("unroll") for (int m = 0; m < 4; ++m) _Pragma("unroll") for (int k = 0; k < 2; ++k) dst[m][k] = *(const PG8_LAS bf16x8*)(lds + PG8_SA(b, h) + aoff + m * 2048 + k * 1024); } while (0)
#define PG8_LDB(dst, b, h) do { _Pragma("unroll") for (int n = 0; n < 2; ++n) _Pragma("unroll") for (int k = 0; k < 2; ++k) dst[n][k] = *(const PG8_LAS bf16x8*)(lds + PG8_SB(b, h) + boff + n * 2048 + k * 1024); } while (0)
#define PG8_MMA(ai, bj, At, Bt) do { __builtin_amdgcn_s_setprio(1); _Pragma("unroll") for (int m = 0; m < 4; ++m) _Pragma("unroll") for (int n = 0; n < 2; ++n) _Pragma("unroll") for (int k = 0; k < 2; ++k) \
        acc[ai][bj][m][n] = __builtin_amdgcn_mfma_f32_16x16x32_bf16(Bt[n][k], At[m][k], acc[ai][bj][m][n], 0, 0, 0); __builtin_amdgcn_s_setprio(0); } while (0)
#define PG8_WAIT_V(n) asm volatile("s_waitcnt vmcnt(" #n ")" ::: "memory")
#define PG8_WAIT_L(n) asm volatile("s_waitcnt lgkmcnt(" #n ")" ::: "memory")
#define PG8_BAR __builtin_amdgcn_s_barrier()
#define PG8_SCHED __builtin_amdgcn_sched_barrier(0)
    Unit cur, nxt; int ui = 0;
    if (!S.next(0, cur)) return;
    f32x4 acc[2][2][4][2];
#pragma unroll
    for (int a = 0; a < 2; ++a)
#pragma unroll
        for (int b = 0; b < 2; ++b)
#pragma unroll
            for (int m = 0; m < 4; ++m)
#pragma unroll
                for (int n = 0; n < 2; ++n) acc[a][b][m][n] = (f32x4){0.f, 0.f, 0.f, 0.f};
    bf16x8 At[4][2], B0[2][2], B1[2][2];
    const char* cA = (const char*)g.A + (size_t)cur.pm * tstep; const char* cB = (const char*)g.Bt + (size_t)cur.pn * tstep;
    S.a_ready(cur);
    if constexpr (SP2) {
        PG8_STAGE(PG8_SB(0, 0), cB, voffB); PG8_STAGE(PG8_SB(0, 1), cB + hstep, voffB); PG8_STAGE(PG8_SA(0, 0), cA, voffA); PG8_STAGE(PG8_SA(0, 1), cA + hstep, voffA);
        if (wr == 1) PG8_BAR;
        PG8_WAIT_V(2); PG8_BAR;
        PG8_STAGE(PG8_SB(1, 0), cB + kstep, voffB); PG8_STAGE(PG8_SA(1, 0), cA + kstep, voffA); PG8_STAGE(PG8_SB(1, 1), cB + hstep + kstep, voffB);
        PG8_WAIT_V(6); PG8_BAR;
    } else {
        PG8_STAGE(PG8_SB(0, 0), cB, voffB); PG8_STAGE(PG8_SA(0, 0), cA, voffA); PG8_STAGE(PG8_SB(0, 1), cB + hstep, voffB); PG8_STAGE(PG8_SA(0, 1), cA + hstep, voffA);
        if (wr == 1) PG8_BAR;
        PG8_WAIT_V(4); PG8_BAR;
        PG8_STAGE(PG8_SB(1, 0), cB + kstep, voffB); PG8_STAGE(PG8_SA(1, 0), cA + kstep, voffA); PG8_STAGE(PG8_SB(1, 1), cB + hstep + kstep, voffB);
        PG8_WAIT_V(6); PG8_BAR;
    }
    for (;;) {
        const bool has_next = S.next(ui + 1, nxt);
        const char* nA = has_next ? (const char*)g.A + (size_t)nxt.pm * tstep : cA; const char* nB = has_next ? (const char*)g.Bt + (size_t)nxt.pn * tstep : cB;
        for (int t = 0; t < nt; t += 2) {
            const bool last = (t == nt - 2);
            const char* a1 = cA + (size_t)(t + 1) * kstep;
            const char* a2 = last ? nA : cA + (size_t)(t + 2) * kstep; const char* b2 = last ? nB : cB + (size_t)(t + 2) * kstep;
            const char* a3 = a2 + kstep; const char* b3 = b2 + kstep;
            if (last && has_next) S.a_ready(nxt);
            if constexpr (SP2) {
            PG8_LDB(B0, 0, 0); PG8_LDB(B1, 0, 1); PG8_SCHED; PG8_LDA(At, 0, 0); PG8_STAGE(PG8_SA(1, 1), a1 + hstep, voffA);
            PG8_WAIT_V(8); PG8_WAIT_L(0); PG8_BAR; PG8_MMA(0, 0, At, B0); PG8_MMA(0, 1, At, B1); PG8_BAR; PG8_SCHED;
            PG8_LDA(At, 0, 1); PG8_STAGE(PG8_SB(0, 0), b2, voffB); PG8_STAGE(PG8_SB(0, 1), b2 + hstep, voffB); PG8_STAGE(PG8_SA(0, 0), a2, voffA);
            PG8_WAIT_V(8); PG8_WAIT_L(0); PG8_BAR; PG8_MMA(1, 0, At, B0); PG8_MMA(1, 1, At, B1); PG8_BAR; PG8_SCHED;
            PG8_LDB(B0, 1, 0); PG8_LDB(B1, 1, 1); PG8_SCHED; PG8_LDA(At, 1, 0); PG8_STAGE(PG8_SA(0, 1), a2 + hstep, voffA);
            PG8_WAIT_V(8); PG8_WAIT_L(0); PG8_BAR; PG8_MMA(0, 0, At, B0); PG8_MMA(0, 1, At, B1); PG8_BAR; PG8_SCHED;
            PG8_LDA(At, 1, 1); PG8_STAGE(PG8_SB(1, 0), b3, voffB); PG8_STAGE(PG8_SB(1, 1), b3 + hstep, voffB); PG8_STAGE(PG8_SA(1, 0), a3, voffA);
            PG8_WAIT_V(8); PG8_WAIT_L(0); PG8_BAR; PG8_MMA(1, 0, At, B0); PG8_MMA(1, 1, At, B1); PG8_BAR; PG8_SCHED;
            } else {
            PG8_LDB(B0, 0, 0); PG8_SCHED; PG8_LDA(At, 0, 0); PG8_STAGE(PG8_SA(1, 1), a1 + hstep, voffA);
            PG8_WAIT_L(8); PG8_BAR; PG8_WAIT_L(0); PG8_MMA(0, 0, At, B0); PG8_BAR; PG8_SCHED;
            PG8_LDB(B1, 0, 1); PG8_STAGE(PG8_SB(0, 0), b2, voffB);
            PG8_BAR; PG8_WAIT_L(0); PG8_MMA(0, 1, At, B1); PG8_BAR;
            PG8_LDA(At, 0, 1); PG8_STAGE(PG8_SA(0, 0), a2, voffA);
            PG8_BAR; PG8_WAIT_L(0); PG8_MMA(1, 0, At, B0); PG8_BAR; PG8_SCHED;
            PG8_STAGE(PG8_SB(0, 1), b2 + hstep, voffB);
            PG8_WAIT_V(6); PG8_BAR; PG8_MMA(1, 1, At, B1); PG8_BAR;
            PG8_LDB(B0, 1, 0); PG8_SCHED; PG8_LDA(At, 1, 0); PG8_STAGE(PG8_SA(0, 1), a2 + hstep, voffA);
            PG8_WAIT_L(8); PG8_BAR; PG8_WAIT_L(0); PG8_MMA(0, 0, At, B0); PG8_BAR; PG8_SCHED;
            PG8_LDB(B1, 1, 1); PG8_STAGE(PG8_SB(1, 0), b3, voffB);
            PG8_BAR; PG8_WAIT_L(0); PG8_MMA(0, 1, At, B1); PG8_BAR;
            PG8_LDA(At, 1, 1); PG8_STAGE(PG8_SA(1, 0), a3, voffA);
            PG8_BAR; PG8_WAIT_L(0); PG8_MMA(1, 0, At, B0); PG8_BAR; PG8_SCHED;
            PG8_STAGE(PG8_SB(1, 1), b3 + hstep, voffB);
            PG8_WAIT_V(6); PG8_BAR; PG8_MMA(1, 1, At, B1); PG8_BAR;
            }
        }
        if constexpr (ALIGN_EPI) { if (wr == 0) PG8_BAR; }
        if constexpr (!Epi::AFTER_DRAIN) { E(acc, cur, wr, wc, fr, fq); S.done(cur); }
        if (!has_next) break;
#pragma unroll
        for (int a = 0; a < 2; ++a)
#pragma unroll
            for (int b = 0; b < 2; ++b)
#pragma unroll
                for (int m = 0; m < 4; ++m)
#pragma unroll
                    for (int n = 0; n < 2; ++n) acc[a][b][m][n] = (f32x4){0.f, 0.f, 0.f, 0.f};
        cur = nxt; cA = nA; cB = nB; ++ui;
        if constexpr (ALIGN_EPI) { if (wr == 1) PG8_BAR; }
    }
    PG8_WAIT_V(0);
    if constexpr (!ALIGN_EPI) { if (wr == 0) PG8_BAR; }
    PG8_BAR;
    if constexpr (Epi::AFTER_DRAIN) { E.fused(acc, cur, wr, wc, fr, fq, lds, wid, lane); S.done(cur); }
#undef PG8_SA
#undef PG8_SB
#undef PG8_STAGE
#undef PG8_LDA
#undef PG8_LDB
#undef PG8_MMA
#undef PG8_WAIT_V
#undef PG8_WAIT_L
#undef PG8_BAR
#undef PG8_SCHED
}
}

#define LAS __attribute__((address_space(3)))
__device__ __forceinline__ int lane_id_v() { int l; asm volatile("v_mbcnt_lo_u32_b32 %0, -1, 0\n\tv_mbcnt_hi_u32_b32 %0, -1, %0" : "=v"(l)); return l; }
#define LANE_ID() lane_id_v()
template <int M> __device__ __forceinline__ float sxor(float v) { return __builtin_bit_cast(float, __builtin_amdgcn_ds_swizzle(__builtin_bit_cast(int, v), (M << 10) | 0x1f)); }
__device__ __forceinline__ void swap32(float& a, float& b) { asm volatile("s_nop 1\n\tv_permlane32_swap_b32 %0, %1\n\ts_nop 3" : "+v"(a), "+v"(b)); }
__device__ __forceinline__ float hsum32(float v) { float a = v, b = v; swap32(a, b); return a + b; }
typedef unsigned short bf16_t;
typedef pg8::f32x4 f32x4;
typedef pg8::u32x4 u32x4;
typedef unsigned u32x2 __attribute__((ext_vector_type(2)));
constexpr int SEQ = 8192, NB = 2, MTOK = NB * SEQ, DM = 1024, DFF = 2816, NMEM = 256, INW = 2304;
constexpr float EPS = 1e-5f;
constexpr float QSCALE = 0.125f * 1.4426950408889634f;
constexpr size_t MiB = 1u << 20;
constexpr size_t WS_WGU1 = 0, WS_WD1 = 11 * MiB, WS_WIN = 16 * MiB + MiB / 2, WS_WMKV = 21 * MiB, WS_WOUT = 22 * MiB, WS_WGU2 = 24 * MiB, WS_WD2 = 35 * MiB;
constexpr size_t WS_ROPE = 41 * MiB, WS_SSQ = 43 * MiB, WS_MEMN = 44 * MiB, WS_MK = 45 * MiB, WS_MVT = 45 * MiB + MiB / 4;
constexpr size_t WS_SMALL = 45 * MiB + MiB / 2;
constexpr int SM_LAM = 0, SM_SUBLN = 256, SM_DWW = 384, SM_DWB = SM_DWW + 31 * 256, SM_LNG = SM_DWB + 256, SM_LNB = SM_LNG + 256, SM_FNG = SM_LNB + 256, SM_END = SM_FNG + 1024;
constexpr size_t WS_CTL = 45 * MiB + 3 * MiB / 4, CTL_BYTES = 65536, CTL_CNT = 16384, CTL_BANK = 4096;
constexpr size_t WS_AB = 46 * MiB, WS_ACT = 78 * MiB, WS_MIXED = 166 * MiB, WS_XBUF = 198 * MiB  , WS_END = 199 * MiB;
constexpr size_t WS_Q = WS_ACT, WS_K = WS_ACT + 16 * MiB, WS_VT = WS_ACT + 32 * MiB, WS_G = WS_ACT + 48 * MiB, WS_MQ = WS_ACT + 56 * MiB;
constexpr int LDS_BYTES = 131072 + 1024;

#ifndef DEFER_W
#define DEFER_W 1
#endif
struct Params { const float* in[25]; float* out; unsigned char* ws; };

__device__ __forceinline__ unsigned f2bf(float f) { unsigned u = __builtin_bit_cast(unsigned, f); return (u + 0x7fffu + ((u >> 16) & 1u)) >> 16; }
__device__ __forceinline__ float bf2f(unsigned short h) { return __builtin_bit_cast(float, (unsigned)h << 16); }
__device__ __forceinline__ unsigned pk2(float lo, float hi) { return pg8::cvt_pk_bf16(lo, hi); }
__device__ __forceinline__ int perm16(int k) { return (k & 3) | (((k >> 3) & 1) << 2) | (((k >> 2) & 1) << 3); }
__device__ __forceinline__ float wave_sum(float v) {
    v += sxor<1>(v); v += sxor<2>(v); v += sxor<4>(v); v += sxor<8>(v); v += sxor<16>(v); v = hsum32(v);
    return v;
}
__device__ __forceinline__ float row_rstd(const float* ssq, int row) {
    const f32x4* p = (const f32x4*)(ssq + (size_t)row * 16);
    const f32x4 a = p[0], b = p[1], c = p[2], d = p[3];
    const float s = ((a.x + a.y) + (a.z + a.w)) + ((b.x + b.y) + (b.z + b.w)) + ((c.x + c.y) + (c.z + c.w)) + ((d.x + d.y) + (d.z + d.w));
    return 1.0f / sqrtf(s * (1.0f / DM) + EPS);
}
__device__ __forceinline__ float row_rstd_q(const float* ssq, int row, int fq) {
    const f32x4 a = ((const f32x4*)(ssq + (size_t)row * 16))[fq];
    float s = (a.x + a.y) + (a.z + a.w);
    s += sxor<16>(s); s = hsum32(s);
    return __builtin_amdgcn_rsqf(s * (1.0f / DM) + EPS);
}
__device__ __forceinline__ float silu_f(float g) { return g * __builtin_amdgcn_rcpf(1.0f + __expf(-g)); }

__device__ __forceinline__ void rows_rstd8(const float* ssq, int row0, int fq, float (&rs)[8]) {
    f32x4 pv[8];
#pragma unroll
    for (int i = 0; i < 8; ++i) pv[i] = ((const f32x4*)(ssq + (size_t)(row0 + (i >> 2) * 128 + (i & 3) * 16) * 16))[fq];
#pragma unroll
    for (int i = 0; i < 8; ++i) { float t = (pv[i].x + pv[i].y) + (pv[i].z + pv[i].w); t += sxor<16>(t); t = hsum32(t); rs[i] = __builtin_amdgcn_rsqf(t * (1.0f / DM) + EPS); }
}

#ifndef EPI_FENCE
#define EPI_FENCE(m) ((m) == 3)
#endif
struct EpiSwiGLU {
    static constexpr bool PERM = true, AFTER_DRAIN = false;
    bf16_t* O; const float* ssq;
    __device__ __forceinline__ void operator()(const f32x4 (&acc)[2][2][4][2], const pg8::Unit& u, int wr, int wc, int fr, int fq) const {
        asm volatile("" : "+v"(fr), "+v"(fq));
        const int row0 = u.pm * 256 + wr * 64 + fr, col0 = u.pn * 128 + wc * 32 + fq * 8;
        float rs8[8];
        if (ssq) rows_rstd8(ssq, row0, fq, rs8); else {
#pragma unroll
            for (int i = 0; i < 8; ++i) rs8[i] = 1.0f; }
#pragma unroll
        for (int ai = 0; ai < 2; ++ai)
#pragma unroll
            for (int m = 0; m < 4; ++m) {
                const int row = row0 + ai * 128 + m * 16;
                const float rs = rs8[ai * 4 + m];
                float v[8];
#pragma unroll
                for (int n = 0; n < 2; ++n)
#pragma unroll
                    for (int i = 0; i < 4; ++i) v[n * 4 + i] = silu_f(acc[ai][0][m][n][i] * rs) * (acc[ai][1][m][n][i] * rs);
                u32x4 w; w.x = pk2(v[0], v[1]); w.y = pk2(v[2], v[3]); w.z = pk2(v[4], v[5]); w.w = pk2(v[6], v[7]);
                *(u32x4*)(O + (size_t)row * DFF + col0) = w;
                if (EPI_FENCE(m)) asm volatile("" ::: "memory");
            }
    }
};
struct EpiResid {
    static constexpr bool PERM = true, AFTER_DRAIN = false;
    const float* basef; const bf16_t* baseb; float* H; bf16_t* HB; float* ssq; float alpha;
    __device__ __forceinline__ void row_part(const f32x4& a0, const f32x4& a1, const f32x4& b0, const f32x4& b1, size_t off, float& ss) const {
        const f32x4 h0 = b0 + a0 * alpha, h1 = b1 + a1 * alpha;
        if (H) { *(f32x4*)(H + off) = h0; *(f32x4*)(H + off + 4) = h1; }
        if (HB) { u32x4 w; w.x = pk2(h0.x, h0.y); w.y = pk2(h0.z, h0.w); w.z = pk2(h1.x, h1.y); w.w = pk2(h1.z, h1.w); *(u32x4*)(HB + off) = w; }
        ss += (h0.x * h0.x + h0.y * h0.y) + (h0.z * h0.z + h0.w * h0.w) + (h1.x * h1.x + h1.y * h1.y) + (h1.z * h1.z + h1.w * h1.w);
    }
    __device__ __forceinline__ void row_end(float ss, int row, int pn, int wc, int fq) const {
        if (ssq) { ss += sxor<16>(ss); ss = hsum32(ss); if (fq == 0) ssq[(size_t)row * 16 + pn * 4 + wc] = ss; }
    }
    __device__ __forceinline__ void operator()(const f32x4 (&acc)[2][2][4][2], const pg8::Unit& u, int wr, int wc, int fr, int fq) const {
        asm volatile("" : "+v"(fr), "+v"(fq));
        const int row0 = u.pm * 256 + wr * 64 + fr, col0 = u.pn * 256 + wc * 32 + fq * 8;
        if (basef) {
#pragma unroll
            for (int g = 0; g < 4; ++g) {
                f32x4 pre[2][2][2];
#pragma unroll
                for (int k = 0; k < 2; ++k)
#pragma unroll
                    for (int bj = 0; bj < 2; ++bj) { const size_t off = (size_t)(row0 + (g >> 1) * 128 + ((g & 1) * 2 + k) * 16) * DM + col0 + bj * 128;
                        pre[k][bj][0] = *(const f32x4*)(basef + off); pre[k][bj][1] = *(const f32x4*)(basef + off + 4); }
#pragma unroll
                for (int k = 0; k < 2; ++k) { const int ai = g >> 1, m = (g & 1) * 2 + k, row = row0 + ai * 128 + m * 16; float ss = 0.f;
#pragma unroll
                    for (int bj = 0; bj < 2; ++bj) row_part(acc[ai][bj][m][0], acc[ai][bj][m][1], pre[k][bj][0], pre[k][bj][1], (size_t)row * DM + col0 + bj * 128, ss);
                    row_end(ss, row, u.pn, wc, fq); }
                asm volatile("" ::: "memory");
            }
        } else {
#pragma unroll
            for (int ai = 0; ai < 2; ++ai) {
                u32x4 pre[4][2];
#pragma unroll
                for (int m = 0; m < 4; ++m)
#pragma unroll
                    for (int bj = 0; bj < 2; ++bj) pre[m][bj] = *(const u32x4*)(baseb + (size_t)(row0 + ai * 128 + m * 16) * DM + col0 + bj * 128);
#pragma unroll
                for (int m = 0; m < 4; ++m) { const int row = row0 + ai * 128 + m * 16; float ss = 0.f;
#pragma unroll
                    for (int bj = 0; bj < 2; ++bj) { const u32x4 w = pre[m][bj];
                        const f32x4 b0 = (f32x4){__builtin_bit_cast(float, w.x << 16), __builtin_bit_cast(float, w.x & 0xffff0000u), __builtin_bit_cast(float, w.y << 16), __builtin_bit_cast(float, w.y & 0xffff0000u)};
                        const f32x4 b1 = (f32x4){__builtin_bit_cast(float, w.z << 16), __builtin_bit_cast(float, w.z & 0xffff0000u), __builtin_bit_cast(float, w.w << 16), __builtin_bit_cast(float, w.w & 0xffff0000u)};
                        row_part(acc[ai][bj][m][0], acc[ai][bj][m][1], b0, b1, (size_t)row * DM + col0 + bj * 128, ss); }
                    row_end(ss, row, u.pn, wc, fq); }
                asm volatile("" ::: "memory");
            }
        }
    }
};
template <bool F32BASE> struct EpiExch {
    static constexpr bool PERM = true, AFTER_DRAIN = true;
    const float* basef; const bf16_t* baseb; const float* rnin; float alpha; float* OUT; const float* gfin; bf16_t* HBN; float* rnout; float* xbuf; unsigned* cnt;
    __device__ __forceinline__ void fused(f32x4 (&acc)[2][2][4][2], const pg8::Unit& u, int wr, int wc, int fr, int fq, LAS unsigned char* lds, int wid, int lane) const {
        asm volatile("" : "+v"(fr), "+v"(fq), "+v"(lane));
        LAS float* Pp = (LAS float*)lds;
        LAS float* S = (LAS float*)(lds + 4096);
        const int col0 = u.pn * 256 + wc * 32 + fq * 8;
        const int rowl0 = wr * 64 + fr;
        if constexpr (F32BASE) {
            unsigned vofff = (unsigned)((rowl0 * DM + col0) * 4); asm volatile("" : "+v"(vofff));
#pragma unroll
            for (int g = 0; g < 8; ++g) {
                const int ai = g >> 2, m = g & 3; f32x4 pre[2][2];
#pragma unroll
                for (int bj = 0; bj < 2; ++bj) { const char* sb = (const char*)(basef + (size_t)(u.pm * 256 + ai * 128 + m * 16) * DM + bj * 128);
                    pre[bj][0] = __builtin_nontemporal_load((const f32x4*)(sb + vofff)); pre[bj][1] = __builtin_nontemporal_load((const f32x4*)(sb + vofff + 16)); }
                float ss = 0.f;
#pragma unroll
                for (int bj = 0; bj < 2; ++bj) { const f32x4 h0 = pre[bj][0] + acc[ai][bj][m][0] * alpha, h1 = pre[bj][1] + acc[ai][bj][m][1] * alpha;
                    acc[ai][bj][m][0] = h0; acc[ai][bj][m][1] = h1;
                    ss += (h0.x * h0.x + h0.y * h0.y) + (h0.z * h0.z + h0.w * h0.w) + (h1.x * h1.x + h1.y * h1.y) + (h1.z * h1.z + h1.w * h1.w); }
                ss += sxor<16>(ss); ss = hsum32(ss);
                if (fq == 0) Pp[(rowl0 + ai * 128 + m * 16) * 4 + wc] = ss;
                if (g & 1) asm volatile("" ::: "memory");
            }
        } else {
#pragma unroll
            for (int ai = 0; ai < 2; ++ai) {
                u32x4 pre[4][2]; float rn[4];
#pragma unroll
                for (int m = 0; m < 4; ++m) { const int row = u.pm * 256 + rowl0 + ai * 128 + m * 16; rn[m] = rnin ? rnin[row] : 1.0f;
#pragma unroll
                    for (int bj = 0; bj < 2; ++bj) pre[m][bj] = *(const u32x4*)(baseb + (size_t)row * DM + col0 + bj * 128); }
#pragma unroll
                for (int m = 0; m < 4; ++m) { float ss = 0.f;
#pragma unroll
                    for (int bj = 0; bj < 2; ++bj) {
                        const u32x4 w = pre[m][bj];
                        const f32x4 b0 = (f32x4){__builtin_bit_cast(float, w.x << 16), __builtin_bit_cast(float, w.x & 0xffff0000u), __builtin_bit_cast(float, w.y << 16), __builtin_bit_cast(float, w.y & 0xffff0000u)};
                        const f32x4 b1 = (f32x4){__builtin_bit_cast(float, w.z << 16), __builtin_bit_cast(float, w.z & 0xffff0000u), __builtin_bit_cast(float, w.w << 16), __builtin_bit_cast(float, w.w & 0xffff0000u)};
                        const f32x4 h0 = b0 * rn[m] + acc[ai][bj][m][0] * alpha, h1 = b1 * rn[m] + acc[ai][bj][m][1] * alpha;
                        acc[ai][bj][m][0] = h0; acc[ai][bj][m][1] = h1;
                        ss += (h0.x * h0.x + h0.y * h0.y) + (h0.z * h0.z + h0.w * h0.w) + (h1.x * h1.x + h1.y * h1.y) + (h1.z * h1.z + h1.w * h1.w);
                    }
                    ss += sxor<16>(ss); ss = hsum32(ss);
                    if (fq == 0) Pp[(rowl0 + ai * 128 + m * 16) * 4 + wc] = ss;
                }
                asm volatile("" ::: "memory");
            }
        }
        asm volatile("s_waitcnt lgkmcnt(0)" ::: "memory"); __builtin_amdgcn_s_barrier(); asm volatile("" ::: "memory");
        const int t = wid * 64 + lane;
        if (t < 256) { const f32x4 p = *(const LAS f32x4*)(Pp + t * 4);
            __hip_atomic_store(xbuf + (size_t)(u.pm * 256 + t) * 4 + u.pn, (p.x + p.y) + (p.z + p.w), __ATOMIC_RELAXED, __HIP_MEMORY_SCOPE_AGENT); }
        asm volatile("s_waitcnt vmcnt(0)" ::: "memory");
        if (lane == 0) __hip_atomic_fetch_add(cnt + 64 * u.pm, 1u, __ATOMIC_RELAXED, __HIP_MEMORY_SCOPE_AGENT);
        if (wid == 0) {
            unsigned spins = 0;
            while ((unsigned)__builtin_amdgcn_readfirstlane(__hip_atomic_load(cnt + 64 * u.pm, __ATOMIC_RELAXED, __HIP_MEMORY_SCOPE_AGENT)) < 32u) { __builtin_amdgcn_s_sleep(2); if (++spins > (1u << 22)) break; }
            __builtin_amdgcn_fence(__ATOMIC_ACQUIRE, "agent");
        }
        asm volatile("s_waitcnt vmcnt(0) lgkmcnt(0)" ::: "memory"); __builtin_amdgcn_s_barrier(); asm volatile("" ::: "memory");
        if (t < 256) { const float* sl = xbuf + (size_t)(u.pm * 256 + t) * 4; float q = 0.f;
#pragma unroll
            for (int k = 0; k < 4; ++k) q += __hip_atomic_load(sl + k, __ATOMIC_RELAXED, __HIP_MEMORY_SCOPE_AGENT);
            const float ms = q * (1.0f / DM) + EPS;
            S[t] = __builtin_amdgcn_rsqf(ms);
            if (rnout && u.pn == 0) rnout[u.pm * 256 + t] = sqrtf(ms); }
        asm volatile("s_waitcnt lgkmcnt(0)" ::: "memory"); __builtin_amdgcn_s_barrier(); asm volatile("" ::: "memory");
        if (OUT) {
#pragma unroll
            for (int bj = 0; bj < 2; ++bj) { const f32x4 g0 = *(const f32x4*)(gfin + col0 + bj * 128), g1 = *(const f32x4*)(gfin + col0 + bj * 128 + 4);
#pragma unroll
                for (int ai = 0; ai < 2; ++ai)
#pragma unroll
                    for (int m = 0; m < 4; ++m) { const int rl = rowl0 + ai * 128 + m * 16; const float rs = S[rl];
                        float* op = OUT + (size_t)(u.pm * 256 + rl) * DM + col0 + bj * 128;
                        *(f32x4*)op = acc[ai][bj][m][0] * rs * g0; *(f32x4*)(op + 4) = acc[ai][bj][m][1] * rs * g1; }
                asm volatile("" ::: "memory"); }
        } else {
#pragma unroll
            for (int ai = 0; ai < 2; ++ai)
#pragma unroll
                for (int m = 0; m < 4; ++m) { const int rl = rowl0 + ai * 128 + m * 16; const float rs = S[rl];
#pragma unroll
                    for (int bj = 0; bj < 2; ++bj) { const f32x4 a0 = acc[ai][bj][m][0] * rs, a1 = acc[ai][bj][m][1] * rs;
                        u32x4 w; w.x = pk2(a0.x, a0.y); w.y = pk2(a0.z, a0.w); w.z = pk2(a1.x, a1.y); w.w = pk2(a1.z, a1.w);
                        *(u32x4*)(HBN + (size_t)(u.pm * 256 + rl) * DM + col0 + bj * 128) = w; }
                    if (m & 1) asm volatile("" ::: "memory"); }
        }
    }
};
struct EpiInProj {
    static constexpr bool PERM = true, AFTER_DRAIN = false;
    const float* ssq; const float* ropec; const float* ropes; bf16_t *Q, *K, *VT, *G, *MQ;
    __device__ __forceinline__ void operator()(const f32x4 (&acc)[2][2][4][2], const pg8::Unit& u, int wr, int wc, int fr, int fq) const {
        asm volatile("" : "+v"(fr), "+v"(fq));
        const int row0 = u.pm * 256 + wr * 64 + fr; const int pn = u.pn;
        float rs8[8];
        if (ssq) rows_rstd8(ssq, row0, fq, rs8); else {
#pragma unroll
            for (int i = 0; i < 8; ++i) rs8[i] = 1.0f; }
        f32x4 rc[2][2], rsn[2][2];
#pragma unroll
        for (int ai = 0; ai < 2; ++ai)
#pragma unroll
            for (int m = 0; m < 4; ++m) {
                const int row = row0 + ai * 128 + m * 16;
                const float rs = rs8[ai * 4 + m];
                if (pn < 4) {
                    const int pos = row & (SEQ - 1);
                    const float sc = (pn < 2) ? QSCALE : 1.0f;
                    if ((m & 1) == 0) {
#pragma unroll
                        for (int k = 0; k < 2; ++k)
#pragma unroll
                            for (int n = 0; n < 2; ++n) { rc[k][n] = *(const f32x4*)(ropec + (pos + 16 * k) * 32 + fq * 8 + n * 4); rsn[k][n] = *(const f32x4*)(ropes + (pos + 16 * k) * 32 + fq * 8 + n * 4); } }
                    float o1[8], o2[8];
#pragma unroll
                    for (int n = 0; n < 2; ++n) {
                        const f32x4 c = rc[m & 1][n], s = rsn[m & 1][n];
#pragma unroll
                        for (int i = 0; i < 4; ++i) { const float x1 = acc[ai][0][m][n][i] * rs, x2 = acc[ai][1][m][n][i] * rs;
                            o1[n * 4 + i] = (x1 * c[i] - x2 * s[i]) * sc; o2[n * 4 + i] = (x2 * c[i] + x1 * s[i]) * sc; }
                    }
                    bf16_t* dst = ((pn < 2) ? Q : K) + (size_t)row * 512 + (pn & 1) * 256 + wc * 64 + fq * 8;
                    u32x4 w; w.x = pk2(o1[0], o1[1]); w.y = pk2(o1[2], o1[3]); w.z = pk2(o1[4], o1[5]); w.w = pk2(o1[6], o1[7]); *(u32x4*)dst = w;
                    w.x = pk2(o2[0], o2[1]); w.y = pk2(o2[2], o2[3]); w.z = pk2(o2[4], o2[5]); w.w = pk2(o2[6], o2[7]); *(u32x4*)(dst + 32) = w;
                } else if (pn < 6) {
                    const int b = u.pm >> 5, t = row & (SEQ - 1);
                    unsigned voff = (unsigned)((wc * 32 + fq * 8) * SEQ + ((t & ~15) | perm16(t & 15))); asm volatile("" : "+v"(voff));
#pragma unroll
                    for (int bj = 0; bj < 2; ++bj)
#pragma unroll
                        for (int n = 0; n < 2; ++n)
#pragma unroll
                            for (int i = 0; i < 4; ++i) { bf16_t* bp = VT + (size_t)((b * 4 + (pn - 4) * 2 + bj) * 128 + n * 4 + i) * SEQ;
                                bp[voff] = (bf16_t)f2bf(acc[ai][bj][m][n][i] * rs); }
                } else if (pn < 8) {
                    float v[8];
#pragma unroll
                    for (int n = 0; n < 2; ++n)
#pragma unroll
                        for (int i = 0; i < 4; ++i) { const float a = acc[ai][0][m][n][i] * rs, g = acc[ai][1][m][n][i] * rs; v[n * 4 + i] = a * __builtin_amdgcn_rcpf(1.0f + __expf(-g)); }
                    u32x4 w; w.x = pk2(v[0], v[1]); w.y = pk2(v[2], v[3]); w.z = pk2(v[4], v[5]); w.w = pk2(v[6], v[7]);
                    *(u32x4*)(G + (size_t)row * 256 + (pn - 6) * 128 + wc * 32 + fq * 8) = w;
                } else {
#pragma unroll
                    for (int bj = 0; bj < 2; ++bj) { const f32x4 a0 = acc[ai][bj][m][0] * (rs * QSCALE), a1 = acc[ai][bj][m][1] * (rs * QSCALE);
                        u32x4 w; w.x = pk2(a0.x, a0.y); w.y = pk2(a0.z, a0.w); w.z = pk2(a1.x, a1.y); w.w = pk2(a1.z, a1.w);
                        *(u32x4*)(MQ + (size_t)row * 256 + bj * 128 + wc * 32 + fq * 8) = w; }
                }
                if (EPI_FENCE(m)) asm volatile("" ::: "memory");
            }
    }
};
struct EpiMemKV {
    static constexpr bool PERM = true, AFTER_DRAIN = false;
    bf16_t *MK, *MVT;
    __device__ __forceinline__ void operator()(const f32x4 (&acc)[2][2][4][2], const pg8::Unit& u, int wr, int wc, int fr, int fq) const {
        asm volatile("" : "+v"(fr), "+v"(fq));
        const int row0 = u.pm * 256 + wr * 64 + fr;
#pragma unroll
        for (int ai = 0; ai < 2; ++ai)
#pragma unroll
            for (int m = 0; m < 4; ++m) {
                const int row = row0 + ai * 128 + m * 16;
                if (u.pn == 0) {
#pragma unroll
                    for (int bj = 0; bj < 2; ++bj) { const f32x4 a0 = acc[ai][bj][m][0], a1 = acc[ai][bj][m][1];
                        u32x4 w; w.x = pk2(a0.x, a0.y); w.y = pk2(a0.z, a0.w); w.z = pk2(a1.x, a1.y); w.w = pk2(a1.z, a1.w);
                        *(u32x4*)(MK + (size_t)row * 256 + bj * 128 + wc * 32 + fq * 8) = w; }
                } else {
                    const int b = u.pm, mi = row & 255;
                    unsigned voff = (unsigned)((wc * 32 + fq * 8) * NMEM + ((mi & ~15) | perm16(mi & 15))); asm volatile("" : "+v"(voff));
#pragma unroll
                    for (int bj = 0; bj < 2; ++bj)
#pragma unroll
                        for (int n = 0; n < 2; ++n)
#pragma unroll
                            for (int i = 0; i < 4; ++i) { bf16_t* bp = MVT + (size_t)((b * 4 + bj * 2) * 64 + n * 4 + i) * NMEM;
                                bp[voff] = (bf16_t)f2bf(acc[ai][bj][m][n][i]); }
                }
                if (EPI_FENCE(m)) asm volatile("" ::: "memory");
            }
    }
};

__device__ __forceinline__ void transpose_item(const float* W, int ldw, int s0, const float* gain, bf16_t* WT, int K, int p0, int k0, LAS float* scr, int lane) {
#pragma unroll 8
    for (int i = 0; i < 32; ++i) { const int kk = 2 * i + (lane >> 5); float v = __builtin_nontemporal_load(&W[(size_t)(k0 + kk) * ldw + s0 + (lane & 31)]); if (gain) v *= gain[k0 + kk];     scr[kk * 33 + (lane & 31)] = v; }
    asm volatile("s_waitcnt lgkmcnt(0)" ::: "memory");
    const int c = lane & 7;
#pragma unroll
    for (int j = 0; j < 4; ++j) { const int n = (lane >> 3) + 8 * j; const LAS float* s = scr + (8 * c) * 33 + n;
        u32x4 o; o.x = pk2(s[0 * 33], s[1 * 33]); o.y = pk2(s[2 * 33], s[3 * 33]); o.z = pk2(s[4 * 33], s[5 * 33]); o.w = pk2(s[6 * 33], s[7 * 33]);
        *(u32x4*)(WT + (size_t)(p0 + n) * K + k0 + 8 * c) = o; }
    asm volatile("s_waitcnt lgkmcnt(0)" ::: "memory");
}
__device__ __forceinline__ int in_src_col(int p0) {
    const int pn = p0 >> 8, p = p0 & 255, bj = p >> 7, wc = (p >> 5) & 3;
    if (pn < 4) return 256 * pn + 64 * wc + 32 * bj;
    if (pn == 6 || pn == 7) return (bj ? 1792 : 1536) + 128 * (pn - 6) + (p & 127);
    return p0;
}
__device__ __forceinline__ void rms_row_to_bf16(const float* xrow, const float* g, bf16_t* orow, int lane) {
    const f32x4* xr = (const f32x4*)xrow + lane; const f32x4* gr = (const f32x4*)g + lane;
    f32x4 v[4]; float s = 0.f;
#pragma unroll
    for (int j = 0; j < 4; ++j) { v[j] = __builtin_nontemporal_load(&xr[64 * j]); s += (v[j].x * v[j].x + v[j].y * v[j].y) + (v[j].z * v[j].z + v[j].w * v[j].w); }
    const float rstd = 1.0f / sqrtf(wave_sum(s) * (1.0f / DM) + EPS);
    u32x2* o8 = (u32x2*)orow + lane;
#pragma unroll
    for (int j = 0; j < 4; ++j) { const f32x4 gg = gr[64 * j]; u32x2 w; w.x = pk2(v[j].x * rstd * gg.x, v[j].y * rstd * gg.y); w.y = pk2(v[j].z * rstd * gg.z, v[j].w * rstd * gg.w); o8[64 * j] = w; }
}

template <int NJ>
__device__ __forceinline__ void naive_stream(const bf16_t* qp, const bf16_t* Kb, int kpitch, const bf16_t* Vt, int vpitch, int nkeys, float (&o)[NJ]) {
    u32x4 q[8];
#pragma unroll
    for (int j = 0; j < 8; ++j) q[j] = *(const u32x4*)(qp + 8 * j);
#define BLO(w) __builtin_bit_cast(float, (w) << 16)
#define BHI(w) __builtin_bit_cast(float, (w) & 0xffff0000u)
    float mx = -INFINITY, l = 0.f; int zoff = 0; asm volatile("" : "+v"(zoff));
#pragma unroll
    for (int j = 0; j < NJ; ++j) o[j] = 0.f;
    for (int kb = 0; kb < nkeys; kb += 16) {
        float s[16];
#pragma unroll
        for (int kk = 0; kk < 16; ++kk) {
            const bf16_t* kp = Kb + (size_t)(kb + kk) * kpitch + zoff; float a = 0.f;
#pragma unroll
            for (int j = 0; j < 8; ++j) { const u32x4 w = *(const u32x4*)(kp + 8 * j);
                a += BLO(q[j].x) * BLO(w.x) + BHI(q[j].x) * BHI(w.x); a += BLO(q[j].y) * BLO(w.y) + BHI(q[j].y) * BHI(w.y);
                a += BLO(q[j].z) * BLO(w.z) + BHI(q[j].z) * BHI(w.z); a += BLO(q[j].w) * BLO(w.w) + BHI(q[j].w) * BHI(w.w); }
            s[kk] = a;
        }
        float bm = s[0];
#pragma unroll
        for (int kk = 1; kk < 16; ++kk) bm = fmaxf(bm, s[kk]);
        const float mn = fmaxf(mx, bm), sc = exp2f(mx - mn); mx = mn;
        float ps = 0.f;
#pragma unroll
        for (int kk = 0; kk < 16; ++kk) { s[kk] = exp2f(s[kk] - mn); ps += s[kk]; }
        l = l * sc + ps;
#pragma unroll
        for (int j = 0; j < NJ; ++j) {
            const bf16_t* vp = Vt + (size_t)j * vpitch + kb;
            const u32x4 w0 = *(const u32x4*)vp, w1 = *(const u32x4*)(vp + 8);
            float a = 0.f;
            a += s[0] * __builtin_bit_cast(float, w0.x << 16) + s[1] * __builtin_bit_cast(float, w0.x & 0xffff0000u);
            a += s[2] * __builtin_bit_cast(float, w0.y << 16) + s[3] * __builtin_bit_cast(float, w0.y & 0xffff0000u);
            a += s[8] * __builtin_bit_cast(float, w0.z << 16) + s[9] * __builtin_bit_cast(float, w0.z & 0xffff0000u);
            a += s[10] * __builtin_bit_cast(float, w0.w << 16) + s[11] * __builtin_bit_cast(float, w0.w & 0xffff0000u);
            a += s[4] * __builtin_bit_cast(float, w1.x << 16) + s[5] * __builtin_bit_cast(float, w1.x & 0xffff0000u);
            a += s[6] * __builtin_bit_cast(float, w1.y << 16) + s[7] * __builtin_bit_cast(float, w1.y & 0xffff0000u);
            a += s[12] * __builtin_bit_cast(float, w1.z << 16) + s[13] * __builtin_bit_cast(float, w1.z & 0xffff0000u);
            a += s[14] * __builtin_bit_cast(float, w1.w << 16) + s[15] * __builtin_bit_cast(float, w1.w & 0xffff0000u);
            o[j] = o[j] * sc + a;
        }
    }
    const float rl = 1.0f / l;
#pragma unroll
    for (int j = 0; j < NJ; ++j) o[j] *= rl;
}


typedef short bf16x8 __attribute__((ext_vector_type(8)));
typedef float f32x16 __attribute__((ext_vector_type(16)));
typedef float f32x2_t __attribute__((ext_vector_type(2)));
typedef __bf16 bf16x2_t __attribute__((ext_vector_type(2)));
__device__ __forceinline__ unsigned cvtpk_s(float lo, float hi) { f32x2_t v = {lo, hi}; bf16x2_t b = __builtin_convertvector(v, bf16x2_t); return __builtin_bit_cast(unsigned, b); }
__device__ __forceinline__ int crow(int r, int hi) { return (r & 3) + 8 * (r >> 2) + 4 * hi; }
#define MFMA32(a, b, c) __builtin_amdgcn_mfma_f32_32x32x16_bf16((a), (b), (c), 0, 0, 0)
constexpr int KST = 144;
constexpr int DA_KSLOT = 16384, DA_VSLOT = 16384, DA_V0 = 3 * DA_KSLOT;
constexpr int DA_WSF = DA_V0 + 3 * DA_VSLOT;
constexpr int MA_VST = 528, MA_VT = 256 * KST;
static_assert(DA_WSF >= 65536 && DA_WSF + 1024 <= 131072 && MA_VT + 64 * MA_VST <= DA_WSF, "attention LDS map");

__device__ __forceinline__ void qk_tile(const LAS unsigned char* Kt, int kst, const bf16x8 (&qr)[4], f32x16& p0, f32x16& p1, int r32, int hi) {
#pragma unroll
    for (int r = 0; r < 16; ++r) { p0[r] = 0.f; p1[r] = 0.f; }
    const LAS unsigned char* ka = Kt + r32 * kst + hi * 16;
#pragma unroll
    for (int ds = 0; ds < 4; ++ds) {
        const bf16x8 a0 = *(const LAS bf16x8*)(ka + ds * 32), a1 = *(const LAS bf16x8*)(ka + 32 * kst + ds * 32);
        p0 = MFMA32(a0, qr[ds], p0); p1 = MFMA32(a1, qr[ds], p1);
    }
}
__device__ __forceinline__ float half_max(float v) { float a = v, b = v; swap32(a, b); return fmaxf(a, b); }
__device__ __forceinline__ float half_sum(float v) { return hsum32(v); }
template <int NDB>
__device__ __forceinline__ void soft_max_rescale(const f32x16& p0, const f32x16& p1, f32x16 (&o)[NDB], float& m, float& l, LAS float* wsf, int r32, int hi) {
    float ra = fmaxf(p0[0], p1[0]), rb = fmaxf(p0[1], p1[1]);
#pragma unroll
    for (int r = 2; r < 16; r += 2) { ra = fmaxf(ra, fmaxf(p0[r], p1[r])); rb = fmaxf(rb, fmaxf(p0[r + 1], p1[r + 1])); }
    const float rm = half_max(fmaxf(ra, rb));
    if (__any(rm > m + 8.0f)) {
        const float mn = (rm > m + 8.0f) ? rm : m;
        const float alpha = __builtin_amdgcn_exp2f(m - mn); l *= alpha; m = mn;
        asm volatile("" ::: "memory");
        if (hi == 0) wsf[r32] = alpha;
        asm volatile("" ::: "memory");
        float al[16];
#pragma unroll
        for (int r = 0; r < 16; ++r) al[r] = wsf[crow(r, hi)];
#pragma unroll
        for (int blk = 0; blk < NDB; ++blk)
#pragma unroll
            for (int r = 0; r < 16; ++r) o[blk][r] *= al[r];
        asm volatile("" ::: "memory");
    }
}
__device__ __forceinline__ void soft_exp_pack(f32x16& p0, f32x16& p1, float m, float& l, bf16x8 (&pa)[4]) {
    float ps0 = 0.f, ps1 = 0.f;
#pragma unroll
    for (int r = 0; r < 16; ++r) { p0[r] = __builtin_amdgcn_exp2f(p0[r] - m); p1[r] = __builtin_amdgcn_exp2f(p1[r] - m); ps0 += p0[r]; ps1 += p1[r]; }
    l += ps0 + ps1;
    u32x4 w;
    w.x = cvtpk_s(p0[0], p0[1]); w.y = cvtpk_s(p0[2], p0[3]); w.z = cvtpk_s(p0[4], p0[5]); w.w = cvtpk_s(p0[6], p0[7]); pa[0] = __builtin_bit_cast(bf16x8, w);
    w.x = cvtpk_s(p0[8], p0[9]); w.y = cvtpk_s(p0[10], p0[11]); w.z = cvtpk_s(p0[12], p0[13]); w.w = cvtpk_s(p0[14], p0[15]); pa[1] = __builtin_bit_cast(bf16x8, w);
    w.x = cvtpk_s(p1[0], p1[1]); w.y = cvtpk_s(p1[2], p1[3]); w.z = cvtpk_s(p1[4], p1[5]); w.w = cvtpk_s(p1[6], p1[7]); pa[2] = __builtin_bit_cast(bf16x8, w);
    w.x = cvtpk_s(p1[8], p1[9]); w.y = cvtpk_s(p1[10], p1[11]); w.z = cvtpk_s(p1[12], p1[13]); w.w = cvtpk_s(p1[14], p1[15]); pa[3] = __builtin_bit_cast(bf16x8, w);
}
template <int NDB>
__device__ __forceinline__ void pv_tile(const LAS unsigned char* Vt, int vst, const bf16x8 (&pa)[4], f32x16 (&o)[NDB], int r32, int hi) {
    const LAS unsigned char* va = Vt + r32 * vst + hi * 16;
#pragma unroll
    for (int st = 0; st < 4; ++st)
#pragma unroll
        for (int blk = 0; blk < NDB; ++blk) {
            const bf16x8 vb = *(const LAS bf16x8*)(va + blk * 32 * vst + st * 32);
            o[blk] = MFMA32(pa[st], vb, o[blk]);
        }
}
template <int NDB>
__device__ __forceinline__ void attn_tile(const LAS unsigned char* Kt, int kst, const LAS unsigned char* Vt, int vst, const bf16x8 (&qr)[4], f32x16 (&o)[NDB], float& m, float& l, LAS float* wsf, int r32, int hi) {
    f32x16 p0, p1; bf16x8 pa[4];
    qk_tile(Kt, kst, qr, p0, p1, r32, hi);
    soft_max_rescale<NDB>(p0, p1, o, m, l, wsf, r32, hi);
    soft_exp_pack(p0, p1, m, l, pa);
    pv_tile<NDB>(Vt, vst, pa, o, r32, hi);
}

#define SB() __builtin_amdgcn_sched_barrier(0)
#define LDF(p) (*(const LAS bf16x8*)(p))
__device__ __forceinline__ float row_max32(const f32x16& p0, const f32x16& p1) {
    float ra = fmaxf(fmaxf(p0[0], p0[1]), p1[0]), rb = fmaxf(fmaxf(p0[2], p0[3]), p1[1]); ra = fmaxf(fmaxf(ra, p1[2]), p1[3]);
#pragma unroll
    for (int r = 4; r < 16; r += 4) { ra = fmaxf(fmaxf(ra, p0[r]), p0[r + 1]); rb = fmaxf(fmaxf(rb, p0[r + 2]), p0[r + 3]); ra = fmaxf(fmaxf(ra, p1[r]), p1[r + 1]); rb = fmaxf(fmaxf(rb, p1[r + 2]), p1[r + 3]); }
    return half_max(fmaxf(ra, rb));
}
__device__ __forceinline__ void da_shift(float d, f32x16& n0, f32x16& n1, f32x16 (&o)[4], float& m, float& l, LAS float* wsf, int r32, int hi) {
    m += d;
#pragma unroll
    for (int r = 0; r < 16; ++r) { n0[r] -= d; n1[r] -= d; }
    const float alpha = __builtin_amdgcn_exp2f(-d); l *= alpha;
    asm volatile("" ::: "memory");
    if (hi == 0) wsf[r32] = alpha;
    asm volatile("" ::: "memory");
    float al[16];
#pragma unroll
    for (int r = 0; r < 16; ++r) al[r] = wsf[crow(r, hi)];
#pragma unroll
    for (int blk = 0; blk < 4; ++blk)
#pragma unroll
        for (int r = 0; r < 16; ++r) o[blk][r] *= al[r];
    asm volatile("" ::: "memory");
}
__device__ __forceinline__ bf16x8 pack8(const f32x16& p, int b) { u32x4 w; w.x = cvtpk_s(p[b], p[b + 1]); w.y = cvtpk_s(p[b + 2], p[b + 3]); w.z = cvtpk_s(p[b + 4], p[b + 5]); w.w = cvtpk_s(p[b + 6], p[b + 7]); return __builtin_bit_cast(bf16x8, w); }
template <bool DOQK>
__device__ __forceinline__ void da_step(const LAS unsigned char* Kt, const LAS unsigned char* Vt, const unsigned (&swo)[4], const bf16x8 (&qr)[4], f32x16& c0, f32x16& c1, f32x16& n0, f32x16& n1, float ninit,
                                        f32x16 (&o)[4], float& l, float& rmn) {
    constexpr int VPF = 3;
    bf16x8 kf[2][2], vf[VPF + 1], pa[4];
    float psa = 0.f, psb = 0.f, one = 1.0f; asm volatile("" : "+v"(one));
    if (DOQK) { kf[0][0] = LDF(Kt + swo[0]); kf[0][1] = LDF(Kt + swo[0] + 32 * 128);
#pragma unroll
        for (int r = 0; r < 16; ++r) { n0[r] = ninit; n1[r] = ninit; } }
    SB();
#define VFA(j) (Vt + swo[(j) >> 2] + ((j) & 3) * 32 * 128)
#pragma unroll
    for (int ds = 0; ds < 4; ++ds) {
        if (DOQK && ds < 3) { kf[(ds + 1) & 1][0] = LDF(Kt + swo[ds + 1]); kf[(ds + 1) & 1][1] = LDF(Kt + swo[ds + 1] + 32 * 128); }
        if (ds + VPF >= 4) vf[ds + VPF - 4] = LDF(VFA(ds + VPF - 4));
        if (DOQK) n0 = MFMA32(kf[ds & 1][0], qr[ds], n0);
        c0[4 * ds + 0] = __builtin_amdgcn_exp2f(c0[4 * ds + 0]); c0[4 * ds + 1] = __builtin_amdgcn_exp2f(c0[4 * ds + 1]);
        if (DOQK) n1 = MFMA32(kf[ds & 1][1], qr[ds], n1);
        c0[4 * ds + 2] = __builtin_amdgcn_exp2f(c0[4 * ds + 2]); c0[4 * ds + 3] = __builtin_amdgcn_exp2f(c0[4 * ds + 3]);
        psa = __builtin_fmaf(c0[4 * ds + 0], one, psa); psb += c0[4 * ds + 1]; psa = __builtin_fmaf(c0[4 * ds + 2], one, psa); psb += c0[4 * ds + 3];
        if (ds == 1) pa[0] = pack8(c0, 0);
        if (ds == 3) pa[1] = pack8(c0, 8);
        SB();
    }
    float ra = -INFINITY;
#pragma unroll
    for (int j = 0; j < 16; ++j) {
        const int st = j >> 2, blk = j & 3;
        if (j + VPF < 16) vf[(j + VPF) % (VPF + 1)] = LDF(VFA(j + VPF));
        o[blk] = MFMA32(pa[st], vf[j % (VPF + 1)], o[blk]);
        if (st < 2) { const int e = 8 * st + 2 * blk;
            c1[e] = __builtin_amdgcn_exp2f(c1[e]); c1[e + 1] = __builtin_amdgcn_exp2f(c1[e + 1]); psa = __builtin_fmaf(c1[e], one, psa); psb += c1[e + 1];
            if (blk == 3) pa[2 + st] = pack8(c1, 8 * st);
        } else if (DOQK) {
            if (st == 2) ra = fmaxf(fmaxf(fmaxf(ra, n0[4 * blk]), fmaxf(n0[4 * blk + 1], n0[4 * blk + 2])), n0[4 * blk + 3]);
            else         ra = fmaxf(fmaxf(fmaxf(ra, n1[4 * blk]), fmaxf(n1[4 * blk + 1], n1[4 * blk + 2])), n1[4 * blk + 3]);
        }
        SB();
    }
#undef VFA
    l += psa + psb;
    if (DOQK) rmn = half_max(ra);
}
__device__ __forceinline__ void qk_tile_sw(const LAS unsigned char* Kt, const unsigned (&swo)[4], const bf16x8 (&qr)[4], f32x16& p0, f32x16& p1) {
#pragma unroll
    for (int r = 0; r < 16; ++r) { p0[r] = 0.f; p1[r] = 0.f; }
#pragma unroll
    for (int ds = 0; ds < 4; ++ds) {
        const bf16x8 a0 = LDF(Kt + swo[ds]), a1 = LDF(Kt + swo[ds] + 32 * 128);
        p0 = MFMA32(a0, qr[ds], p0); p1 = MFMA32(a1, qr[ds], p1);
    }
}

#define XB_TMO      128
#define XB_XCNT(j)  (256  + 64 * (j))
#define XB_XSUB(j)  (1280 + 64 * (j))
#define XB_XGEN(j)  (2304 + 64 * (j))
#define XB_TOP      3328
#define XB_TOPGEN   3392
#define XCD_BAR_WORDS 3456
#define XB_SPIN_CAP (1u << 18)

__device__ __forceinline__ unsigned xb_ld(unsigned* p)              { return __hip_atomic_load(p, __ATOMIC_RELAXED, __HIP_MEMORY_SCOPE_AGENT); }
__device__ __forceinline__ unsigned xb_add(unsigned* p, unsigned v) { return __hip_atomic_fetch_add(p, v, __ATOMIC_RELAXED, __HIP_MEMORY_SCOPE_AGENT); }
__device__ __forceinline__ unsigned xb_xcc_id() { return (unsigned)__builtin_amdgcn_s_getreg((3 << 11) | 20) & 0xFu; }
#define XB_SPIN(cond, bar) do { unsigned _sp = 0; while (cond) { __builtin_amdgcn_s_sleep(1); \
    if ((++_sp & 255u) == 0u) { if (xb_ld(&(bar)[XB_TMO])) break; if (_sp > XB_SPIN_CAP) { atomicAdd(&(bar)[XB_TMO], 1u); break; } } } } while (0)

struct XcdBarrier {
    unsigned* bar; unsigned x; bool w0;
    volatile LAS unsigned* st;
};

__device__ __forceinline__ XcdBarrier xcd_barrier_post(unsigned* bar, volatile LAS unsigned* st) {
    XcdBarrier b; b.bar = bar; b.x = xb_xcc_id(); b.st = st;
    if (threadIdx.x == 0) (void)xb_add(&bar[XB_XCNT(b.x)], 1u);
    return b;
}
__device__ __forceinline__ void xcd_barrier_complete(unsigned* bar, unsigned x, unsigned& nloc, unsigned& nx) {
    const unsigned G = gridDim.x * gridDim.y * gridDim.z;
    unsigned sum, cnt, mine, sp = 0u;
    for (;;) {
        sum = 0u; cnt = 0u; mine = 0u;
#pragma unroll
        for (unsigned j = 0; j < 16; ++j) { const unsigned c = xb_ld(&bar[XB_XCNT(j)]); sum += c; cnt += (c > 0u) ? 1u : 0u; mine = (j == x) ? c : mine; }
        if (sum == G) break;
        __builtin_amdgcn_s_sleep(1);
        if ((++sp & 255u) == 0u) { if (xb_ld(&bar[XB_TMO])) break; if (sp > XB_SPIN_CAP) { atomicAdd(&bar[XB_TMO], 1u); break; } }
    }
    nloc = mine > 0u ? mine : 1u; nx = cnt > 0u ? cnt : 1u;
}

__device__ __forceinline__ void xcd_barrier(const XcdBarrier& b) {
    asm volatile("s_waitcnt vmcnt(0)" ::: "memory");
    __syncthreads();
    if (b.w0 && LANE_ID() == 0) {
        unsigned* bar = b.bar;
        __builtin_amdgcn_s_waitcnt(0);
        unsigned nloc = b.st[0], nx = b.st[1];
        if (nloc == 0u) { xcd_barrier_complete(bar, b.x, nloc, nx); b.st[0] = nloc; b.st[1] = nx; }
        const unsigned old = xb_add(&bar[XB_XSUB(b.x)], 1u);
        const unsigned gen = old / nloc;
        if (old + 1u == (gen + 1u) * nloc) {
            __builtin_amdgcn_fence(__ATOMIC_RELEASE, "agent");
            asm volatile("s_waitcnt vmcnt(0)" ::: "memory");
            const unsigned og = xb_add(&bar[XB_TOP], 1u);
            const unsigned tg = og / nx;
            if (og + 1u == (tg + 1u) * nx) xb_add(&bar[XB_TOPGEN], 1u);
            else XB_SPIN(xb_ld(&bar[XB_TOPGEN]) == tg, bar);
            __builtin_amdgcn_fence(__ATOMIC_ACQUIRE, "agent");
            xb_add(&bar[XB_XGEN(b.x)], 1u);
            asm volatile("s_waitcnt vmcnt(0)" ::: "memory");
        } else {
            XB_SPIN(xb_ld(&bar[XB_XGEN(b.x)]) == gen, bar);
            __builtin_amdgcn_fence(__ATOMIC_ACQUIRE, "agent");
            asm volatile("s_waitcnt vmcnt(0)" ::: "memory");
        }
    }
    __syncthreads();
}

__global__ void __launch_bounds__(512, 2) fwd_megakernel(Params P) {
    extern __shared__ __attribute__((aligned(16))) unsigned char lds_raw[];
    LAS unsigned char* lds = (LAS unsigned char*)lds_raw;
    cg::grid_group grid = cg::this_grid();
    const int tid = threadIdx.x, lane = tid & 63, wave = __builtin_amdgcn_readfirstlane(tid >> 6);
    const int G = gridDim.x, gw = blockIdx.x * 8 + wave, NGW = G * 8;
    unsigned char* ws = P.ws;
    const float* x = P.in[0]; float* H = P.out;
    volatile LAS unsigned* bst = (volatile LAS unsigned*)(lds + 131072);
    if (tid < 2) bst[tid] = 0u;
    __syncthreads();
    XcdBarrier xbar = xcd_barrier_post((unsigned*)(ws + WS_CTL), bst); xbar.w0 = (wave == 0);
#if !defined(NO_CG_SYNC) && !defined(CG_SYNC_AT_END)
    grid.sync();
#endif
#define GRID_BAR() xcd_barrier(xbar)
    bf16_t* W_GU1 = (bf16_t*)(ws + WS_WGU1); bf16_t* W_D1 = (bf16_t*)(ws + WS_WD1); bf16_t* W_IN = (bf16_t*)(ws + WS_WIN); bf16_t* W_MKV = (bf16_t*)(ws + WS_WMKV);
    bf16_t* W_OUT = (bf16_t*)(ws + WS_WOUT); bf16_t* W_GU2 = (bf16_t*)(ws + WS_WGU2); bf16_t* W_D2 = (bf16_t*)(ws + WS_WD2);
    float* ROPEC = (float*)(ws + WS_ROPE); float* ROPES = ROPEC + SEQ * 32; float* SSQ = (float*)(ws + WS_SSQ); float* RN1 = SSQ; float* RN2 = SSQ + MTOK;
    bf16_t* MEMN = (bf16_t*)(ws + WS_MEMN); bf16_t* MK = (bf16_t*)(ws + WS_MK); bf16_t* MVT = (bf16_t*)(ws + WS_MVT);
    bf16_t* AB = (bf16_t*)(ws + WS_AB); bf16_t* ACT = (bf16_t*)(ws + WS_ACT); bf16_t* MIXED = (bf16_t*)(ws + WS_MIXED);
    bf16_t* Qb = (bf16_t*)(ws + WS_Q); bf16_t* Kb = (bf16_t*)(ws + WS_K); bf16_t* VT = (bf16_t*)(ws + WS_VT); bf16_t* Gb = (bf16_t*)(ws + WS_G); bf16_t* MQ = (bf16_t*)(ws + WS_MQ);

#ifndef P0_REPS
#define P0_REPS 1
#endif
    {
        LAS float* scr = (LAS float*)(lds + wave * 16384);
        constexpr int I_GU = (5632 / 32) * (DM / 64), I_D = DEFER_W ? 0 : (DM / 32) * (DFF / 64), I_IN = (INW / 32) * (DM / 64), I_MKV = (512 / 32) * (DM / 64);
        constexpr int NITEMS = I_GU + I_D + I_IN + I_MKV;
        for (int it = gw; it < NITEMS * P0_REPS; it += NGW) {
            int r = it % NITEMS;
            if (r < I_GU) {
                const int kb = r % (DM / 64), pb = r / (DM / 64), p0 = pb * 32, pn = p0 >> 8, bj = (p0 >> 7) & 1, j0 = p0 & 127;
                transpose_item(bj ? P.in[4] : P.in[3], DFF, 128 * pn + j0, nullptr, W_GU1, DM, p0, kb * 64, scr, lane); continue; }
            r -= I_GU;
            if (r < I_D) { const int kb = r % (DFF / 64), pb = r / (DFF / 64);
                transpose_item(P.in[5], DM, pb * 32, nullptr, W_D1, DFF, pb * 32, kb * 64, scr, lane); continue; }
            r -= I_D;
            if (r < I_IN) { const int kb = r % (DM / 64), pb = r / (DM / 64);
                transpose_item(P.in[8], INW, in_src_col(pb * 32), P.in[6], W_IN, DM, pb * 32, kb * 64, scr, lane); continue; }
            r -= I_IN;
            { const int kb = r % (DM / 64), pb = r / (DM / 64);
                transpose_item(P.in[18], 512, pb * 32, nullptr, W_MKV, DM, pb * 32, kb * 64, scr, lane); }
        }
#if !DEFER_W
        { constexpr int I_OUT = (DM / 32) * (DM / 64);
          for (int it = gw; it < I_GU + I_D + I_OUT; it += NGW) { int r = it;
            if (r < I_GU) { const int kb = r % (DM / 64), pb = r / (DM / 64), p0 = pb * 32, pn = p0 >> 8, bj = (p0 >> 7) & 1, j0 = p0 & 127;
                transpose_item(bj ? P.in[22] : P.in[21], DFF, 128 * pn + j0, P.in[20], W_GU2, DM, p0, kb * 64, scr, lane); continue; }
            r -= I_GU;
            if (r < I_D) { const int kb = r % (DFF / 64), pb = r / (DFF / 64);
                transpose_item(P.in[23], DM, pb * 32, nullptr, W_D2, DFF, pb * 32, kb * 64, scr, lane); continue; }
            r -= I_D;
            { const int kb = r % (DM / 64), pb = r / (DM / 64);
                transpose_item(P.in[19], DM, pb * 32, nullptr, W_OUT, DM, pb * 32, kb * 64, scr, lane); } } }
#endif
        for (int m_ = gw; m_ < MTOK * P0_REPS; m_ += NGW) { const int m = m_ & (MTOK - 1); rms_row_to_bf16(x + (size_t)m * DM, P.in[2], AB + (size_t)m * DM, lane); }
        for (int m = gw; m < NB * NMEM; m += NGW) rms_row_to_bf16(P.in[1] + (size_t)m * DM, P.in[7], MEMN + (size_t)m * DM, lane);
        { float* SM = (float*)(ws + WS_SMALL);
          for (int e = blockIdx.x * 512 + tid; e < SM_END; e += G * 512) {
            float v;
            if (e < 64) v = P.in[9][e]; else if (e < 128) v = P.in[10][e - 64]; else if (e < 192) v = P.in[11][e - 128]; else if (e < SM_SUBLN) v = P.in[12][e - 192];
            else if (e < SM_DWW) v = P.in[13][e - SM_SUBLN];
            else if (e < SM_DWB) v = P.in[14][e - SM_DWW];
            else if (e < SM_LNG) v = P.in[15][e - SM_DWB];
            else if (e < SM_LNB) v = P.in[16][e - SM_LNG];
            else if (e < SM_FNG) v = P.in[17][e - SM_LNB];
            else v = P.in[24][e - SM_FNG];
            SM[e] = v; } }
        for (int e = blockIdx.x * 512 + tid; e < SEQ * 32; e += G * 512) {
            const int pos = e >> 5, i = e & 31;
            const float invf = (float)exp2(-(double)(2 * i) / 64.0 * 13.287712379549449);
            const float ang = (float)pos * invf;
            const double xd = (double)ang, kd = rint(xd * 0.63661977236758134), rr = fma(-kd, 1.5707963267948966, xd) - kd * 6.123233995736766e-17, r2 = rr * rr;
            const double sn = rr * (1.0 + r2 * (-1.0 / 6 + r2 * (1.0 / 120 + r2 * (-1.0 / 5040 + r2 * (1.0 / 362880 + r2 * (-1.0 / 39916800 + r2 * (1.0 / 6227020800.0)))))));
            const double cs = 1.0 + r2 * (-0.5 + r2 * (1.0 / 24 + r2 * (-1.0 / 720 + r2 * (1.0 / 40320 + r2 * (-1.0 / 3628800 + r2 * (1.0 / 479001600.0 + r2 * (-1.0 / 87178291200.0)))))));
            const int qd = ((int)kd) & 3;
            const double sv = (qd == 0) ? sn : (qd == 1) ? cs : (qd == 2) ? -sn : -cs;
            const double cv = (qd == 0) ? cs : (qd == 1) ? -sn : (qd == 2) ? -cs : sn;
            ROPEC[e] = (float)cv; ROPES[e] = (float)sv;
        }
    }
    GRID_BAR();
#ifndef NO_P1
    { pg8::Gemm g{AB, W_GU1, MTOK, 2 * DFF, DM}; pg8::StaticOrder S; S.init(MTOK, 2 * DFF, G, (int)blockIdx.x); EpiSwiGLU E{ACT, nullptr};
      pg8::gemm_phase<EpiSwiGLU, pg8::StaticOrder, true, true>(lds, g, S, E, wave);
#ifdef P1_TWICE
      pg8::gemm_phase<EpiSwiGLU, pg8::StaticOrder, true, true>(lds, g, S, E, wave);
#endif
    }
#if DEFER_W
    if ((int)blockIdx.x >= G / 2) {
        int lane_t = LANE_ID(); asm volatile("" : "+v"(lane_t)); const int lane = lane_t;
        LAS float* scr = (LAS float*)(lds + wave * 16384);
        constexpr int I_D1 = (DM / 32) * (DFF / 64);
        for (int r = ((int)blockIdx.x - G / 2) * 8 + wave; r < I_D1; r += (G - G / 2) * 8) {
            const int kb = r % (DFF / 64), pb = r / (DFF / 64);
            transpose_item(P.in[5], DM, pb * 32, nullptr, W_D1, DFF, pb * 32, kb * 64, scr, lane); }
    }
#endif
#endif
    GRID_BAR();
#ifdef SYNC_EXTRA
    for (int i = 0; i < SYNC_EXTRA; ++i) GRID_BAR();
#endif
#ifndef NO_P2
    { pg8::Gemm g{ACT, W_D1, MTOK, DM, DFF}; pg8::StaticOrder S; S.init(MTOK, DM, G, (int)blockIdx.x);
      EpiExch<true> E{x, nullptr, nullptr, 0.5f, nullptr, nullptr, AB, RN1, (float*)(ws + WS_XBUF), (unsigned*)(ws + WS_CTL + CTL_CNT)};
      pg8::gemm_phase<EpiExch<true>, pg8::StaticOrder, false, true>(lds, g, S, E, wave);
    }
#endif
    GRID_BAR();
#ifndef NO_P3
    { pg8::Gemm g{AB, W_IN, MTOK, INW, DM}; pg8::StaticOrder S; S.init(MTOK, INW, G, (int)blockIdx.x); EpiInProj E{nullptr, ROPEC, ROPES, Qb, Kb, VT, Gb, MQ};
      pg8::gemm_phase<EpiInProj, pg8::StaticOrder, true, true>(lds, g, S, E, wave);
#ifdef P3_TWICE
      pg8::gemm_phase<EpiInProj, pg8::StaticOrder, true, true>(lds, g, S, E, wave);
#endif
      pg8::Gemm g2{MEMN, W_MKV, NB * NMEM, 512, DM}; pg8::StaticOrder S2; S2.init(NB * NMEM, 512, G, ((int)blockIdx.x >= G - 4) ? (int)blockIdx.x - (G - 4) : 1 << 20); EpiMemKV E2{MK, MVT};
      pg8::gemm_phase<EpiMemKV, pg8::StaticOrder, true, true>(lds, g2, S2, E2, wave); }
#if DEFER_W
    if ((int)blockIdx.x >= G / 4 && (int)blockIdx.x < G - 4) {
        int lane_t = LANE_ID(); asm volatile("" : "+v"(lane_t)); const int lane = lane_t;
        LAS float* scr = (LAS float*)(lds + wave * 16384);
        constexpr int I_D = (DM / 32) * (DFF / 64), I_OUT = (DM / 32) * (DM / 64), I_GUH = (5632 / 32) * (DM / 64);
        for (int r0 = ((int)blockIdx.x - G / 4) * 8 + wave; r0 < I_D + I_OUT + I_GUH; r0 += (G - 4 - G / 4) * 8) {
            int r = r0;
            if (r < I_GUH) {
                const int kb = r % (DM / 64), pb = r / (DM / 64), p0 = pb * 32, pn = p0 >> 8, bj = (p0 >> 7) & 1, j0 = p0 & 127;
                transpose_item(bj ? P.in[22] : P.in[21], DFF, 128 * pn + j0, P.in[20], W_GU2, DM, p0, kb * 64, scr, lane); continue; }
            r -= I_GUH;
            if (r < I_OUT) { const int kb = r % (DM / 64), pb = r / (DM / 64);
                transpose_item(P.in[19], DM, pb * 32, nullptr, W_OUT, DM, pb * 32, kb * 64, scr, lane); continue; }
            r -= I_OUT;
            { const int kb = r % (DFF / 64), pb = r / (DFF / 64);
                transpose_item(P.in[23], DM, pb * 32, nullptr, W_D2, DFF, pb * 32, kb * 64, scr, lane); }
        }
    }
#endif
#endif
    GRID_BAR();
#ifndef NO_P4
    {
        const float* SM = (const float*)(ws + WS_SMALL);
#define LAM_COMPUTE(lamv) do { const int ll_ = LANE_ID(); const float a_ = SM[ll_] * SM[64 + ll_], b_ = SM[128 + ll_] * SM[192 + ll_]; lamv = __expf(wave_sum(a_)) - __expf(wave_sum(b_)) + 0.2f; } while (0)
#ifdef NAIVE_ATT
        float lam; LAM_COMPUTE(lam);
        {
            const int qi = lane >> 2, dq = lane & 3;
            for (int item = gw, rnd = 0; item < 4096; item += NGW, ++rnd) {
                const int bh = item & 7, rest = item >> 3, qsub = rest & 3; int ch = rest >> 2; if ((rnd & 1) && NGW == 2048) ch = 191 - ch;
                const int b = bh >> 2, h = bh & 3, row = b * SEQ + ch * 64 + qsub * 16 + qi, nkeys = (ch + 1) * 64;
                float o1[32], o2[32];
                naive_stream<32>(Qb + (size_t)row * 512 + h * 128, Kb + (size_t)b * SEQ * 512 + h * 128, 512, VT + ((size_t)(bh) * 128 + dq * 32) * SEQ, SEQ, nkeys, o1);
                naive_stream<32>(Qb + (size_t)row * 512 + h * 128 + 64, Kb + (size_t)b * SEQ * 512 + h * 128 + 64, 512, VT + ((size_t)(bh) * 128 + dq * 32) * SEQ, SEQ, nkeys, o2);
                float ss = 0.f;
#pragma unroll
                for (int j = 0; j < 32; ++j) { o1[j] -= lam * o2[j]; ss += o1[j] * o1[j]; }
                ss += sxor<1>(ss); ss += sxor<2>(ss);
                const float rs = 0.8f / sqrtf(ss * (1.0f / 128) + EPS);
                bf16_t* dst = MIXED + (size_t)row * DM + h * 128 + dq * 32;
#pragma unroll
                for (int j = 0; j < 32; j += 8) { u32x4 w;
                    w.x = pk2(o1[j] * rs * SM[SM_SUBLN + dq * 32 + j], o1[j + 1] * rs * SM[SM_SUBLN + dq * 32 + j + 1]); w.y = pk2(o1[j + 2] * rs * SM[SM_SUBLN + dq * 32 + j + 2], o1[j + 3] * rs * SM[SM_SUBLN + dq * 32 + j + 3]);
                    w.z = pk2(o1[j + 4] * rs * SM[SM_SUBLN + dq * 32 + j + 4], o1[j + 5] * rs * SM[SM_SUBLN + dq * 32 + j + 5]); w.w = pk2(o1[j + 6] * rs * SM[SM_SUBLN + dq * 32 + j + 6], o1[j + 7] * rs * SM[SM_SUBLN + dq * 32 + j + 7]);
                    *(u32x4*)(dst + j) = w; }
            }
        }
        {
            const int qi = lane >> 2, dq = lane & 3;
            for (int item = gw; item < MTOK / 16 * 4; item += NGW) {
                const int hm = item & 3, rb = item >> 2, row = rb * 16 + qi, b = row >> 13;
                float o[16];
                naive_stream<16>(MQ + (size_t)row * 256 + hm * 64, MK + (size_t)b * NMEM * 256 + hm * 64, 256, MVT + ((size_t)(b * 4 + hm) * 64 + dq * 16) * NMEM, NMEM, NMEM, o);
                bf16_t* dst = MIXED + (size_t)row * DM + 768 + hm * 64 + dq * 16;
                u32x4 w; w.x = pk2(o[0], o[1]); w.y = pk2(o[2], o[3]); w.z = pk2(o[4], o[5]); w.w = pk2(o[6], o[7]); *(u32x4*)dst = w;
                w.x = pk2(o[8], o[9]); w.y = pk2(o[10], o[11]); w.z = pk2(o[12], o[13]); w.w = pk2(o[14], o[15]); *(u32x4*)(dst + 8) = w;
            }
        }
#else
        {
            int lane_d = LANE_ID(); asm volatile("" : "+v"(lane_d)); const int lane = lane_d;
            const int r32 = lane & 31, hi = lane >> 5, c = wave >> 2, wq = wave & 3;
            LAS float* wsf = (LAS float*)(lds + DA_WSF) + wave * 32;
            unsigned swo[4];
            { const int sw = (r32 >> 1) & 7;
#pragma unroll
              for (int x = 0; x < 4; ++x) swo[x] = (unsigned)(r32 * 128 + (((2 * x + hi) ^ sw) << 4)); }
            const int rin = 8 * wave + (lane >> 3), lc = (lane & 7) ^ ((rin >> 1) & 7);
            const unsigned kvoff = (unsigned)((rin * 512 + lc * 8) * 2), vvoff = (unsigned)((rin * SEQ + lc * 8) * 2);
            const unsigned qoff = (unsigned)(((wq * 32 + r32) * 512 + c * 64 + hi * 8) * 2);
            const unsigned ldsb = (unsigned)(size_t)lds_raw + (unsigned)wave * 1024u;
#ifndef DA_REPS
#define DA_REPS 1
#endif
            for (int pair_ = blockIdx.x; pair_ < 256 * DA_REPS; pair_ += G)
            for (int half = 0; half < 2; ++half) {
                const int pair = pair_ & 255, bh = pair & 7, sidx = pair >> 3, qb = half ? 63 - sidx : sidx, b = bh >> 2, h = bh & 3;
                const int q0 = qb * 128, NT = 2 * qb + 2;
                const char* kbase = (const char*)(Kb + (size_t)b * SEQ * 512 + h * 128);
                const char* vbase = (const char*)(VT + (size_t)bh * 128 * SEQ);
#define DA_GLDS(voff, sbase, dst, imm) do { unsigned keep_; const char* ga_ = (sbase) + (voff); asm volatile("s_mov_b32 %0, m0\n\ts_mov_b32 m0, %2\n\ts_nop 0\n\tglobal_load_lds_dwordx4 %1, off\n\ts_mov_b32 m0, %0" \
                    : "=&s"(keep_) : "v"(ga_), "s"(dst) : "memory"); } while (0)
#define DA_DMA_K(tt, sl) do { const int tt_ = (tt) < NT ? (tt) : NT - 1; const char* kb_ = kbase + (size_t)tt_ * (64 * 512 * 2); const unsigned d_ = (unsigned)__builtin_amdgcn_readfirstlane(ldsb + (sl) * DA_KSLOT); \
                    DA_GLDS(kvoff, kb_, d_, 0); const unsigned d2_ = d_ + 8192u; const char* kb2_ = kb_ + 128; DA_GLDS(kvoff, kb2_, d2_, 0); } while (0)
#define DA_DMA_V(tt, sl) do { const int tt_ = (tt) < NT ? (tt) : NT - 1; const char* vb_ = vbase + (size_t)tt_ * 128; const char* vb2_ = vb_ + (size_t)64 * SEQ * 2; const unsigned d_ = (unsigned)__builtin_amdgcn_readfirstlane(ldsb + DA_V0 + (sl) * DA_VSLOT); \
                    DA_GLDS(vvoff, vb_, d_, 0); const unsigned d2_ = d_ + 8192u; DA_GLDS(vvoff, vb2_, d2_, 0); } while (0)
#define DA_BAR(N) asm volatile("s_waitcnt vmcnt(" #N ") lgkmcnt(0)\n\ts_barrier" ::: "memory")
#define DA_KB(t) (lds + ((t) % 3) * DA_KSLOT + c * 8192)
#define DA_VB(t) (lds + DA_V0 + ((t) % 3) * DA_VSLOT)
#define DA_SHIFTCHK(N0, N1) do { if (__any(rmn > 8.0f)) da_shift((rmn > 8.0f) ? rmn : 0.f, N0, N1, o, m, l, wsf, r32, hi); } while (0)
                DA_DMA_K(0, 0); DA_DMA_V(0, 0); DA_DMA_K(1, 1);
                bf16x8 qr[4];
                { const char* qbase = (const char*)(Qb + ((size_t)(b * SEQ + q0)) * 512 + h * 128);
                  asm volatile("global_load_dwordx4 %0, %4, %5 offset:0\n\tglobal_load_dwordx4 %1, %4, %5 offset:32\n\tglobal_load_dwordx4 %2, %4, %5 offset:64\n\tglobal_load_dwordx4 %3, %4, %5 offset:96"
                               : "=&v"(qr[0]), "=&v"(qr[1]), "=&v"(qr[2]), "=&v"(qr[3]) : "v"(qoff), "s"(qbase) : "memory"); }
                f32x16 o[4];
#pragma unroll
                for (int blk = 0; blk < 4; ++blk)
#pragma unroll
                    for (int r = 0; r < 16; ++r) o[blk][r] = 0.f;
                float m = 0.f, l = 0.f;
                DA_BAR(0);
                DA_DMA_K(2, 2); DA_DMA_V(1, 1);
                f32x16 pA0, pA1, pB0, pB1; float rmn;
                qk_tile_sw(DA_KB(0), swo, qr, pA0, pA1);
                { const float rm0 = row_max32(pA0, pA1); m = rm0;
#pragma unroll
                  for (int r = 0; r < 16; ++r) { pA0[r] -= rm0; pA1[r] -= rm0; } }
                DA_BAR(4);
                const bool masklast = (wq < 2);
                int t = 0;
                for (; t + 2 < NT; t += 2) {
                    DA_DMA_K(t + 3, t % 3); DA_DMA_V(t + 2, (t + 2) % 3);
                    da_step<true>(DA_KB(t + 1), DA_VB(t), swo, qr, pA0, pA1, pB0, pB1, -m, o, l, rmn); DA_SHIFTCHK(pB0, pB1);
                    DA_BAR(4);
                    DA_DMA_K(t + 4, (t + 1) % 3); DA_DMA_V(t + 3, (t + 3) % 3);
                    da_step<true>(DA_KB(t + 2), DA_VB(t + 1), swo, qr, pB0, pB1, pA0, pA1, -m, o, l, rmn); DA_SHIFTCHK(pA0, pA1);
                    DA_BAR(4);
                }
                DA_DMA_K(t + 3, t % 3); DA_DMA_V(t + 2, (t + 2) % 3);
                da_step<true>(DA_KB(t + 1), DA_VB(t), swo, qr, pA0, pA1, pB0, pB1, masklast ? -INFINITY : -m, o, l, rmn); DA_SHIFTCHK(pB0, pB1);
                DA_BAR(4);
                da_step<false>(DA_KB(t), DA_VB(t + 1), swo, qr, pB0, pB1, pA0, pA1, 0.f, o, l, rmn);
                DA_BAR(0);
#undef DA_GLDS
#undef DA_DMA_K
#undef DA_DMA_V
#undef DA_BAR
#undef DA_KB
#undef DA_VB
#undef DA_SHIFTCHK
                int r32f = r32, lanef = lane; asm volatile("" : "+v"(r32f), "+v"(lanef));
                { float inv = 1.0f / half_sum(l); if (c) { float lam; LAM_COMPUTE(lam); inv *= lam; }
                  asm volatile("" ::: "memory");
                  if (hi == 0) wsf[r32] = inv;
                  asm volatile("" ::: "memory");
                  float sc[16];
#pragma unroll
                  for (int r = 0; r < 16; ++r) sc[r] = wsf[crow(r, hi)];
#pragma unroll
                  for (int blk = 0; blk < 4; ++blk)
#pragma unroll
                      for (int r = 0; r < 16; ++r) o[blk][r] *= sc[r]; }
                LAS float* cb = (LAS float*)lds + wq * 4096 + lanef;
                if (c) {
#pragma unroll
                    for (int blk = 0; blk < 4; ++blk)
#pragma unroll
                        for (int r = 0; r < 16; ++r) cb[(blk * 16 + r) * 64] = o[blk][r];
                }
                __syncthreads();
                if (!c) {
                    float ss[16];
#pragma unroll
                    for (int r = 0; r < 16; ++r) ss[r] = 0.f;
#pragma unroll
                    for (int blk = 0; blk < 4; ++blk)
#pragma unroll
                        for (int r = 0; r < 16; ++r) { o[blk][r] -= cb[(blk * 16 + r) * 64]; ss[r] += o[blk][r] * o[blk][r]; }
#pragma unroll
                    for (int r = 0; r < 16; ++r) {
                        ss[r] += sxor<1>(ss[r]); ss[r] += sxor<2>(ss[r]); ss[r] += sxor<4>(ss[r]); ss[r] += sxor<8>(ss[r]); ss[r] += sxor<16>(ss[r]);
                        ss[r] = 0.8f / sqrtf(ss[r] * (1.0f / 128) + EPS); }
                    unsigned voffm = (unsigned)((4 * hi * DM + r32f) * 2); asm volatile("" : "+v"(voffm));
                    const char* mbase = (const char*)(MIXED + ((size_t)(b * SEQ + q0 + wq * 32)) * DM + h * 128);
#pragma unroll
                    for (int blk = 0; blk < 4; ++blk) { const float gsub = SM[SM_SUBLN + blk * 32 + r32f];
#pragma unroll
                        for (int r = 0; r < 16; ++r) *(bf16_t*)(mbase + (size_t)(((r & 3) + 8 * (r >> 2)) * DM + blk * 32) * 2 + voffm) = (bf16_t)f2bf(o[blk][r] * ss[r] * gsub); }
                }
                __syncthreads();
            }
        }
        {
            int tidm = wave * 64 + LANE_ID(); asm volatile("" : "+v"(tidm));
            const int tid = tidm, lane = tid & 63, r32 = lane & 31, hi = lane >> 5;
            LAS float* wsf = (LAS float*)(lds + DA_WSF) + wave * 32;
#ifndef MEM_REPS
#define MEM_REPS 1
#endif
            for (int u_ = blockIdx.x; u_ < 256 * MEM_REPS; u_ += G) {
                const int u = u_ & 255, hm = u & 3, b = (u >> 2) & 1, qb = u >> 3;
#pragma unroll
                for (int i = 0; i < 4; ++i) { const int idx = tid + 512 * i;
                    { const int row = idx >> 3, ch = idx & 7; *(LAS u32x4*)(lds + row * KST + ch * 16) = *(const u32x4*)(MK + ((size_t)(b * NMEM + row)) * 256 + hm * 64 + ch * 8); }
                    { const int d = idx >> 5, ch = idx & 31; *(LAS u32x4*)(lds + MA_VT + d * MA_VST + ch * 16) = *(const u32x4*)(MVT + ((size_t)((b * 4 + hm) * 64 + d)) * NMEM + ch * 8); } }
                const int row0 = b * SEQ + qb * 256 + wave * 32;
                bf16x8 qr[4];
                { const bf16_t* qp = MQ + ((size_t)(row0 + r32)) * 256 + hm * 64 + hi * 8;
#pragma unroll
                  for (int ds = 0; ds < 4; ++ds) qr[ds] = *(const bf16x8*)(qp + ds * 16); }
                f32x16 o[2];
#pragma unroll
                for (int blk = 0; blk < 2; ++blk)
#pragma unroll
                    for (int r = 0; r < 16; ++r) o[blk][r] = 0.f;
                float m = -INFINITY, l = 0.f;
                __syncthreads();
                for (int t = 0; t < 4; ++t) attn_tile<2>(lds + t * 64 * KST, KST, lds + MA_VT + t * 128, MA_VST, qr, o, m, l, wsf, r32, hi);
                { const float inv = 1.0f / half_sum(l);
                  asm volatile("" ::: "memory");
                  if (hi == 0) wsf[r32] = inv;
                  asm volatile("" ::: "memory");
                  unsigned voffm = (unsigned)((4 * hi * DM + r32) * 2); asm volatile("" : "+v"(voffm));
                  const char* mbase = (const char*)(MIXED + (size_t)row0 * DM + 768 + hm * 64);
#pragma unroll
                  for (int r = 0; r < 16; ++r) { const float sc = wsf[crow(r, hi)]; const char* rb = mbase + (size_t)(((r & 3) + 8 * (r >> 2)) * DM) * 2;
                      *(bf16_t*)(rb + voffm) = (bf16_t)f2bf(o[0][r] * sc); *(bf16_t*)(rb + 64 + voffm) = (bf16_t)f2bf(o[1][r] * sc); } }
                __syncthreads();
            }
        }
#endif
        {
            int tidc = wave * 64 + LANE_ID(); asm volatile("" : "+v"(tidc));
            const int tid = tidc, lane = tid & 63;
            bf16_t* Gs = (bf16_t*)lds_raw;
            float* Y = (float*)(lds_raw + 49152);
            const float* dw_w = SM + SM_DWW; const float* dw_b = SM + SM_DWB; const float* ln_g = SM + SM_LNG; const float* ln_b = SM + SM_LNB;
            #ifndef CONV_REPS
#define CONV_REPS 1
#endif
            for (int unit_ = blockIdx.x; unit_ < MTOK / 64 * CONV_REPS; unit_ += G) {
                const int unit = unit_ & (MTOK / 64 - 1), t0 = unit * 64, bstart = t0 & ~(SEQ - 1);
                __syncthreads();
                { u32x4 gv[6];
#pragma unroll
                  for (int k = 0; k < 6; ++k) { const int c = tid + 512 * k, r = c >> 5, cc = c & 31, t = t0 - 30 + r;
                      gv[k] = (u32x4){0u, 0u, 0u, 0u}; if (c < 94 * 32 && t >= bstart) gv[k] = *(const u32x4*)(Gb + (size_t)t * 256 + cc * 8); }
#pragma unroll
                  for (int k = 0; k < 6; ++k) { const int c = tid + 512 * k, r = c >> 5, cc = c & 31; if (c < 94 * 32) *(u32x4*)(Gs + r * 256 + cc * 8) = gv[k]; } }
                __syncthreads();
                { const int cp = tid & 127, tq = tid >> 7; float w0[31], w1[31];
#pragma unroll
                    for (int j = 0; j < 31; ++j) { w0[j] = dw_w[j * 256 + 2 * cp]; w1[j] = dw_w[j * 256 + 2 * cp + 1]; }
                    const float bias0 = dw_b[2 * cp], bias1 = dw_b[2 * cp + 1];
                    const unsigned* Gs32 = (const unsigned*)Gs;
                    for (int tt = 0; tt < 16; ++tt) { const int t = tq * 16 + tt; float a0 = bias0, a1 = bias1;
#pragma unroll
                        for (int j = 0; j < 31; ++j) { const unsigned g2 = Gs32[(t + j) * 128 + cp];
                            a0 += __builtin_bit_cast(float, g2 << 16) * w0[j]; a1 += __builtin_bit_cast(float, g2 & 0xffff0000u) * w1[j]; }
                        *(f32x2_t*)(Y + t * 256 + 2 * cp) = (f32x2_t){a0, a1}; } }
                __syncthreads();
                { f32x4 v[8]; float sm[8], sq[8];
#pragma unroll
                  for (int tt = 0; tt < 8; ++tt) { v[tt] = *(const f32x4*)(Y + (wave * 8 + tt) * 256 + lane * 4); sm[tt] = (v[tt].x + v[tt].y) + (v[tt].z + v[tt].w); }
#define RED8(a) do { _Pragma("unroll") for (int tt = 0; tt < 8; ++tt) a[tt] += sxor<1>(a[tt]); _Pragma("unroll") for (int tt = 0; tt < 8; ++tt) a[tt] += sxor<2>(a[tt]); \
                     _Pragma("unroll") for (int tt = 0; tt < 8; ++tt) a[tt] += sxor<4>(a[tt]); _Pragma("unroll") for (int tt = 0; tt < 8; ++tt) a[tt] += sxor<8>(a[tt]); \
                     _Pragma("unroll") for (int tt = 0; tt < 8; ++tt) a[tt] += sxor<16>(a[tt]); _Pragma("unroll") for (int tt = 0; tt < 8; ++tt) a[tt] = hsum32(a[tt]); } while (0)
                  RED8(sm);
#pragma unroll
                  for (int tt = 0; tt < 8; ++tt) { v[tt] = v[tt] - sm[tt] * (1.0f / 256); sq[tt] = (v[tt].x * v[tt].x + v[tt].y * v[tt].y) + (v[tt].z * v[tt].z + v[tt].w * v[tt].w); }
                  RED8(sq);
#undef RED8
                  const f32x4 gg = *(const f32x4*)(ln_g + lane * 4), bb = *(const f32x4*)(ln_b + lane * 4);
#pragma unroll
                  for (int tt = 0; tt < 8; ++tt) { const float rstd = 1.0f / sqrtf(sq[tt] * (1.0f / 256) + EPS);
                      const f32x4 y = v[tt] * rstd * gg + bb;
                      u32x2 wv; wv.x = pk2(silu_f(y.x), silu_f(y.y)); wv.y = pk2(silu_f(y.z), silu_f(y.w));
                      *(u32x2*)(MIXED + (size_t)(t0 + wave * 8 + tt) * DM + 512 + lane * 4) = wv; } }
            }
            __syncthreads();
        }
    }
#endif
    GRID_BAR();
#ifndef NO_P5
    { pg8::Gemm g{MIXED, W_OUT, MTOK, DM, DM}; pg8::StaticOrder S; S.init(MTOK, DM, G, (int)blockIdx.x);
      EpiExch<false> E{nullptr, AB, RN1, 1.0f, nullptr, nullptr, AB, RN2, (float*)(ws + WS_XBUF) + (size_t)MTOK * 4, (unsigned*)(ws + WS_CTL + CTL_CNT) + CTL_BANK};
      pg8::gemm_phase<EpiExch<false>, pg8::StaticOrder, false, true>(lds, g, S, E, wave); }
#endif
    GRID_BAR();
#ifndef NO_P6
    { pg8::Gemm g{AB, W_GU2, MTOK, 2 * DFF, DM}; pg8::StaticOrder S; S.init(MTOK, 2 * DFF, G, (int)blockIdx.x); EpiSwiGLU E{ACT, nullptr};
      pg8::gemm_phase<EpiSwiGLU, pg8::StaticOrder, true, true>(lds, g, S, E, wave);
#ifdef P6_TWICE
      pg8::gemm_phase<EpiSwiGLU, pg8::StaticOrder, true, true>(lds, g, S, E, wave);
#endif
    }
#endif
    GRID_BAR();
#ifndef NO_P7
    { pg8::Gemm g{ACT, W_D2, MTOK, DM, DFF}; pg8::StaticOrder S; S.init(MTOK, DM, G, (int)blockIdx.x);
      EpiExch<false> E{nullptr, AB, RN2, 0.5f, H, (const float*)(ws + WS_SMALL) + SM_FNG, nullptr, nullptr, (float*)(ws + WS_XBUF) + (size_t)MTOK * 8, (unsigned*)(ws + WS_CTL + CTL_CNT) + 2 * CTL_BANK};
      pg8::gemm_phase<EpiExch<false>, pg8::StaticOrder, false, true>(lds, g, S, E, wave); }
#endif
#if defined(CG_SYNC_AT_END)
    grid.sync();
#endif
}

extern "C" void kernel_launch(void* const* d_in, const int* in_sizes, int n_in, void* d_out, int out_size, void* d_ws, size_t ws_size, hipStream_t stream) {
    static int grid_blocks = 0;
    if (grid_blocks == 0) {
        if (n_in != 25 || ws_size < WS_END) { fprintf(stderr, "kernel_launch: unexpected inputs (n_in %d, ws %zu)\n", n_in, ws_size); grid_blocks = -1; return; }
        int dev = 0, cus = 0, per_cu = 0;
        hipGetDevice(&dev); hipDeviceGetAttribute(&cus, hipDeviceAttributeMultiprocessorCount, dev);
        if (hipFuncSetAttribute((const void*)fwd_megakernel, hipFuncAttributeMaxDynamicSharedMemorySize, LDS_BYTES) != hipSuccess) fprintf(stderr, "kernel_launch: hipFuncSetAttribute failed\n");
        if (hipOccupancyMaxActiveBlocksPerMultiprocessor(&per_cu, (const void*)fwd_megakernel, 512, LDS_BYTES) != hipSuccess || per_cu < 1) { fprintf(stderr, "kernel_launch: occupancy query failed (%d)\n", per_cu); per_cu = 1; }
        (void)hipGetLastError();
        grid_blocks = cus * 1;
        if (grid_blocks != 256) { fprintf(stderr, "kernel_launch: built for a 256-CU device (one 256x256 unit per workgroup in the fused final phase), found %d CUs; nothing launched\n", cus); grid_blocks = -1; return; }
        fprintf(stderr, "kernel_launch: cus %d per_cu %d grid %d\n", cus, per_cu, grid_blocks);
    }
    if (grid_blocks < 0) return;
    if (hipMemsetAsync((char*)d_ws + WS_CTL, 0, CTL_BYTES, stream) != hipSuccess) { fprintf(stderr, "kernel_launch: memset failed\n"); return; }
    Params p{};
    for (int i = 0; i < 25; ++i) p.in[i] = (const float*)d_in[i];
    p.out = (float*)d_out; p.ws = (unsigned char*)d_ws;
    void* args[] = {&p};
    hipError_t e = hipLaunchCooperativeKernel((const void*)fwd_megakernel, dim3(grid_blocks), dim3(512), args, LDS_BYTES, stream);
    if (e != hipSuccess) fprintf(stderr, "cooperative launch failed: %s (grid %d)\n", hipGetErrorString(e), grid_blocks);
}
```

```cpp
#include <hip/hip_runtime.h>
#include <hip/hip_cooperative_groups.h>
#include <cstdio>
#include <cstdint>
namespace cg = cooperative_groups;
namespace pg8 {
#define PG8_LAS __attribute__((address_space(3)))
typedef unsigned short bf16_t;
typedef short bf16x8 __attribute__((ext_vector_type(8)));
typedef float f32x4 __attribute__((ext_vector_type(4)));
typedef unsigned u32x4 __attribute__((ext_vector_type(4)));
constexpr int BM = 256, BK = 64, HALF = 128, HTB = HALF * BK * 2  , STAGE_BYTES = 8 * HTB, NXCD = 8, WGM = 8;

__host__ __device__ __forceinline__ int lds_byte(int r, int c) { const int st = (r >> 4) * 2 + (c >> 5), rr = r & 15, cc = c & 31, ob = rr * 64 + cc * 2; return st * 1024 + (ob ^ (((ob >> 9) & 1) << 5)); }
__host__ __device__ __forceinline__ void stage_rc(int b, int& R, int& C) { const int st = b / 1024, sb = b % 1024, swz = sb ^ (((sb >> 9) & 1) << 5); R = (st >> 1) * 16 + swz / 64; C = (st & 1) * 32 + (swz % 64) / 2; }
__host__ __device__ __forceinline__ int perm32(int rho) { const int n = rho >> 4, i = rho & 15; return 8 * (i >> 2) + 4 * n + (i & 3); }

struct Unit { int pm, pn; };
struct Gemm { const bf16_t* A; const bf16_t* Bt; int M, N, K; };

struct StaticOrder {
    int nM, nN, nwg, G, c;
    __host__ __device__ void init(int M, int N, int G_, int c_) { nM = M / BM; nN = N / BM; nwg = nM * nN; G = G_; c = c_; }
    __host__ __device__ bool next(int i, Unit& u) const {
        const long L = (long)i * G + c; if (L >= nwg) return false;
        int wgid = (int)L; { const int q = nwg / NXCD, r = nwg % NXCD, xcd = wgid % NXCD, off = wgid / NXCD; wgid = (xcd < r ? xcd * (q + 1) : r * (q + 1) + (xcd - r) * q) + off; }
        const int nig = WGM * nN, gid = wgid / nig, fm = gid * WGM, gsz = (nM - fm) < WGM ? (nM - fm) : WGM;
        u.pm = fm + ((wgid % nig) % gsz); u.pn = (wgid % nig) / gsz; return true;
    }
    __device__ __forceinline__ void a_ready(const Unit&) const {}
    __device__ __forceinline__ void done(const Unit&) const {}
};

__device__ __forceinline__ unsigned cvt_pk_bf16(float lo, float hi) { unsigned r; asm volatile("v_cvt_pk_bf16_f32 %0, %1, %2" : "=v"(r) : "v"(lo), "v"(hi)); return r; }
typedef float f32x2 __attribute__((ext_vector_type(2)));
template <class Epi, class Sched, bool ALIGN_EPI = false, bool SP2 = false>
__device__ __forceinline__ void gemm_phase(PG8_LAS unsigned char* lds, const Gemm g, const Sched& S, const Epi& E, int wave_id) {
    int tid_; asm volatile("v_mbcnt_lo_u32_b32 %0, -1, 0\n\tv_mbcnt_hi_u32_b32 %0, -1, %0" : "=v"(tid_)); tid_ += wave_id * 64;
    const int tid = tid_, wid = __builtin_amdgcn_readfirstlane(tid >> 6), lane = tid & 63, wr = wid >> 2, wc = wid & 3, fr = lane & 15, fq = lane >> 4;
    const int K = g.K, nt = K / BK;
    unsigned voffA[2], voffB[2];
#pragma unroll
    for (int i = 0; i < 2; ++i) { int R, C; stage_rc(tid * 16 + i * 8192, R, C); const int Rb = Epi::PERM ? ((R & ~31) + perm32(R & 31)) : R;
        voffA[i] = (unsigned)(R * K + C) * 2u; voffB[i] = (unsigned)(Rb * K + C) * 2u; }
    const size_t kstep = (size_t)(BK * 2);
    const size_t hstep = (size_t)HALF * K * 2;
    const size_t tstep = 2 * hstep;
    const unsigned ldsw = (unsigned)wid * 1024u;
    const int aoff = lds_byte(wr * 64 + fr, fq * 8), boff = lds_byte(wc * 32 + fr, fq * 8);
#define PG8_SA(b, h) (((b) * 2 + (h)) * HTB)
#define PG8_SB(b, h) ((4 + (b) * 2 + (h)) * HTB)
#define PG8_STAGE(bufoff, gbase, voff) do { _Pragma("unroll") for (int _i = 0; _i < 2; ++_i) \
        __builtin_amdgcn_global_load_lds((const unsigned*)((const char*)(gbase) + (voff)[_i]), (PG8_LAS unsigned*)(lds + (bufoff) + ldsw + _i * 8192), 16, 0, 0); } while (0)
#define PG8_LDA(dst, b, h) do { _Pragma("unroll") for (int m = 0; m < 4; ++m) _Pragma("unroll") for (int k = 0; k < 2; ++k) dst[m][k] = *(const PG8_LAS bf16x8*)(lds + PG8_SA(b, h) + aoff + m * 2048 + k * 1024); } while (0)
#define PG8_LDB(dst, b, h) do { _Pragma("unroll") for (int n = 0; n < 2; ++n) _Pragma("unroll") for (int k = 0; k < 2; ++k) dst[n][k] = *(const PG8_LAS bf16x8*)(lds + PG8_SB(b, h) + boff + n * 2048 + k * 1024); } while (0)
#define PG8_MMA(ai, bj, At, Bt) do { __builtin_amdgcn_s_setprio(1); _Pragma("unroll") for (int m = 0; m < 4; ++m) _Pragma("unroll") for (int n = 0; n < 2; ++n) _Pragma("unroll") for (int k = 0; k < 2; ++k) \
        acc[ai][bj][m][n] = __builtin_amdgcn_mfma_f32_16x16x32_bf16(Bt[n][k], At[m][k], acc[ai][bj][m][n], 0, 0, 0); __builtin_amdgcn_s_setprio(0); } while (0)
#define PG8_WAIT_V(n) asm volatile("s_waitcnt vmcnt(" #n ")" ::: "memory")
#define PG8_WAIT_L(n) asm volatile("s_waitcnt lgkmcnt(" #n ")" ::: "memory")
#define PG8_BAR __builtin_amdgcn_s_barrier()
#define PG8_SCHED __builtin_amdgcn_sched_barrier(0)
    Unit cur, nxt; int ui = 0;
    if (!S.next(0, cur)) return;
    f32x4 acc[2][2][4][2];
#pragma unroll
    for (int a = 0; a < 2; ++a)
#pragma unroll
        for (int b = 0; b < 2; ++b)
#pragma unroll
            for (int m = 0; m < 4; ++m)
#pragma unroll
                for (int n = 0; n < 2; ++n) acc[a][b][m][n] = (f32x4){0.f, 0.f, 0.f, 0.f};
    bf16x8 At[4][2], B0[2][2], B1[2][2];
    const char* cA = (const char*)g.A + (size_t)cur.pm * tstep; const char* cB = (const char*)g.Bt + (size_t)cur.pn * tstep;
    S.a_ready(cur);
    if constexpr (SP2) {
        PG8_STAGE(PG8_SB(0, 0), cB, voffB); PG8_STAGE(PG8_SB(0, 1), cB + hstep, voffB); PG8_STAGE(PG8_SA(0, 0), cA, voffA); PG8_STAGE(PG8_SA(0, 1), cA + hstep, voffA);
        if (wr == 1) PG8_BAR;
        PG8_WAIT_V(2); PG8_BAR;
        PG8_STAGE(PG8_SB(1, 0), cB + kstep, voffB); PG8_STAGE(PG8_SA(1, 0), cA + kstep, voffA); PG8_STAGE(PG8_SB(1, 1), cB + hstep + kstep, voffB);
        PG8_WAIT_V(6); PG8_BAR;
    } else {
        PG8_STAGE(PG8_SB(0, 0), cB, voffB); PG8_STAGE(PG8_SA(0, 0), cA, voffA); PG8_STAGE(PG8_SB(0, 1), cB + hstep, voffB); PG8_STAGE(PG8_SA(0, 1), cA + hstep, voffA);
        if (wr == 1) PG8_BAR;
        PG8_WAIT_V(4); PG8_BAR;
        PG8_STAGE(PG8_SB(1, 0), cB + kstep, voffB); PG8_STAGE(PG8_SA(1, 0), cA + kstep, voffA); PG8_STAGE(PG8_SB(1, 1), cB + hstep + kstep, voffB);
        PG8_WAIT_V(6); PG8_BAR;
    }
    for (;;) {
        const bool has_next = S.next(ui + 1, nxt);
        const char* nA = has_next ? (const char*)g.A + (size_t)nxt.pm * tstep : cA; const char* nB = has_next ? (const char*)g.Bt + (size_t)nxt.pn * tstep : cB;
        for (int t = 0; t < nt; t += 2) {
            const bool last = (t == nt - 2);
            const char* a1 = cA + (size_t)(t + 1) * kstep;
            const char* a2 = last ? nA : cA + (size_t)(t + 2) * kstep; const char* b2 = last ? nB : cB + (size_t)(t + 2) * kstep;
            const char* a3 = a2 + kstep; const char* b3 = b2 + kstep;
            if (last && has_next) S.a_ready(nxt);
            if constexpr (SP2) {
            PG8_LDB(B0, 0, 0); PG8_LDB(B1, 0, 1); PG8_SCHED; PG8_LDA(At, 0, 0); PG8_STAGE(PG8_SA(1, 1), a1 + hstep, voffA);
            PG8_WAIT_V(8); PG8_WAIT_L(0); PG8_BAR; PG8_MMA(0, 0, At, B0); PG8_MMA(0, 1, At, B1); PG8_BAR; PG8_SCHED;
            PG8_LDA(At, 0, 1); PG8_STAGE(PG8_SB(0, 0), b2, voffB); PG8_STAGE(PG8_SB(0, 1), b2 + hstep, voffB); PG8_STAGE(PG8_SA(0, 0), a2, voffA);
            PG8_WAIT_V(8); PG8_WAIT_L(0); PG8_BAR; PG8_MMA(1, 0, At, B0); PG8_MMA(1, 1, At, B1); PG8_BAR; PG8_SCHED;
            PG8_LDB(B0, 1, 0); PG8_LDB(B1, 1, 1); PG8_SCHED; PG8_LDA(At, 1, 0); PG8_STAGE(PG8_SA(0, 1), a2 + hstep, voffA);
            PG8_WAIT_V(8); PG8_WAIT_L(0); PG8_BAR; PG8_MMA(0, 0, At, B0); PG8_MMA(0, 1, At, B1); PG8_BAR; PG8_SCHED;
            PG8_LDA(At, 1, 1); PG8_STAGE(PG8_SB(1, 0), b3, voffB); PG8_STAGE(PG8_SB(1, 1), b3 + hstep, voffB); PG8_STAGE(PG8_SA(1, 0), a3, voffA);
            PG8_WAIT_V(8); PG8_WAIT_L(0); PG8_BAR; PG8_MMA(1, 0, At, B0); PG8_MMA(1, 1, At, B1); PG8_BAR; PG8_SCHED;
            } else {
            PG8_LDB(B0, 0, 0); PG8_SCHED; PG8_LDA(At, 0, 0); PG8_STAGE(PG8_SA(1, 1), a1 + hstep, voffA);
            PG8_WAIT_L(8); PG8_BAR; PG8_WAIT_L(0); PG8_MMA(0, 0, At, B0); PG8_BAR; PG8_SCHED;
            PG8_LDB(B1, 0, 1); PG8_STAGE(PG8_SB(0, 0), b2, voffB);
            PG8_BAR; PG8_WAIT_L(0); PG8_MMA(0, 1, At, B1); PG8_BAR;
            PG8_LDA(At, 0, 1); PG8_STAGE(PG8_SA(0, 0), a2, voffA);
            PG8_BAR; PG8_WAIT_L(0); PG8_MMA(1, 0, At, B0); PG8_BAR; PG8_SCHED;
            PG8_STAGE(PG8_SB(0, 1), b2 + hstep, voffB);
            PG8_WAIT_V(6); PG8_BAR; PG8_MMA(1, 1, At, B1); PG8_BAR;
            PG8_LDB(B0, 1, 0); PG8_SCHED; PG8_LDA(At, 1, 0); PG8_STAGE(PG8_SA(0, 1), a2 + hstep, voffA);
            PG8_WAIT_L(8); PG8_BAR; PG8_WAIT_L(0); PG8_MMA(0, 0, At, B0); PG8_BAR; PG8_SCHED;
            PG8_LDB(B1, 1, 1); PG8_STAGE(PG8_SB(1, 0), b3, voffB);
            PG8_BAR; PG8_WAIT_L(0); PG8_MMA(0, 1, At, B1); PG8_BAR;
            PG8_LDA(At, 1, 1); PG8_STAGE(PG8_SA(1, 0), a3, voffA);
            PG8_BAR; PG8_WAIT_L(0); PG8_MMA(1, 0, At, B0); PG8_BAR; PG8_SCHED;
            PG8_STAGE(PG8_SB(1, 1), b3 + hstep, voffB);
            PG8_WAIT_V(6); PG8_BAR; PG8_MMA(1, 1, At, B1); PG8_BAR;
            }
        }
        if constexpr (ALIGN_EPI) { if (wr == 0) PG8_BAR; }
        if constexpr (!Epi::AFTER_DRAIN) { E(acc, cur, wr, wc, fr, fq); S.done(cur); }
        if (!has_next) break;
#pragma unroll
        for (int a = 0; a < 2; ++a)
#pragma unroll
            for (int b = 0; b < 2; ++b)
#pragma unroll
                for (int m = 0; m < 4; ++m)
#pragma unroll
                    for (int n = 0; n < 2; ++n) acc[a][b][m][n] = (f32x4){0.f, 0.f, 0.f, 0.f};
        cur = nxt; cA = nA; cB = nB; ++ui;
        if constexpr (ALIGN_EPI) { if (wr == 1) PG8_BAR; }
    }
    PG8_WAIT_V(0);
    if constexpr (!ALIGN_EPI) { if (wr == 0) PG8_BAR; }
    PG8_BAR;
    if constexpr (Epi::AFTER_DRAIN) { E.fused(acc, cur, wr, wc, fr, fq, lds, wid, lane); S.done(cur); }
#undef PG8_SA
#undef PG8_SB
#undef PG8_STAGE
#undef PG8_LDA
#undef PG8_LDB
#undef PG8_MMA
#undef PG8_WAIT_V
#undef PG8_WAIT_L
#undef PG8_BAR
#undef PG8_SCHED
}
}

#define LAS __attribute__((address_space(3)))
__device__ __forceinline__ int lane_id_v() { int l; asm volatile("v_mbcnt_lo_u32_b32 %0, -1, 0\n\tv_mbcnt_hi_u32_b32 %0, -1, %0" : "=v"(l)); return l; }
#define LANE_ID() lane_id_v()
template <int M> __device__ __forceinline__ float sxor(float v) { return __builtin_bit_cast(float, __builtin_amdgcn_ds_swizzle(__builtin_bit_cast(int, v), (M << 10) | 0x1f)); }
__device__ __forceinline__ void swap32(float& a, float& b) { asm volatile("s_nop 1\n\tv_permlane32_swap_b32 %0, %1\n\ts_nop 3" : "+v"(a), "+v"(b)); }
__device__ __forceinline__ float hsum32(float v) { float a = v, b = v; swap32(a, b); return a + b; }
typedef unsigned short bf16_t;
typedef pg8::f32x4 f32x4;
typedef pg8::u32x4 u32x4;
typedef unsigned u32x2 __attribute__((ext_vector_type(2)));
constexpr int SEQ = 8192, NB = 2, MTOK = NB * SEQ, DM = 1024, DFF = 2816, NMEM = 256, INW = 2304;
constexpr float EPS = 1e-5f;
constexpr float QSCALE = 0.125f * 1.4426950408889634f;
constexpr size_t MiB = 1u << 20;
constexpr size_t WS_WGU1 = 0, WS_WD1 = 11 * MiB, WS_WIN = 16 * MiB + MiB / 2, WS_WMKV = 21 * MiB, WS_WOUT = 22 * MiB, WS_WGU2 = 24 * MiB, WS_WD2 = 35 * MiB;
constexpr size_t WS_ROPE = 41 * MiB, WS_SSQ = 43 * MiB, WS_MEMN = 44 * MiB, WS_MK = 45 * MiB, WS_MVT = 45 * MiB + MiB / 4;
constexpr size_t WS_SMALL = 45 * MiB + MiB / 2;
constexpr int SM_LAM = 0, SM_SUBLN = 256, SM_DWW = 384, SM_DWB = SM_DWW + 31 * 256, SM_LNG = SM_DWB + 256, SM_LNB = SM_LNG + 256, SM_FNG = SM_LNB + 256, SM_END = SM_FNG + 1024;
constexpr size_t WS_CTL = 45 * MiB + 3 * MiB / 4, CTL_BYTES = 65536, CTL_CNT = 16384, CTL_BANK = 4096;
constexpr size_t WS_AB = 46 * MiB, WS_ACT = 78 * MiB, WS_MIXED = 166 * MiB, WS_XBUF = 198 * MiB  , WS_END = 199 * MiB;
constexpr size_t WS_Q = WS_ACT, WS_K = WS_ACT + 16 * MiB, WS_VT = WS_ACT + 32 * MiB, WS_G = WS_ACT + 48 * MiB, WS_MQ = WS_ACT + 56 * MiB;
constexpr int LDS_BYTES = 131072 + 1024;

#ifndef DEFER_W
#define DEFER_W 1
#endif
struct Params { const float* in[25]; float* out; unsigned char* ws; };

__device__ __forceinline__ unsigned f2bf(float f) { unsigned u = __builtin_bit_cast(unsigned, f); return (u + 0x7fffu + ((u >> 16) & 1u)) >> 16; }
__device__ __forceinline__ float bf2f(unsigned short h) { return __builtin_bit_cast(float, (unsigned)h << 16); }
__device__ __forceinline__ unsigned pk2(float lo, float hi) { return pg8::cvt_pk_bf16(lo, hi); }
__device__ __forceinline__ int perm16(int k) { return (k & 3) | (((k >> 3) & 1) << 2) | (((k >> 2) & 1) << 3); }
__device__ __forceinline__ float wave_sum(float v) {
    v += sxor<1>(v); v += sxor<2>(v); v += sxor<4>(v); v += sxor<8>(v); v += sxor<16>(v); v = hsum32(v);
    return v;
}
__device__ __forceinline__ float row_rstd(const float* ssq, int row) {
    const f32x4* p = (const f32x4*)(ssq + (size_t)row * 16);
    const f32x4 a = p[0], b = p[1], c = p[2], d = p[3];
    const float s = ((a.x + a.y) + (a.z + a.w)) + ((b.x + b.y) + (b.z + b.w)) + ((c.x + c.y) + (c.z + c.w)) + ((d.x + d.y) + (d.z + d.w));
    return 1.0f / sqrtf(s * (1.0f / DM) + EPS);
}
__device__ __forceinline__ float row_rstd_q(const float* ssq, int row, int fq) {
    const f32x4 a = ((const f32x4*)(ssq + (size_t)row * 16))[fq];
    float s = (a.x + a.y) + (a.z + a.w);
    s += sxor<16>(s); s = hsum32(s);
    return __builtin_amdgcn_rsqf(s * (1.0f / DM) + EPS);
}
__device__ __forceinline__ float silu_f(float g) { return g * __builtin_amdgcn_rcpf(1.0f + __expf(-g)); }

__device__ __forceinline__ void rows_rstd8(const float* ssq, int row0, int fq, float (&rs)[8]) {
    f32x4 pv[8];
#pragma unroll
    for (int i = 0; i < 8; ++i) pv[i] = ((const f32x4*)(ssq + (size_t)(row0 + (i >> 2) * 128 + (i & 3) * 16) * 16))[fq];
#pragma unroll
    for (int i = 0; i < 8; ++i) { float t = (pv[i].x + pv[i].y) + (pv[i].z + pv[i].w); t += sxor<16>(t); t = hsum32(t); rs[i] = __builtin_amdgcn_rsqf(t * (1.0f / DM) + EPS); }
}

#ifndef EPI_FENCE
#define EPI_FENCE(m) ((m) == 3)
#endif
struct EpiSwiGLU {
    static constexpr bool PERM = true, AFTER_DRAIN = false;
    bf16_t* O; const float* ssq;
    __device__ __forceinline__ void operator()(const f32x4 (&acc)[2][2][4][2], const pg8::Unit& u, int wr, int wc, int fr, int fq) const {
        asm volatile("" : "+v"(fr), "+v"(fq));
        const int row0 = u.pm * 256 + wr * 64 + fr, col0 = u.pn * 128 + wc * 32 + fq * 8;
        float rs8[8];
        if (ssq) rows_rstd8(ssq, row0, fq, rs8); else {
#pragma unroll
            for (int i = 0; i < 8; ++i) rs8[i] = 1.0f; }
#pragma unroll
        for (int ai = 0; ai < 2; ++ai)
#pragma unroll
            for (int m = 0; m < 4; ++m) {
                const int row = row0 + ai * 128 + m * 16;
                const float rs = rs8[ai * 4 + m];
                float v[8];
#pragma unroll
                for (int n = 0; n < 2; ++n)
#pragma unroll
                    for (int i = 0; i < 4; ++i) v[n * 4 + i] = silu_f(acc[ai][0][m][n][i] * rs) * (acc[ai][1][m][n][i] * rs);
                u32x4 w; w.x = pk2(v[0], v[1]); w.y = pk2(v[2], v[3]); w.z = pk2(v[4], v[5]); w.w = pk2(v[6], v[7]);
                *(u32x4*)(O + (size_t)row * DFF + col0) = w;
                if (EPI_FENCE(m)) asm volatile("" ::: "memory");
            }
    }
};
struct EpiResid {
    static constexpr bool PERM = true, AFTER_DRAIN = false;
    const float* basef; const bf16_t* baseb; float* H; bf16_t* HB; float* ssq; float alpha;
    __device__ __forceinline__ void row_part(const f32x4& a0, const f32x4& a1, const f32x4& b0, const f32x4& b1, size_t off, float& ss) const {
        const f32x4 h0 = b0 + a0 * alpha, h1 = b1 + a1 * alpha;
        if (H) { *(f32x4*)(H + off) = h0; *(f32x4*)(H + off + 4) = h1; }
        if (HB) { u32x4 w; w.x = pk2(h0.x, h0.y); w.y = pk2(h0.z, h0.w); w.z = pk2(h1.x, h1.y); w.w = pk2(h1.z, h1.w); *(u32x4*)(HB + off) = w; }
        ss += (h0.x * h0.x + h0.y * h0.y) + (h0.z * h0.z + h0.w * h0.w) + (h1.x * h1.x + h1.y * h1.y) + (h1.z * h1.z + h1.w * h1.w);
    }
    __device__ __forceinline__ void row_end(float ss, int row, int pn, int wc, int fq) const {
        if (ssq) { ss += sxor<16>(ss); ss = hsum32(ss); if (fq == 0) ssq[(size_t)row * 16 + pn * 4 + wc] = ss; }
    }
    __device__ __forceinline__ void operator()(const f32x4 (&acc)[2][2][4][2], const pg8::Unit& u, int wr, int wc, int fr, int fq) const {
        asm volatile("" : "+v"(fr), "+v"(fq));
        const int row0 = u.pm * 256 + wr * 64 + fr, col0 = u.pn * 256 + wc * 32 + fq * 8;
        if (basef) {
#pragma unroll
            for (int g = 0; g < 4; ++g) {
                f32x4 pre[2][2][2];
#pragma unroll
                for (int k = 0; k < 2; ++k)
#pragma unroll
                    for (int bj = 0; bj < 2; ++bj) { const size_t off = (size_t)(row0 + (g >> 1) * 128 + ((g & 1) * 2 + k) * 16) * DM + col0 + bj * 128;
                        pre[k][bj][0] = *(const f32x4*)(basef + off); pre[k][bj][1] = *(const f32x4*)(basef + off + 4); }
#pragma unroll
                for (int k = 0; k < 2; ++k) { const int ai = g >> 1, m = (g & 1) * 2 + k, row = row0 + ai * 128 + m * 16; float ss = 0.f;
#pragma unroll
                    for (int bj = 0; bj < 2; ++bj) row_part(acc[ai][bj][m][0], acc[ai][bj][m][1], pre[k][bj][0], pre[k][bj][1], (size_t)row * DM + col0 + bj * 128, ss);
                    row_end(ss, row, u.pn, wc, fq); }
                asm volatile("" ::: "memory");
            }
        } else {
#pragma unroll
            for (int ai = 0; ai < 2; ++ai) {
                u32x4 pre[4][2];
#pragma unroll
                for (int m = 0; m < 4; ++m)
#pragma unroll
                    for (int bj = 0; bj < 2; ++bj) pre[m][bj] = *(const u32x4*)(baseb + (size_t)(row0 + ai * 128 + m * 16) * DM + col0 + bj * 128);
#pragma unroll
                for (int m = 0; m < 4; ++m) { const int row = row0 + ai * 128 + m * 16; float ss = 0.f;
#pragma unroll
                    for (int bj = 0; bj < 2; ++bj) { const u32x4 w = pre[m][bj];
                        const f32x4 b0 = (f32x4){__builtin_bit_cast(float, w.x << 16), __builtin_bit_cast(float, w.x & 0xffff0000u), __builtin_bit_cast(float, w.y << 16), __builtin_bit_cast(float, w.y & 0xffff0000u)};
                        const f32x4 b1 = (f32x4){__builtin_bit_cast(float, w.z << 16), __builtin_bit_cast(float, w.z & 0xffff0000u), __builtin_bit_cast(float, w.w << 16), __builtin_bit_cast(float, w.w & 0xffff0000u)};
                        row_part(acc[ai][bj][m][0], acc[ai][bj][m][1], b0, b1, (size_t)row * DM + col0 + bj * 128, ss); }
                    row_end(ss, row, u.pn, wc, fq); }
                asm volatile("" ::: "memory");
            }
        }
    }
};
template <bool F32BASE> struct EpiExch {
    static constexpr bool PERM = true, AFTER_DRAIN = true;
    const float* basef; const bf16_t* baseb; const float* rnin; float alpha; float* OUT; const float* gfin; bf16_t* HBN; float* rnout; float* xbuf; unsigned* cnt;
    __device__ __forceinline__ void fused(f32x4 (&acc)[2][2][4][2], const pg8::Unit& u, int wr, int wc, int fr, int fq, LAS unsigned char* lds, int wid, int lane) const {
        asm volatile("" : "+v"(fr), "+v"(fq), "+v"(lane));
        LAS float* Pp = (LAS float*)lds;
        LAS float* S = (LAS float*)(lds + 4096);
        const int col0 = u.pn * 256 + wc * 32 + fq * 8;
        const int rowl0 = wr * 64 + fr;
        if constexpr (F32BASE) {
            unsigned vofff = (unsigned)((rowl0 * DM + col0) * 4); asm volatile("" : "+v"(vofff));
#pragma unroll
            for (int g = 0; g < 8; ++g) {
                const int ai = g >> 2, m = g & 3; f32x4 pre[2][2];
#pragma unroll
                for (int bj = 0; bj < 2; ++bj) { const char* sb = (const char*)(basef + (size_t)(u.pm * 256 + ai * 128 + m * 16) * DM + bj * 128);
                    pre[bj][0] = __builtin_nontemporal_load((const f32x4*)(sb + vofff)); pre[bj][1] = __builtin_nontemporal_load((const f32x4*)(sb + vofff + 16)); }
                float ss = 0.f;
#pragma unroll
                for (int bj = 0; bj < 2; ++bj) { const f32x4 h0 = pre[bj][0] + acc[ai][bj][m][0] * alpha, h1 = pre[bj][1] + acc[ai][bj][m][1] * alpha;
                    acc[ai][bj][m][0] = h0; acc[ai][bj][m][1] = h1;
                    ss += (h0.x * h0.x + h0.y * h0.y) + (h0.z * h0.z + h0.w * h0.w) + (h1.x * h1.x + h1.y * h1.y) + (h1.z * h1.z + h1.w * h1.w); }
                ss += sxor<16>(ss); ss = hsum32(ss);
                if (fq == 0) Pp[(rowl0 + ai * 128 + m * 16) * 4 + wc] = ss;
                if (g & 1) asm volatile("" ::: "memory");
            }
        } else {
#pragma unroll
            for (int ai = 0; ai < 2; ++ai) {
                u32x4 pre[4][2]; float rn[4];
#pragma unroll
                for (int m = 0; m < 4; ++m) { const int row = u.pm * 256 + rowl0 + ai * 128 + m * 16; rn[m] = rnin ? rnin[row] : 1.0f;
#pragma unroll
                    for (int bj = 0; bj < 2; ++bj) pre[m][bj] = *(const u32x4*)(baseb + (size_t)row * DM + col0 + bj * 128); }
#pragma unroll
                for (int m = 0; m < 4; ++m) { float ss = 0.f;
#pragma unroll
                    for (int bj = 0; bj < 2; ++bj) {
                        const u32x4 w = pre[m][bj];
                        const f32x4 b0 = (f32x4){__builtin_bit_cast(float, w.x << 16), __builtin_bit_cast(float, w.x & 0xffff0000u), __builtin_bit_cast(float, w.y << 16), __builtin_bit_cast(float, w.y & 0xffff0000u)};
                        const f32x4 b1 = (f32x4){__builtin_bit_cast(float, w.z << 16), __builtin_bit_cast(float, w.z & 0xffff0000u), __builtin_bit_cast(float, w.w << 16), __builtin_bit_cast(float, w.w & 0xffff0000u)};
                        const f32x4 h0 = b0 * rn[m] + acc[ai][bj][m][0] * alpha, h1 = b1 * rn[m] + acc[ai][bj][m][1] * alpha;
                        acc[ai][bj][m][0] = h0; acc[ai][bj][m][1] = h1;
                        ss += (h0.x * h0.x + h0.y * h0.y) + (h0.z * h0.z + h0.w * h0.w) + (h1.x * h1.x + h1.y * h1.y) + (h1.z * h1.z + h1.w * h1.w);
                    }
                    ss += sxor<16>(ss); ss = hsum32(ss);
                    if (fq == 0) Pp[(rowl0 + ai * 128 + m * 16) * 4 + wc] = ss;
                }
                asm volatile("" ::: "memory");
            }
        }
        asm volatile("s_waitcnt lgkmcnt(0)" ::: "memory"); __builtin_amdgcn_s_barrier(); asm volatile("" ::: "memory");
        const int t = wid * 64 + lane;
        if (t < 256) { const f32x4 p = *(const LAS f32x4*)(Pp + t * 4);
            __hip_atomic_store(xbuf + (size_t)(u.pm * 256 + t) * 4 + u.pn, (p.x + p.y) + (p.z + p.w), __ATOMIC_RELAXED, __HIP_MEMORY_SCOPE_AGENT); }
        asm volatile("s_waitcnt vmcnt(0)" ::: "memory");
        if (lane == 0) __hip_atomic_fetch_add(cnt + 64 * u.pm, 1u, __ATOMIC_RELAXED, __HIP_MEMORY_SCOPE_AGENT);
        if (wid == 0) {
            unsigned spins = 0;
            while ((unsigned)__builtin_amdgcn_readfirstlane(__hip_atomic_load(cnt + 64 * u.pm, __ATOMIC_RELAXED, __HIP_MEMORY_SCOPE_AGENT)) < 32u) { __builtin_amdgcn_s_sleep(2); if (++spins > (1u << 22)) break; }
            __builtin_amdgcn_fence(__ATOMIC_ACQUIRE, "agent");
        }
        asm volatile("s_waitcnt vmcnt(0) lgkmcnt(0)" ::: "memory"); __builtin_amdgcn_s_barrier(); asm volatile("" ::: "memory");
        if (t < 256) { const float* sl = xbuf + (size_t)(u.pm * 256 + t) * 4; float q = 0.f;
#pragma unroll
            for (int k = 0; k < 4; ++k) q += __hip_atomic_load(sl + k, __ATOMIC_RELAXED, __HIP_MEMORY_SCOPE_AGENT);
            const float ms = q * (1.0f / DM) + EPS;
            S[t] = __builtin_amdgcn_rsqf(ms);
            if (rnout && u.pn == 0) rnout[u.pm * 256 + t] = sqrtf(ms); }
        asm volatile("s_waitcnt lgkmcnt(0)" ::: "memory"); __builtin_amdgcn_s_barrier(); asm volatile("" ::: "memory");
        if (OUT) {
#pragma unroll
            for (int bj = 0; bj < 2; ++bj) { const f32x4 g0 = *(const f32x4*)(gfin + col0 + bj * 128), g1 = *(const f32x4*)(gfin + col0 + bj * 128 + 4);
#pragma unroll
                for (int ai = 0; ai < 2; ++ai)
#pragma unroll
                    for (int m = 0; m < 4; ++m) { const int rl = rowl0 + ai * 128 + m * 16; const float rs = S[rl];
                        float* op = OUT + (size_t)(u.pm * 256 + rl) * DM + col0 + bj * 128;
                        *(f32x4*)op = acc[ai][bj][m][0] * rs * g0; *(f32x4*)(op + 4) = acc[ai][bj][m][1] * rs * g1; }
                asm volatile("" ::: "memory"); }
        } else {
#pragma unroll
            for (int ai = 0; ai < 2; ++ai)
#pragma unroll
                for (int m = 0; m < 4; ++m) { const int rl = rowl0 + ai * 128 + m * 16; const float rs = S[rl];
#pragma unroll
                    for (int bj = 0; bj < 2; ++bj) { const f32x4 a0 = acc[ai][bj][m][0] * rs, a1 = acc[ai][bj][m][1] * rs;
                        u32x4 w; w.x = pk2(a0.x, a0.y); w.y = pk2(a0.z, a0.w); w.z = pk2(a1.x, a1.y); w.w = pk2(a1.z, a1.w);
                        *(u32x4*)(HBN + (size_t)(u.pm * 256 + rl) * DM + col0 + bj * 128) = w; }
                    if (m & 1) asm volatile("" ::: "memory"); }
        }
    }
};
struct EpiInProj {
    static constexpr bool PERM = true, AFTER_DRAIN = false;
    const float* ssq; const float* ropec; const float* ropes; bf16_t *Q, *K, *VT, *G, *MQ;
    __device__ __forceinline__ void operator()(const f32x4 (&acc)[2][2][4][2], const pg8::Unit& u, int wr, int wc, int fr, int fq) const {
        asm volatile("" : "+v"(fr), "+v"(fq));
        const int row0 = u.pm * 256 + wr * 64 + fr; const int pn = u.pn;
        float rs8[8];
        if (ssq) rows_rstd8(ssq, row0, fq, rs8); else {
#pragma unroll
            for (int i = 0; i < 8; ++i) rs8[i] = 1.0f; }
        f32x4 rc[2][2], rsn[2][2];
#pragma unroll
        for (int ai = 0; ai < 2; ++ai)
#pragma unroll
            for (int m = 0; m < 4; ++m) {
                const int row = row0 + ai * 128 + m * 16;
                const float rs = rs8[ai * 4 + m];
                if (pn < 4) {
                    const int pos = row & (SEQ - 1);
                    const float sc = (pn < 2) ? QSCALE : 1.0f;
                    if ((m & 1) == 0) {
#pragma unroll
                        for (int k = 0; k < 2; ++k)
#pragma unroll
                            for (int n = 0; n < 2; ++n) { rc[k][n] = *(const f32x4*)(ropec + (pos + 16 * k) * 32 + fq * 8 + n * 4); rsn[k][n] = *(const f32x4*)(ropes + (pos + 16 * k) * 32 + fq * 8 + n * 4); } }
                    float o1[8], o2[8];
#pragma unroll
                    for (int n = 0; n < 2; ++n) {
                        const f32x4 c = rc[m & 1][n], s = rsn[m & 1][n];
#pragma unroll
                        for (int i = 0; i < 4; ++i) { const float x1 = acc[ai][0][m][n][i] * rs, x2 = acc[ai][1][m][n][i] * rs;
                            o1[n * 4 + i] = (x1 * c[i] - x2 * s[i]) * sc; o2[n * 4 + i] = (x2 * c[i] + x1 * s[i]) * sc; }
                    }
                    bf16_t* dst = ((pn < 2) ? Q : K) + (size_t)row * 512 + (pn & 1) * 256 + wc * 64 + fq * 8;
                    u32x4 w; w.x = pk2(o1[0], o1[1]); w.y = pk2(o1[2], o1[3]); w.z = pk2(o1[4], o1[5]); w.w = pk2(o1[6], o1[7]); *(u32x4*)dst = w;
                    w.x = pk2(o2[0], o2[1]); w.y = pk2(o2[2], o2[3]); w.z = pk2(o2[4], o2[5]); w.w = pk2(o2[6], o2[7]); *(u32x4*)(dst + 32) = w;
                } else if (pn < 6) {
                    const int b = u.pm >> 5, t = row & (SEQ - 1);
                    unsigned voff = (unsigned)((wc * 32 + fq * 8) * SEQ + ((t & ~15) | perm16(t & 15))); asm volatile("" : "+v"(voff));
#pragma unroll
                    for (int bj = 0; bj < 2; ++bj)
#pragma unroll
                        for (int n = 0; n < 2; ++n)
#pragma unroll
                            for (int i = 0; i < 4; ++i) { bf16_t* bp = VT + (size_t)((b * 4 + (pn - 4) * 2 + bj) * 128 + n * 4 + i) * SEQ;
                                bp[voff] = (bf16_t)f2bf(acc[ai][bj][m][n][i] * rs); }
                } else if (pn < 8) {
                    float v[8];
#pragma unroll
                    for (int n = 0; n < 2; ++n)
#pragma unroll
                        for (int i = 0; i < 4; ++i) { const float a = acc[ai][0][m][n][i] * rs, g = acc[ai][1][m][n][i] * rs; v[n * 4 + i] = a * __builtin_amdgcn_rcpf(1.0f + __expf(-g)); }
                    u32x4 w; w.x = pk2(v[0], v[1]); w.y = pk2(v[2], v[3]); w.z = pk2(v[4], v[5]); w.w = pk2(v[6], v[7]);
                    *(u32x4*)(G + (size_t)row * 256 + (pn - 6) * 128 + wc * 32 + fq * 8) = w;
                } else {
#pragma unroll
                    for (int bj = 0; bj < 2; ++bj) { const f32x4 a0 = acc[ai][bj][m][0] * (rs * QSCALE), a1 = acc[ai][bj][m][1] * (rs * QSCALE);
                        u32x4 w; w.x = pk2(a0.x, a0.y); w.y = pk2(a0.z, a0.w); w.z = pk2(a1.x, a1.y); w.w = pk2(a1.z, a1.w);
                        *(u32x4*)(MQ + (size_t)row * 256 + bj * 128 + wc * 32 + fq * 8) = w; }
                }
                if (EPI_FENCE(m)) asm volatile("" ::: "memory");
            }
    }
};
struct EpiMemKV {
    static constexpr bool PERM = true, AFTER_DRAIN = false;
    bf16_t *MK, *MVT;
    __device__ __forceinline__ void operator()(const f32x4 (&acc)[2][2][4][2], const pg8::Unit& u, int wr, int wc, int fr, int fq) const {
        asm volatile("" : "+v"(fr), "+v"(fq));
        const int row0 = u.pm * 256 + wr * 64 + fr;
#pragma unroll
        for (int ai = 0; ai < 2; ++ai)
#pragma unroll
            for (int m = 0; m < 4; ++m) {
                const int row = row0 + ai * 128 + m * 16;
                if (u.pn == 0) {
#pragma unroll
                    for (int bj = 0; bj < 2; ++bj) { const f32x4 a0 = acc[ai][bj][m][0], a1 = acc[ai][bj][m][1];
                        u32x4 w; w.x = pk2(a0.x, a0.y); w.y = pk2(a0.z, a0.w); w.z = pk2(a1.x, a1.y); w.w = pk2(a1.z, a1.w);
                        *(u32x4*)(MK + (size_t)row * 256 + bj * 128 + wc * 32 + fq * 8) = w; }
                } else {
                    const int b = u.pm, mi = row & 255;
                    unsigned voff = (unsigned)((wc * 32 + fq * 8) * NMEM + ((mi & ~15) | perm16(mi & 15))); asm volatile("" : "+v"(voff));
#pragma unroll
                    for (int bj = 0; bj < 2; ++bj)
#pragma unroll
                        for (int n = 0; n < 2; ++n)
#pragma unroll
                            for (int i = 0; i < 4; ++i) { bf16_t* bp = MVT + (size_t)((b * 4 + bj * 2) * 64 + n * 4 + i) * NMEM;
                                bp[voff] = (bf16_t)f2bf(acc[ai][bj][m][n][i]); }
                }
                if (EPI_FENCE(m)) asm volatile("" ::: "memory");
            }
    }
};

__device__ __forceinline__ void transpose_item(const float* W, int ldw, int s0, const float* gain, bf16_t* WT, int K, int p0, int k0, LAS float* scr, int lane) {
    float v[32];
    const float* wp = W + (size_t)(k0 + (lane >> 5)) * ldw + s0 + (lane & 31);
#pragma unroll
    for (int i = 0; i < 32; ++i) v[i] = __builtin_nontemporal_load(wp + (size_t)(2 * i) * ldw);
    const int c = lane & 7;
    f32x4 g0 = {1.f, 1.f, 1.f, 1.f}, g1 = g0;
    if (gain) { g0 = *(const f32x4*)(gain + k0 + 8 * c); g1 = *(const f32x4*)(gain + k0 + 8 * c + 4); }
#pragma unroll
    for (int i = 0; i < 32; ++i) scr[(2 * i + (lane >> 5)) * 33 + (lane & 31)] = v[i];
    asm volatile("s_waitcnt lgkmcnt(0)" ::: "memory");
#pragma unroll
    for (int j = 0; j < 4; ++j) { const int n = (lane >> 3) + 8 * j; const LAS float* s = scr + (8 * c) * 33 + n;
        u32x4 o; o.x = pk2(s[0 * 33] * g0.x, s[1 * 33] * g0.y); o.y = pk2(s[2 * 33] * g0.z, s[3 * 33] * g0.w); o.z = pk2(s[4 * 33] * g1.x, s[5 * 33] * g1.y); o.w = pk2(s[6 * 33] * g1.z, s[7 * 33] * g1.w);
        *(u32x4*)(WT + (size_t)(p0 + n) * K + k0 + 8 * c) = o; }
    asm volatile("s_waitcnt lgkmcnt(0)" ::: "memory");
}
__device__ __forceinline__ int in_src_col(int p0) {
    const int pn = p0 >> 8, p = p0 & 255, bj = p >> 7, wc = (p >> 5) & 3;
    if (pn < 4) return 256 * pn + 64 * wc + 32 * bj;
    if (pn == 6 || pn == 7) return (bj ? 1792 : 1536) + 128 * (pn - 6) + (p & 127);
    return p0;
}
__device__ __forceinline__ void rms_row_to_bf16(const float* xrow, const float* g, bf16_t* orow, int lane) {
    const f32x4* xr = (const f32x4*)xrow + lane; const f32x4* gr = (const f32x4*)g + lane;
    f32x4 v[4]; float s = 0.f;
#pragma unroll
    for (int j = 0; j < 4; ++j) { v[j] = __builtin_nontemporal_load(&xr[64 * j]); s += (v[j].x * v[j].x + v[j].y * v[j].y) + (v[j].z * v[j].z + v[j].w * v[j].w); }
    const float rstd = 1.0f / sqrtf(wave_sum(s) * (1.0f / DM) + EPS);
    u32x2* o8 = (u32x2*)orow + lane;
#pragma unroll
    for (int j = 0; j < 4; ++j) { const f32x4 gg = gr[64 * j]; u32x2 w; w.x = pk2(v[j].x * rstd * gg.x, v[j].y * rstd * gg.y); w.y = pk2(v[j].z * rstd * gg.z, v[j].w * rstd * gg.w); o8[64 * j] = w; }
}

template <int NJ>
__device__ __forceinline__ void naive_stream(const bf16_t* qp, const bf16_t* Kb, int kpitch, const bf16_t* Vt, int vpitch, int nkeys, float (&o)[NJ]) {
    u32x4 q[8];
#pragma unroll
    for (int j = 0; j < 8; ++j) q[j] = *(const u32x4*)(qp + 8 * j);
#define BLO(w) __builtin_bit_cast(float, (w) << 16)
#define BHI(w) __builtin_bit_cast(float, (w) & 0xffff0000u)
    float mx = -INFINITY, l = 0.f; int zoff = 0; asm volatile("" : "+v"(zoff));
#pragma unroll
    for (int j = 0; j < NJ; ++j) o[j] = 0.f;
    for (int kb = 0; kb < nkeys; kb += 16) {
        float s[16];
#pragma unroll
        for (int kk = 0; kk < 16; ++kk) {
            const bf16_t* kp = Kb + (size_t)(kb + kk) * kpitch + zoff; float a = 0.f;
#pragma unroll
            for (int j = 0; j < 8; ++j) { const u32x4 w = *(const u32x4*)(kp + 8 * j);
                a += BLO(q[j].x) * BLO(w.x) + BHI(q[j].x) * BHI(w.x); a += BLO(q[j].y) * BLO(w.y) + BHI(q[j].y) * BHI(w.y);
                a += BLO(q[j].z) * BLO(w.z) + BHI(q[j].z) * BHI(w.z); a += BLO(q[j].w) * BLO(w.w) + BHI(q[j].w) * BHI(w.w); }
            s[kk] = a;
        }
        float bm = s[0];
#pragma unroll
        for (int kk = 1; kk < 16; ++kk) bm = fmaxf(bm, s[kk]);
        const float mn = fmaxf(mx, bm), sc = exp2f(mx - mn); mx = mn;
        float ps = 0.f;
#pragma unroll
        for (int kk = 0; kk < 16; ++kk) { s[kk] = exp2f(s[kk] - mn); ps += s[kk]; }
        l = l * sc + ps;
#pragma unroll
        for (int j = 0; j < NJ; ++j) {
            const bf16_t* vp = Vt + (size_t)j * vpitch + kb;
            const u32x4 w0 = *(const u32x4*)vp, w1 = *(const u32x4*)(vp + 8);
            float a = 0.f;
            a += s[0] * __builtin_bit_cast(float, w0.x << 16) + s[1] * __builtin_bit_cast(float, w0.x & 0xffff0000u);
            a += s[2] * __builtin_bit_cast(float, w0.y << 16) + s[3] * __builtin_bit_cast(float, w0.y & 0xffff0000u);
            a += s[8] * __builtin_bit_cast(float, w0.z << 16) + s[9] * __builtin_bit_cast(float, w0.z & 0xffff0000u);
            a += s[10] * __builtin_bit_cast(float, w0.w << 16) + s[11] * __builtin_bit_cast(float, w0.w & 0xffff0000u);
            a += s[4] * __builtin_bit_cast(float, w1.x << 16) + s[5] * __builtin_bit_cast(float, w1.x & 0xffff0000u);
            a += s[6] * __builtin_bit_cast(float, w1.y << 16) + s[7] * __builtin_bit_cast(float, w1.y & 0xffff0000u);
            a += s[12] * __builtin_bit_cast(float, w1.z << 16) + s[13] * __builtin_bit_cast(float, w1.z & 0xffff0000u);
            a += s[14] * __builtin_bit_cast(float, w1.w << 16) + s[15] * __builtin_bit_cast(float, w1.w & 0xffff0000u);
            o[j] = o[j] * sc + a;
        }
    }
    const float rl = 1.0f / l;
#pragma unroll
    for (int j = 0; j < NJ; ++j) o[j] *= rl;
}


typedef short bf16x8 __attribute__((ext_vector_type(8)));
typedef float f32x16 __attribute__((ext_vector_type(16)));
typedef float f32x2_t __attribute__((ext_vector_type(2)));
typedef __bf16 bf16x2_t __attribute__((ext_vector_type(2)));
__device__ __forceinline__ unsigned cvtpk_s(float lo, float hi) { f32x2_t v = {lo, hi}; bf16x2_t b = __builtin_convertvector(v, bf16x2_t); return __builtin_bit_cast(unsigned, b); }
__device__ __forceinline__ int crow(int r, int hi) { return (r & 3) + 8 * (r >> 2) + 4 * hi; }
#define MFMA32(a, b, c) __builtin_amdgcn_mfma_f32_32x32x16_bf16((a), (b), (c), 0, 0, 0)
constexpr int KST = 144;
constexpr int DA_KSLOT = 16384, DA_VSLOT = 16384, DA_V0 = 3 * DA_KSLOT;
constexpr int DA_WSF = DA_V0 + 3 * DA_VSLOT;
constexpr int MA_VST = 528, MA_VT = 256 * KST;
static_assert(DA_WSF >= 65536 && DA_WSF + 1024 <= 131072 && MA_VT + 64 * MA_VST <= DA_WSF, "attention LDS map");

__device__ __forceinline__ void qk_tile(const LAS unsigned char* Kt, int kst, const bf16x8 (&qr)[4], f32x16& p0, f32x16& p1, int r32, int hi) {
#pragma unroll
    for (int r = 0; r < 16; ++r) { p0[r] = 0.f; p1[r] = 0.f; }
    const LAS unsigned char* ka = Kt + r32 * kst + hi * 16;
#pragma unroll
    for (int ds = 0; ds < 4; ++ds) {
        const bf16x8 a0 = *(const LAS bf16x8*)(ka + ds * 32), a1 = *(const LAS bf16x8*)(ka + 32 * kst + ds * 32);
        p0 = MFMA32(a0, qr[ds], p0); p1 = MFMA32(a1, qr[ds], p1);
    }
}
__device__ __forceinline__ float half_max(float v) { float a = v, b = v; swap32(a, b); return fmaxf(a, b); }
__device__ __forceinline__ float half_sum(float v) { return hsum32(v); }
template <int NDB>
__device__ __forceinline__ void soft_max_rescale(const f32x16& p0, const f32x16& p1, f32x16 (&o)[NDB], float& m, float& l, LAS float* wsf, int r32, int hi) {
    float ra = fmaxf(p0[0], p1[0]), rb = fmaxf(p0[1], p1[1]);
#pragma unroll
    for (int r = 2; r < 16; r += 2) { ra = fmaxf(ra, fmaxf(p0[r], p1[r])); rb = fmaxf(rb, fmaxf(p0[r + 1], p1[r + 1])); }
    const float rm = half_max(fmaxf(ra, rb));
    if (__any(rm > m + 8.0f)) {
        const float mn = (rm > m + 8.0f) ? rm : m;
        const float alpha = __builtin_amdgcn_exp2f(m - mn); l *= alpha; m = mn;
        asm volatile("" ::: "memory");
        if (hi == 0) wsf[r32] = alpha;
        asm volatile("" ::: "memory");
        float al[16];
#pragma unroll
        for (int r = 0; r < 16; ++r) al[r] = wsf[crow(r, hi)];
#pragma unroll
        for (int blk = 0; blk < NDB; ++blk)
#pragma unroll
            for (int r = 0; r < 16; ++r) o[blk][r] *= al[r];
        asm volatile("" ::: "memory");
    }
}
__device__ __forceinline__ void soft_exp_pack(f32x16& p0, f32x16& p1, float m, float& l, bf16x8 (&pa)[4]) {
    float ps0 = 0.f, ps1 = 0.f;
#pragma unroll
    for (int r = 0; r < 16; ++r) { p0[r] = __builtin_amdgcn_exp2f(p0[r] - m); p1[r] = __builtin_amdgcn_exp2f(p1[r] - m); ps0 += p0[r]; ps1 += p1[r]; }
    l += ps0 + ps1;
    u32x4 w;
    w.x = cvtpk_s(p0[0], p0[1]); w.y = cvtpk_s(p0[2], p0[3]); w.z = cvtpk_s(p0[4], p0[5]); w.w = cvtpk_s(p0[6], p0[7]); pa[0] = __builtin_bit_cast(bf16x8, w);
    w.x = cvtpk_s(p0[8], p0[9]); w.y = cvtpk_s(p0[10], p0[11]); w.z = cvtpk_s(p0[12], p0[13]); w.w = cvtpk_s(p0[14], p0[15]); pa[1] = __builtin_bit_cast(bf16x8, w);
    w.x = cvtpk_s(p1[0], p1[1]); w.y = cvtpk_s(p1[2], p1[3]); w.z = cvtpk_s(p1[4], p1[5]); w.w = cvtpk_s(p1[6], p1[7]); pa[2] = __builtin_bit_cast(bf16x8, w);
    w.x = cvtpk_s(p1[8], p1[9]); w.y = cvtpk_s(p1[10], p1[11]); w.z = cvtpk_s(p1[12], p1[13]); w.w = cvtpk_s(p1[14], p1[15]); pa[3] = __builtin_bit_cast(bf16x8, w);
}
template <int NDB>
__device__ __forceinline__ void pv_tile(const LAS unsigned char* Vt, int vst, const bf16x8 (&pa)[4], f32x16 (&o)[NDB], int r32, int hi) {
    const LAS unsigned char* va = Vt + r32 * vst + hi * 16;
#pragma unroll
    for (int st = 0; st < 4; ++st)
#pragma unroll
        for (int blk = 0; blk < NDB; ++blk) {
            const bf16x8 vb = *(const LAS bf16x8*)(va + blk * 32 * vst + st * 32);
            o[blk] = MFMA32(pa[st], vb, o[blk]);
        }
}
template <int NDB>
__device__ __forceinline__ void attn_tile(const LAS unsigned char* Kt, int kst, const LAS unsigned char* Vt, int vst, const bf16x8 (&qr)[4], f32x16 (&o)[NDB], float& m, float& l, LAS float* wsf, int r32, int hi) {
    f32x16 p0, p1; bf16x8 pa[4];
    qk_tile(Kt, kst, qr, p0, p1, r32, hi);
    soft_max_rescale<NDB>(p0, p1, o, m, l, wsf, r32, hi);
    soft_exp_pack(p0, p1, m, l, pa);
    pv_tile<NDB>(Vt, vst, pa, o, r32, hi);
}

#define SB() __builtin_amdgcn_sched_barrier(0)
#define LDF(p) (*(const LAS bf16x8*)(p))
__device__ __forceinline__ float row_max32(const f32x16& p0, const f32x16& p1) {
    float ra = fmaxf(fmaxf(p0[0], p0[1]), p1[0]), rb = fmaxf(fmaxf(p0[2], p0[3]), p1[1]); ra = fmaxf(fmaxf(ra, p1[2]), p1[3]);
#pragma unroll
    for (int r = 4; r < 16; r += 4) { ra = fmaxf(fmaxf(ra, p0[r]), p0[r + 1]); rb = fmaxf(fmaxf(rb, p0[r + 2]), p0[r + 3]); ra = fmaxf(fmaxf(ra, p1[r]), p1[r + 1]); rb = fmaxf(fmaxf(rb, p1[r + 2]), p1[r + 3]); }
    return half_max(fmaxf(ra, rb));
}
__device__ __forceinline__ void da_shift(float d, f32x16& n0, f32x16& n1, f32x16 (&o)[4], float& m, float& l, LAS float* wsf, int r32, int hi) {
    m += d;
#pragma unroll
    for (int r = 0; r < 16; ++r) { n0[r] -= d; n1[r] -= d; }
    const float alpha = __builtin_amdgcn_exp2f(-d); l *= alpha;
    asm volatile("" ::: "memory");
    if (hi == 0) wsf[r32] = alpha;
    asm volatile("" ::: "memory");
    float al[16];
#pragma unroll
    for (int r = 0; r < 16; ++r) al[r] = wsf[crow(r, hi)];
#pragma unroll
    for (int blk = 0; blk < 4; ++blk)
#pragma unroll
        for (int r = 0; r < 16; ++r) o[blk][r] *= al[r];
    asm volatile("" ::: "memory");
}
__device__ __forceinline__ bf16x8 pack8(const f32x16& p, int b) { u32x4 w; w.x = cvtpk_s(p[b], p[b + 1]); w.y = cvtpk_s(p[b + 2], p[b + 3]); w.z = cvtpk_s(p[b + 4], p[b + 5]); w.w = cvtpk_s(p[b + 6], p[b + 7]); return __builtin_bit_cast(bf16x8, w); }
template <bool DOQK>
__device__ __forceinline__ void da_step(const LAS unsigned char* Kt, const LAS unsigned char* Vt, const unsigned (&swo)[4], const bf16x8 (&qr)[4], f32x16& c0, f32x16& c1, f32x16& n0, f32x16& n1, float ninit,
                                        f32x16 (&o)[4], float& l, float& rmn) {
    constexpr int VPF = 3;
    bf16x8 kf[2][2], vf[VPF + 1], pa[4];
    float psa = 0.f, psb = 0.f, one = 1.0f; asm volatile("" : "+v"(one));
    if (DOQK) { kf[0][0] = LDF(Kt + swo[0]); kf[0][1] = LDF(Kt + swo[0] + 32 * 128);
#pragma unroll
        for (int r = 0; r < 16; ++r) { n0[r] = ninit; n1[r] = ninit; } }
    SB();
#define VFA(j) (Vt + swo[(j) >> 2] + ((j) & 3) * 32 * 128)
#pragma unroll
    for (int ds = 0; ds < 4; ++ds) {
        if (DOQK && ds < 3) { kf[(ds + 1) & 1][0] = LDF(Kt + swo[ds + 1]); kf[(ds + 1) & 1][1] = LDF(Kt + swo[ds + 1] + 32 * 128); }
        if (ds + VPF >= 4) vf[ds + VPF - 4] = LDF(VFA(ds + VPF - 4));
        if (DOQK) n0 = MFMA32(kf[ds & 1][0], qr[ds], n0);
        c0[4 * ds + 0] = __builtin_amdgcn_exp2f(c0[4 * ds + 0]); c0[4 * ds + 1] = __builtin_amdgcn_exp2f(c0[4 * ds + 1]);
        if (DOQK) n1 = MFMA32(kf[ds & 1][1], qr[ds], n1);
        c0[4 * ds + 2] = __builtin_amdgcn_exp2f(c0[4 * ds + 2]); c0[4 * ds + 3] = __builtin_amdgcn_exp2f(c0[4 * ds + 3]);
        psa = __builtin_fmaf(c0[4 * ds + 0], one, psa); psb += c0[4 * ds + 1]; psa = __builtin_fmaf(c0[4 * ds + 2], one, psa); psb += c0[4 * ds + 3];
        if (ds == 1) pa[0] = pack8(c0, 0);
        if (ds == 3) pa[1] = pack8(c0, 8);
        SB();
    }
    float ra = -INFINITY;
#pragma unroll
    for (int j = 0; j < 16; ++j) {
        const int st = j >> 2, blk = j & 3;
        if (j + VPF < 16) vf[(j + VPF) % (VPF + 1)] = LDF(VFA(j + VPF));
        o[blk] = MFMA32(pa[st], vf[j % (VPF + 1)], o[blk]);
        if (st < 2) { const int e = 8 * st + 2 * blk;
            c1[e] = __builtin_amdgcn_exp2f(c1[e]); c1[e + 1] = __builtin_amdgcn_exp2f(c1[e + 1]); psa = __builtin_fmaf(c1[e], one, psa); psb += c1[e + 1];
            if (blk == 3) pa[2 + st] = pack8(c1, 8 * st);
        } else if (DOQK) {
            if (st == 2) ra = fmaxf(fmaxf(fmaxf(ra, n0[4 * blk]), fmaxf(n0[4 * blk + 1], n0[4 * blk + 2])), n0[4 * blk + 3]);
            else         ra = fmaxf(fmaxf(fmaxf(ra, n1[4 * blk]), fmaxf(n1[4 * blk + 1], n1[4 * blk + 2])), n1[4 * blk + 3]);
        }
        SB();
    }
#undef VFA
    l += psa + psb;
    if (DOQK) rmn = half_max(ra);
}
__device__ __forceinline__ void qk_tile_sw(const LAS unsigned char* Kt, const unsigned (&swo)[4], const bf16x8 (&qr)[4], f32x16& p0, f32x16& p1) {
#pragma unroll
    for (int r = 0; r < 16; ++r) { p0[r] = 0.f; p1[r] = 0.f; }
#pragma unroll
    for (int ds = 0; ds < 4; ++ds) {
        const bf16x8 a0 = LDF(Kt + swo[ds]), a1 = LDF(Kt + swo[ds] + 32 * 128);
        p0 = MFMA32(a0, qr[ds], p0); p1 = MFMA32(a1, qr[ds], p1);
    }
}

#define XB_TMO      128
#define XB_XCNT(j)  (256  + 64 * (j))
#define XB_XSUB(j)  (1280 + 64 * (j))
#define XB_XGEN(j)  (2304 + 64 * (j))
#define XB_TOP      3328
#define XB_TOPGEN   3392
#define XCD_BAR_WORDS 3456
#define XB_SPIN_CAP (1u << 18)

__device__ __forceinline__ unsigned xb_ld(unsigned* p)              { return __hip_atomic_load(p, __ATOMIC_RELAXED, __HIP_MEMORY_SCOPE_AGENT); }
__device__ __forceinline__ unsigned xb_add(unsigned* p, unsigned v) { return __hip_atomic_fetch_add(p, v, __ATOMIC_RELAXED, __HIP_MEMORY_SCOPE_AGENT); }
__device__ __forceinline__ unsigned xb_xcc_id() { return (unsigned)__builtin_amdgcn_s_getreg((3 << 11) | 20) & 0xFu; }
#define XB_SPIN(cond, bar) do { unsigned _sp = 0; while (cond) { __builtin_amdgcn_s_sleep(1); \
    if ((++_sp & 255u) == 0u) { if (xb_ld(&(bar)[XB_TMO])) break; if (_sp > XB_SPIN_CAP) { atomicAdd(&(bar)[XB_TMO], 1u); break; } } } } while (0)

struct XcdBarrier {
    unsigned* bar; unsigned x; bool w0;
    volatile LAS unsigned* st;
};

__device__ __forceinline__ XcdBarrier xcd_barrier_post(unsigned* bar, volatile LAS unsigned* st) {
    XcdBarrier b; b.bar = bar; b.x = xb_xcc_id(); b.st = st;
    if (threadIdx.x == 0) (void)xb_add(&bar[XB_XCNT(b.x)], 1u);
    return b;
}
__device__ __forceinline__ void xcd_barrier_complete(unsigned* bar, unsigned x, unsigned& nloc, unsigned& nx) {
    const unsigned G = gridDim.x * gridDim.y * gridDim.z;
    unsigned sum, cnt, mine, sp = 0u;
    for (;;) {
        sum = 0u; cnt = 0u; mine = 0u;
#pragma unroll
        for (unsigned j = 0; j < 16; ++j) { const unsigned c = xb_ld(&bar[XB_XCNT(j)]); sum += c; cnt += (c > 0u) ? 1u : 0u; mine = (j == x) ? c : mine; }
        if (sum == G) break;
        __builtin_amdgcn_s_sleep(1);
        if ((++sp & 255u) == 0u) { if (xb_ld(&bar[XB_TMO])) break; if (sp > XB_SPIN_CAP) { atomicAdd(&bar[XB_TMO], 1u); break; } }
    }
    nloc = mine > 0u ? mine : 1u; nx = cnt > 0u ? cnt : 1u;
}

__device__ __forceinline__ void xcd_barrier(const XcdBarrier& b) {
    asm volatile("s_waitcnt vmcnt(0)" ::: "memory");
    __syncthreads();
    if (b.w0 && LANE_ID() == 0) {
        unsigned* bar = b.bar;
        __builtin_amdgcn_s_waitcnt(0);
        unsigned nloc = b.st[0], nx = b.st[1];
        if (nloc == 0u) { xcd_barrier_complete(bar, b.x, nloc, nx); b.st[0] = nloc; b.st[1] = nx; }
        const unsigned old = xb_add(&bar[XB_XSUB(b.x)], 1u);
        const unsigned gen = old / nloc;
        if (old + 1u == (gen + 1u) * nloc) {
            __builtin_amdgcn_fence(__ATOMIC_RELEASE, "agent");
            asm volatile("s_waitcnt vmcnt(0)" ::: "memory");
            const unsigned og = xb_add(&bar[XB_TOP], 1u);
            const unsigned tg = og / nx;
            if (og + 1u == (tg + 1u) * nx) xb_add(&bar[XB_TOPGEN], 1u);
            else XB_SPIN(xb_ld(&bar[XB_TOPGEN]) == tg, bar);
            __builtin_amdgcn_fence(__ATOMIC_ACQUIRE, "agent");
            xb_add(&bar[XB_XGEN(b.x)], 1u);
            asm volatile("s_waitcnt vmcnt(0)" ::: "memory");
        } else {
            XB_SPIN(xb_ld(&bar[XB_XGEN(b.x)]) == gen, bar);
            __builtin_amdgcn_fence(__ATOMIC_ACQUIRE, "agent");
            asm volatile("s_waitcnt vmcnt(0)" ::: "memory");
        }
    }
    __syncthreads();
}

__global__ void __launch_bounds__(512, 2) fwd_megakernel(Params P) {
    extern __shared__ __attribute__((aligned(16))) unsigned char lds_raw[];
    LAS unsigned char* lds = (LAS unsigned char*)lds_raw;
    cg::grid_group grid = cg::this_grid();
    const int tid = threadIdx.x, lane = tid & 63, wave = __builtin_amdgcn_readfirstlane(tid >> 6);
    const int G = gridDim.x, gw = blockIdx.x * 8 + wave, NGW = G * 8;
    unsigned char* ws = P.ws;
    const float* x = P.in[0]; float* H = P.out;
    volatile LAS unsigned* bst = (volatile LAS unsigned*)(lds + 131072);
    if (tid < 2) bst[tid] = 0u;
    __syncthreads();
    XcdBarrier xbar = xcd_barrier_post((unsigned*)(ws + WS_CTL), bst); xbar.w0 = (wave == 0);
#if !defined(NO_CG_SYNC) && !defined(CG_SYNC_AT_END)
    grid.sync();
#endif
#define GRID_BAR() xcd_barrier(xbar)
    bf16_t* W_GU1 = (bf16_t*)(ws + WS_WGU1); bf16_t* W_D1 = (bf16_t*)(ws + WS_WD1); bf16_t* W_IN = (bf16_t*)(ws + WS_WIN); bf16_t* W_MKV = (bf16_t*)(ws + WS_WMKV);
    bf16_t* W_OUT = (bf16_t*)(ws + WS_WOUT); bf16_t* W_GU2 = (bf16_t*)(ws + WS_WGU2); bf16_t* W_D2 = (bf16_t*)(ws + WS_WD2);
    float* ROPEC = (float*)(ws + WS_ROPE); float* ROPES = ROPEC + SEQ * 32; float* SSQ = (float*)(ws + WS_SSQ); float* RN1 = SSQ; float* RN2 = SSQ + MTOK;
    bf16_t* MEMN = (bf16_t*)(ws + WS_MEMN); bf16_t* MK = (bf16_t*)(ws + WS_MK); bf16_t* MVT = (bf16_t*)(ws + WS_MVT);
    bf16_t* AB = (bf16_t*)(ws + WS_AB); bf16_t* ACT = (bf16_t*)(ws + WS_ACT); bf16_t* MIXED = (bf16_t*)(ws + WS_MIXED);
    bf16_t* Qb = (bf16_t*)(ws + WS_Q); bf16_t* Kb = (bf16_t*)(ws + WS_K); bf16_t* VT = (bf16_t*)(ws + WS_VT); bf16_t* Gb = (bf16_t*)(ws + WS_G); bf16_t* MQ = (bf16_t*)(ws + WS_MQ);

#ifndef P0_REPS
#define P0_REPS 1
#endif
    {
        LAS float* scr = (LAS float*)(lds + wave * 16384);
        constexpr int I_GU = (5632 / 32) * (DM / 64), I_D = DEFER_W ? 0 : (DM / 32) * (DFF / 64), I_IN = (INW / 32) * (DM / 64), I_MKV = (512 / 32) * (DM / 64);
        constexpr int NITEMS = I_GU + I_D + I_IN + I_MKV;
        for (int it = gw; it < NITEMS * P0_REPS; it += NGW) {
            int r = it % NITEMS;
            if (r < I_GU) {
                const int kb = r % (DM / 64), pb = r / (DM / 64), p0 = pb * 32, pn = p0 >> 8, bj = (p0 >> 7) & 1, j0 = p0 & 127;
                transpose_item(bj ? P.in[4] : P.in[3], DFF, 128 * pn + j0, nullptr, W_GU1, DM, p0, kb * 64, scr, lane); continue; }
            r -= I_GU;
            if (r < I_D) { const int kb = r % (DFF / 64), pb = r / (DFF / 64);
                transpose_item(P.in[5], DM, pb * 32, nullptr, W_D1, DFF, pb * 32, kb * 64, scr, lane); continue; }
            r -= I_D;
            if (r < I_IN) { const int kb = r % (DM / 64), pb = r / (DM / 64);
                transpose_item(P.in[8], INW, in_src_col(pb * 32), P.in[6], W_IN, DM, pb * 32, kb * 64, scr, lane); continue; }
            r -= I_IN;
            { const int kb = r % (DM / 64), pb = r / (DM / 64);
                transpose_item(P.in[18], 512, pb * 32, nullptr, W_MKV, DM, pb * 32, kb * 64, scr, lane); }
        }
#if !DEFER_W
        { constexpr int I_OUT = (DM / 32) * (DM / 64);
          for (int it = gw; it < I_GU + I_D + I_OUT; it += NGW) { int r = it;
            if (r < I_GU) { const int kb = r % (DM / 64), pb = r / (DM / 64), p0 = pb * 32, pn = p0 >> 8, bj = (p0 >> 7) & 1, j0 = p0 & 127;
                transpose_item(bj ? P.in[22] : P.in[21], DFF, 128 * pn + j0, P.in[20], W_GU2, DM, p0, kb * 64, scr, lane); continue; }
            r -= I_GU;
            if (r < I_D) { const int kb = r % (DFF / 64), pb = r / (DFF / 64);
                transpose_item(P.in[23], DM, pb * 32, nullptr, W_D2, DFF, pb * 32, kb * 64, scr, lane); continue; }
            r -= I_D;
            { const int kb = r % (DM / 64), pb = r / (DM / 64);
                transpose_item(P.in[19], DM, pb * 32, nullptr, W_OUT, DM, pb * 32, kb * 64, scr, lane); } } }
#endif
        for (int m_ = gw; m_ < MTOK * P0_REPS; m_ += NGW) { const int m = m_ & (MTOK - 1); rms_row_to_bf16(x + (size_t)m * DM, P.in[2], AB + (size_t)m * DM, lane); }
        for (int m = gw; m < NB * NMEM; m += NGW) rms_row_to_bf16(P.in[1] + (size_t)m * DM, P.in[7], MEMN + (size_t)m * DM, lane);
        { float* SM = (float*)(ws + WS_SMALL);
          for (int e = blockIdx.x * 512 + tid; e < SM_END; e += G * 512) {
            float v;
            if (e < 64) v = P.in[9][e]; else if (e < 128) v = P.in[10][e - 64]; else if (e < 192) v = P.in[11][e - 128]; else if (e < SM_SUBLN) v = P.in[12][e - 192];
            else if (e < SM_DWW) v = P.in[13][e - SM_SUBLN];
            else if (e < SM_DWB) v = P.in[14][e - SM_DWW];
            else if (e < SM_LNG) v = P.in[15][e - SM_DWB];
            else if (e < SM_LNB) v = P.in[16][e - SM_LNG];
            else if (e < SM_FNG) v = P.in[17][e - SM_LNB];
            else v = P.in[24][e - SM_FNG];
            SM[e] = v; } }
        for (int e = blockIdx.x * 512 + tid; e < SEQ * 32; e += G * 512) {
            const int pos = e >> 5, i = e & 31;
            const float invf = (float)exp2(-(double)(2 * i) / 64.0 * 13.287712379549449);
            const float ang = (float)pos * invf;
            const double xd = (double)ang, kd = rint(xd * 0.63661977236758134), rr = fma(-kd, 1.5707963267948966, xd) - kd * 6.123233995736766e-17, r2 = rr * rr;
            const double sn = rr * (1.0 + r2 * (-1.0 / 6 + r2 * (1.0 / 120 + r2 * (-1.0 / 5040 + r2 * (1.0 / 362880 + r2 * (-1.0 / 39916800 + r2 * (1.0 / 6227020800.0)))))));
            const double cs = 1.0 + r2 * (-0.5 + r2 * (1.0 / 24 + r2 * (-1.0 / 720 + r2 * (1.0 / 40320 + r2 * (-1.0 / 3628800 + r2 * (1.0 / 479001600.0 + r2 * (-1.0 / 87178291200.0)))))));
            const int qd = ((int)kd) & 3;
            const double sv = (qd == 0) ? sn : (qd == 1) ? cs : (qd == 2) ? -sn : -cs;
            const double cv = (qd == 0) ? cs : (qd == 1) ? -sn : (qd == 2) ? -cs : sn;
            ROPEC[e] = (float)cv; ROPES[e] = (float)sv;
        }
    }
    GRID_BAR();
#ifndef NO_P1
    { pg8::Gemm g{AB, W_GU1, MTOK, 2 * DFF, DM}; pg8::StaticOrder S; S.init(MTOK, 2 * DFF, G, (int)blockIdx.x); EpiSwiGLU E{ACT, nullptr};
      pg8::gemm_phase<EpiSwiGLU, pg8::StaticOrder, true, true>(lds, g, S, E, wave);
#ifdef P1_TWICE
      pg8::gemm_phase<EpiSwiGLU, pg8::StaticOrder, true, true>(lds, g, S, E, wave);
#endif
    }
#if DEFER_W
    if ((int)blockIdx.x >= G / 2) {
        int lane_t = LANE_ID(); asm volatile("" : "+v"(lane_t)); const int lane = lane_t;
        LAS float* scr = (LAS float*)(lds + wave * 16384);
        constexpr int I_D1 = (DM / 32) * (DFF / 64);
        for (int r = ((int)blockIdx.x - G / 2) * 8 + wave; r < I_D1; r += (G - G / 2) * 8) {
            const int kb = r % (DFF / 64), pb = r / (DFF / 64);
            transpose_item(P.in[5], DM, pb * 32, nullptr, W_D1, DFF, pb * 32, kb * 64, scr, lane); }
    }
#endif
#endif
    GRID_BAR();
#ifdef SYNC_EXTRA
    for (int i = 0; i < SYNC_EXTRA; ++i) GRID_BAR();
#endif
#ifndef NO_P2
    { pg8::Gemm g{ACT, W_D1, MTOK, DM, DFF}; pg8::StaticOrder S; S.init(MTOK, DM, G, (int)blockIdx.x);
      EpiExch<true> E{x, nullptr, nullptr, 0.5f, nullptr, nullptr, AB, RN1, (float*)(ws + WS_XBUF), (unsigned*)(ws + WS_CTL + CTL_CNT)};
      pg8::gemm_phase<EpiExch<true>, pg8::StaticOrder, false, true>(lds, g, S, E, wave);
    }
#endif
    GRID_BAR();
#ifndef NO_P3
    { pg8::Gemm g{AB, W_IN, MTOK, INW, DM}; pg8::StaticOrder S; S.init(MTOK, INW, G, (int)blockIdx.x); EpiInProj E{nullptr, ROPEC, ROPES, Qb, Kb, VT, Gb, MQ};
      pg8::gemm_phase<EpiInProj, pg8::StaticOrder, true, true>(lds, g, S, E, wave);
#ifdef P3_TWICE
      pg8::gemm_phase<EpiInProj, pg8::StaticOrder, true, true>(lds, g, S, E, wave);
#endif
      pg8::Gemm g2{MEMN, W_MKV, NB * NMEM, 512, DM}; pg8::StaticOrder S2; S2.init(NB * NMEM, 512, G, ((int)blockIdx.x >= G - 4) ? (int)blockIdx.x - (G - 4) : 1 << 20); EpiMemKV E2{MK, MVT};
      pg8::gemm_phase<EpiMemKV, pg8::StaticOrder, true, true>(lds, g2, S2, E2, wave); }
#if DEFER_W
    if ((int)blockIdx.x >= G / 4 && (int)blockIdx.x < G - 4) {
        int lane_t = LANE_ID(); asm volatile("" : "+v"(lane_t)); const int lane = lane_t;
        LAS float* scr = (LAS float*)(lds + wave * 16384);
        constexpr int I_D = (DM / 32) * (DFF / 64), I_OUT = (DM / 32) * (DM / 64), I_GUH = (5632 / 32) * (DM / 64);
        for (int r0 = ((int)blockIdx.x - G / 4) * 8 + wave; r0 < I_D + I_OUT + I_GUH; r0 += (G - 4 - G / 4) * 8) {
            int r = r0;
            if (r < I_GUH) {
                const int kb = r % (DM / 64), pb = r / (DM / 64), p0 = pb * 32, pn = p0 >> 8, bj = (p0 >> 7) & 1, j0 = p0 & 127;
                transpose_item(bj ? P.in[22] : P.in[21], DFF, 128 * pn + j0, P.in[20], W_GU2, DM, p0, kb * 64, scr, lane); continue; }
            r -= I_GUH;
            if (r < I_OUT) { const int kb = r % (DM / 64), pb = r / (DM / 64);
                transpose_item(P.in[19], DM, pb * 32, nullptr, W_OUT, DM, pb * 32, kb * 64, scr, lane); continue; }
            r -= I_OUT;
            { const int kb = r % (DFF / 64), pb = r / (DFF / 64);
                transpose_item(P.in[23], DM, pb * 32, nullptr, W_D2, DFF, pb * 32, kb * 64, scr, lane); }
        }
    }
#endif
#endif
    GRID_BAR();
#ifndef NO_P4
    {
        const float* SM = (const float*)(ws + WS_SMALL);
#define LAM_COMPUTE(lamv) do { const int ll_ = LANE_ID(); const float a_ = SM[ll_] * SM[64 + ll_], b_ = SM[128 + ll_] * SM[192 + ll_]; lamv = __expf(wave_sum(a_)) - __expf(wave_sum(b_)) + 0.2f; } while (0)
#ifdef NAIVE_ATT
        float lam; LAM_COMPUTE(lam);
        {
            const int qi = lane >> 2, dq = lane & 3;
            for (int item = gw, rnd = 0; item < 4096; item += NGW, ++rnd) {
                const int bh = item & 7, rest = item >> 3, qsub = rest & 3; int ch = rest >> 2; if ((rnd & 1) && NGW == 2048) ch = 191 - ch;
                const int b = bh >> 2, h = bh & 3, row = b * SEQ + ch * 64 + qsub * 16 + qi, nkeys = (ch + 1) * 64;
                float o1[32], o2[32];
                naive_stream<32>(Qb + (size_t)row * 512 + h * 128, Kb + (size_t)b * SEQ * 512 + h * 128, 512, VT + ((size_t)(bh) * 128 + dq * 32) * SEQ, SEQ, nkeys, o1);
                naive_stream<32>(Qb + (size_t)row * 512 + h * 128 + 64, Kb + (size_t)b * SEQ * 512 + h * 128 + 64, 512, VT + ((size_t)(bh) * 128 + dq * 32) * SEQ, SEQ, nkeys, o2);
                float ss = 0.f;
#pragma unroll
                for (int j = 0; j < 32; ++j) { o1[j] -= lam * o2[j]; ss += o1[j] * o1[j]; }
                ss += sxor<1>(ss); ss += sxor<2>(ss);
                const float rs = 0.8f / sqrtf(ss * (1.0f / 128) + EPS);
                bf16_t* dst = MIXED + (size_t)row * DM + h * 128 + dq * 32;
#pragma unroll
                for (int j = 0; j < 32; j += 8) { u32x4 w;
                    w.x = pk2(o1[j] * rs * SM[SM_SUBLN + dq * 32 + j], o1[j + 1] * rs * SM[SM_SUBLN + dq * 32 + j + 1]); w.y = pk2(o1[j + 2] * rs * SM[SM_SUBLN + dq * 32 + j + 2], o1[j + 3] * rs * SM[SM_SUBLN + dq * 32 + j + 3]);
                    w.z = pk2(o1[j + 4] * rs * SM[SM_SUBLN + dq * 32 + j + 4], o1[j + 5] * rs * SM[SM_SUBLN + dq * 32 + j + 5]); w.w = pk2(o1[j + 6] * rs * SM[SM_SUBLN + dq * 32 + j + 6], o1[j + 7] * rs * SM[SM_SUBLN + dq * 32 + j + 7]);
                    *(u32x4*)(dst + j) = w; }
            }
        }
        {
            const int qi = lane >> 2, dq = lane & 3;
            for (int item = gw; item < MTOK / 16 * 4; item += NGW) {
                const int hm = item & 3, rb = item >> 2, row = rb * 16 + qi, b = row >> 13;
                float o[16];
                naive_stream<16>(MQ + (size_t)row * 256 + hm * 64, MK + (size_t)b * NMEM * 256 + hm * 64, 256, MVT + ((size_t)(b * 4 + hm) * 64 + dq * 16) * NMEM, NMEM, NMEM, o);
                bf16_t* dst = MIXED + (size_t)row * DM + 768 + hm * 64 + dq * 16;
                u32x4 w; w.x = pk2(o[0], o[1]); w.y = pk2(o[2], o[3]); w.z = pk2(o[4], o[5]); w.w = pk2(o[6], o[7]); *(u32x4*)dst = w;
                w.x = pk2(o[8], o[9]); w.y = pk2(o[10], o[11]); w.z = pk2(o[12], o[13]); w.w = pk2(o[14], o[15]); *(u32x4*)(dst + 8) = w;
            }
        }
#else
        {
            int lane_d = LANE_ID(); asm volatile("" : "+v"(lane_d)); const int lane = lane_d;
            const int r32 = lane & 31, hi = lane >> 5, c = wave >> 2, wq = wave & 3;
            LAS float* wsf = (LAS float*)(lds + DA_WSF) + wave * 32;
            unsigned swo[4];
            { const int sw = (r32 >> 1) & 7;
#pragma unroll
              for (int x = 0; x < 4; ++x) swo[x] = (unsigned)(r32 * 128 + (((2 * x + hi) ^ sw) << 4)); }
            const int rin = 8 * wave + (lane >> 3), lc = (lane & 7) ^ ((rin >> 1) & 7);
            const unsigned kvoff = (unsigned)((rin * 512 + lc * 8) * 2), vvoff = (unsigned)((rin * SEQ + lc * 8) * 2);
            const unsigned qoff = (unsigned)(((wq * 32 + r32) * 512 + c * 64 + hi * 8) * 2);
            const unsigned ldsb = (unsigned)(size_t)lds_raw + (unsigned)wave * 1024u;
#ifndef DA_REPS
#define DA_REPS 1
#endif
            for (int pair_ = blockIdx.x; pair_ < 256 * DA_REPS; pair_ += G)
            for (int half = 0; half < 2; ++half) {
                const int pair = pair_ & 255, bh = pair & 7, sidx = pair >> 3, qb = half ? 63 - sidx : sidx, b = bh >> 2, h = bh & 3;
                const int q0 = qb * 128, NT = 2 * qb + 2;
                const char* kbase = (const char*)(Kb + (size_t)b * SEQ * 512 + h * 128);
                const char* vbase = (const char*)(VT + (size_t)bh * 128 * SEQ);
#define DA_GLDS(voff, sbase, dst, imm) do { unsigned keep_; const char* ga_ = (sbase) + (voff); asm volatile("s_mov_b32 %0, m0\n\ts_mov_b32 m0, %2\n\ts_nop 0\n\tglobal_load_lds_dwordx4 %1, off\n\ts_mov_b32 m0, %0" \
                    : "=&s"(keep_) : "v"(ga_), "s"(dst) : "memory"); } while (0)
#define DA_DMA_K(tt, sl) do { const int tt_ = (tt) < NT ? (tt) : NT - 1; const char* kb_ = kbase + (size_t)tt_ * (64 * 512 * 2); const unsigned d_ = (unsigned)__builtin_amdgcn_readfirstlane(ldsb + (sl) * DA_KSLOT); \
                    DA_GLDS(kvoff, kb_, d_, 0); const unsigned d2_ = d_ + 8192u; const char* kb2_ = kb_ + 128; DA_GLDS(kvoff, kb2_, d2_, 0); } while (0)
#define DA_DMA_V(tt, sl) do { const int tt_ = (tt) < NT ? (tt) : NT - 1; const char* vb_ = vbase + (size_t)tt_ * 128; const char* vb2_ = vb_ + (size_t)64 * SEQ * 2; const unsigned d_ = (unsigned)__builtin_amdgcn_readfirstlane(ldsb + DA_V0 + (sl) * DA_VSLOT); \
                    DA_GLDS(vvoff, vb_, d_, 0); const unsigned d2_ = d_ + 8192u; DA_GLDS(vvoff, vb2_, d2_, 0); } while (0)
#define DA_BAR(N) asm volatile("s_waitcnt vmcnt(" #N ") lgkmcnt(0)\n\ts_barrier" ::: "memory")
#define DA_KB(t) (lds + ((t) % 3) * DA_KSLOT + c * 8192)
#define DA_VB(t) (lds + DA_V0 + ((t) % 3) * DA_VSLOT)
#define DA_SHIFTCHK(N0, N1) do { if (__any(rmn > 8.0f)) da_shift((rmn > 8.0f) ? rmn : 0.f, N0, N1, o, m, l, wsf, r32, hi); } while (0)
                DA_DMA_K(0, 0); DA_DMA_V(0, 0); DA_DMA_K(1, 1);
                bf16x8 qr[4];
                { const char* qbase = (const char*)(Qb + ((size_t)(b * SEQ + q0)) * 512 + h * 128);
                  asm volatile("global_load_dwordx4 %0, %4, %5 offset:0\n\tglobal_load_dwordx4 %1, %4, %5 offset:32\n\tglobal_load_dwordx4 %2, %4, %5 offset:64\n\tglobal_load_dwordx4 %3, %4, %5 offset:96"
                               : "=&v"(qr[0]), "=&v"(qr[1]), "=&v"(qr[2]), "=&v"(qr[3]) : "v"(qoff), "s"(qbase) : "memory"); }
                f32x16 o[4];
#pragma unroll
                for (int blk = 0; blk < 4; ++blk)
#pragma unroll
                    for (int r = 0; r < 16; ++r) o[blk][r] = 0.f;
                float m = 0.f, l = 0.f;
                DA_BAR(0);
                DA_DMA_K(2, 2); DA_DMA_V(1, 1);
                f32x16 pA0, pA1, pB0, pB1; float rmn;
                qk_tile_sw(DA_KB(0), swo, qr, pA0, pA1);
                { const float rm0 = row_max32(pA0, pA1); m = rm0;
#pragma unroll
                  for (int r = 0; r < 16; ++r) { pA0[r] -= rm0; pA1[r] -= rm0; } }
                DA_BAR(4);
                const bool masklast = (wq < 2);
                int t = 0;
                for (; t + 2 < NT; t += 2) {
                    DA_DMA_K(t + 3, t % 3); DA_DMA_V(t + 2, (t + 2) % 3);
                    da_step<true>(DA_KB(t + 1), DA_VB(t), swo, qr, pA0, pA1, pB0, pB1, -m, o, l, rmn); DA_SHIFTCHK(pB0, pB1);
                    DA_BAR(4);
                    DA_DMA_K(t + 4, (t + 1) % 3); DA_DMA_V(t + 3, (t + 3) % 3);
                    da_step<true>(DA_KB(t + 2), DA_VB(t + 1), swo, qr, pB0, pB1, pA0, pA1, -m, o, l, rmn); DA_SHIFTCHK(pA0, pA1);
                    DA_BAR(4);
                }
                DA_DMA_K(t + 3, t % 3); DA_DMA_V(t + 2, (t + 2) % 3);
                da_step<true>(DA_KB(t + 1), DA_VB(t), swo, qr, pA0, pA1, pB0, pB1, masklast ? -INFINITY : -m, o, l, rmn); DA_SHIFTCHK(pB0, pB1);
                DA_BAR(4);
                da_step<false>(DA_KB(t), DA_VB(t + 1), swo, qr, pB0, pB1, pA0, pA1, 0.f, o, l, rmn);
                DA_BAR(0);
#undef DA_GLDS
#undef DA_DMA_K
#undef DA_DMA_V
#undef DA_BAR
#undef DA_KB
#undef DA_VB
#undef DA_SHIFTCHK
                int r32f = r32, lanef = lane; asm volatile("" : "+v"(r32f), "+v"(lanef));
                { float inv = 1.0f / half_sum(l); if (c) { float lam; LAM_COMPUTE(lam); inv *= lam; }
                  asm volatile("" ::: "memory");
                  if (hi == 0) wsf[r32] = inv;
                  asm volatile("" ::: "memory");
                  float sc[16];
#pragma unroll
                  for (int r = 0; r < 16; ++r) sc[r] = wsf[crow(r, hi)];
#pragma unroll
                  for (int blk = 0; blk < 4; ++blk)
#pragma unroll
                      for (int r = 0; r < 16; ++r) o[blk][r] *= sc[r]; }
                LAS float* cb = (LAS float*)lds + wq * 4096 + lanef;
                if (c) {
#pragma unroll
                    for (int blk = 0; blk < 4; ++blk)
#pragma unroll
                        for (int r = 0; r < 16; ++r) cb[(blk * 16 + r) * 64] = o[blk][r];
                }
                __syncthreads();
                if (!c) {
                    float ss[16];
#pragma unroll
                    for (int r = 0; r < 16; ++r) ss[r] = 0.f;
#pragma unroll
                    for (int blk = 0; blk < 4; ++blk)
#pragma unroll
                        for (int r = 0; r < 16; ++r) { o[blk][r] -= cb[(blk * 16 + r) * 64]; ss[r] += o[blk][r] * o[blk][r]; }
#pragma unroll
                    for (int r = 0; r < 16; ++r) {
                        ss[r] += sxor<1>(ss[r]); ss[r] += sxor<2>(ss[r]); ss[r] += sxor<4>(ss[r]); ss[r] += sxor<8>(ss[r]); ss[r] += sxor<16>(ss[r]);
                        ss[r] = 0.8f / sqrtf(ss[r] * (1.0f / 128) + EPS); }
                    unsigned voffm = (unsigned)((4 * hi * DM + r32f) * 2); asm volatile("" : "+v"(voffm));
                    const char* mbase = (const char*)(MIXED + ((size_t)(b * SEQ + q0 + wq * 32)) * DM + h * 128);
#pragma unroll
                    for (int blk = 0; blk < 4; ++blk) { const float gsub = SM[SM_SUBLN + blk * 32 + r32f];
#pragma unroll
                        for (int r = 0; r < 16; ++r) *(bf16_t*)(mbase + (size_t)(((r & 3) + 8 * (r >> 2)) * DM + blk * 32) * 2 + voffm) = (bf16_t)f2bf(o[blk][r] * ss[r] * gsub); }
                }
                __syncthreads();
            }
        }
        {
            int tidm = wave * 64 + LANE_ID(); asm volatile("" : "+v"(tidm));
            const int tid = tidm, lane = tid & 63, r32 = lane & 31, hi = lane >> 5;
            LAS float* wsf = (LAS float*)(lds + DA_WSF) + wave * 32;
#ifndef MEM_REPS
#define MEM_REPS 1
#endif
            for (int u_ = blockIdx.x; u_ < 256 * MEM_REPS; u_ += G) {
                const int u = u_ & 255, hm = u & 3, b = (u >> 2) & 1, qb = u >> 3;
#pragma unroll
                for (int i = 0; i < 4; ++i) { const int idx = tid + 512 * i;
                    { const int row = idx >> 3, ch = idx & 7; *(LAS u32x4*)(lds + row * KST + ch * 16) = *(const u32x4*)(MK + ((size_t)(b * NMEM + row)) * 256 + hm * 64 + ch * 8); }
                    { const int d = idx >> 5, ch = idx & 31; *(LAS u32x4*)(lds + MA_VT + d * MA_VST + ch * 16) = *(const u32x4*)(MVT + ((size_t)((b * 4 + hm) * 64 + d)) * NMEM + ch * 8); } }
                const int row0 = b * SEQ + qb * 256 + wave * 32;
                bf16x8 qr[4];
                { const bf16_t* qp = MQ + ((size_t)(row0 + r32)) * 256 + hm * 64 + hi * 8;
#pragma unroll
                  for (int ds = 0; ds < 4; ++ds) qr[ds] = *(const bf16x8*)(qp + ds * 16); }
                f32x16 o[2];
#pragma unroll
                for (int blk = 0; blk < 2; ++blk)
#pragma unroll
                    for (int r = 0; r < 16; ++r) o[blk][r] = 0.f;
                float m = -INFINITY, l = 0.f;
                __syncthreads();
                for (int t = 0; t < 4; ++t) attn_tile<2>(lds + t * 64 * KST, KST, lds + MA_VT + t * 128, MA_VST, qr, o, m, l, wsf, r32, hi);
                { const float inv = 1.0f / half_sum(l);
                  asm volatile("" ::: "memory");
                  if (hi == 0) wsf[r32] = inv;
                  asm volatile("" ::: "memory");
                  unsigned voffm = (unsigned)((4 * hi * DM + r32) * 2); asm volatile("" : "+v"(voffm));
                  const char* mbase = (const char*)(MIXED + (size_t)row0 * DM + 768 + hm * 64);
#pragma unroll
                  for (int r = 0; r < 16; ++r) { const float sc = wsf[crow(r, hi)]; const char* rb = mbase + (size_t)(((r & 3) + 8 * (r >> 2)) * DM) * 2;
                      *(bf16_t*)(rb + voffm) = (bf16_t)f2bf(o[0][r] * sc); *(bf16_t*)(rb + 64 + voffm) = (bf16_t)f2bf(o[1][r] * sc); } }
                __syncthreads();
            }
        }
#endif
        {
            int tidc = wave * 64 + LANE_ID(); asm volatile("" : "+v"(tidc));
            const int tid = tidc, lane = tid & 63;
            bf16_t* Gs = (bf16_t*)lds_raw;
            float* Y = (float*)(lds_raw + 49152);
            const float* dw_w = SM + SM_DWW; const float* dw_b = SM + SM_DWB; const float* ln_g = SM + SM_LNG; const float* ln_b = SM + SM_LNB;
            #ifndef CONV_REPS
#define CONV_REPS 1
#endif
            for (int unit_ = blockIdx.x; unit_ < MTOK / 64 * CONV_REPS; unit_ += G) {
                const int unit = unit_ & (MTOK / 64 - 1), t0 = unit * 64, bstart = t0 & ~(SEQ - 1);
                __syncthreads();
                for (int c = tid; c < 94 * 32; c += 512) { const int r = c >> 5, cc = c & 31, t = t0 - 30 + r;
                    u32x4 v = {0u, 0u, 0u, 0u}; if (t >= bstart) v = *(const u32x4*)(Gb + (size_t)t * 256 + cc * 8);
                    *(u32x4*)(Gs + r * 256 + cc * 8) = v; }
                __syncthreads();
                { const int cp = tid & 127, tq = tid >> 7; float w0[31], w1[31];
#pragma unroll
                    for (int j = 0; j < 31; ++j) { w0[j] = dw_w[j * 256 + 2 * cp]; w1[j] = dw_w[j * 256 + 2 * cp + 1]; }
                    const float bias0 = dw_b[2 * cp], bias1 = dw_b[2 * cp + 1];
                    const unsigned* Gs32 = (const unsigned*)Gs;
                    for (int tt = 0; tt < 16; ++tt) { const int t = tq * 16 + tt; float a0 = bias0, a1 = bias1;
#pragma unroll
                        for (int j = 0; j < 31; ++j) { const unsigned g2 = Gs32[(t + j) * 128 + cp];
                            a0 += __builtin_bit_cast(float, g2 << 16) * w0[j]; a1 += __builtin_bit_cast(float, g2 & 0xffff0000u) * w1[j]; }
                        *(f32x2_t*)(Y + t * 256 + 2 * cp) = (f32x2_t){a0, a1}; } }
                __syncthreads();
                { f32x4 v[8]; float sm[8], sq[8];
#pragma unroll
                  for (int tt = 0; tt < 8; ++tt) { v[tt] = *(const f32x4*)(Y + (wave * 8 + tt) * 256 + lane * 4); sm[tt] = (v[tt].x + v[tt].y) + (v[tt].z + v[tt].w); }
#define RED8(a) do { _Pragma("unroll") for (int tt = 0; tt < 8; ++tt) a[tt] += sxor<1>(a[tt]); _Pragma("unroll") for (int tt = 0; tt < 8; ++tt) a[tt] += sxor<2>(a[tt]); \
                     _Pragma("unroll") for (int tt = 0; tt < 8; ++tt) a[tt] += sxor<4>(a[tt]); _Pragma("unroll") for (int tt = 0; tt < 8; ++tt) a[tt] += sxor<8>(a[tt]); \
                     _Pragma("unroll") for (int tt = 0; tt < 8; ++tt) a[tt] += sxor<16>(a[tt]); _Pragma("unroll") for (int tt = 0; tt < 8; ++tt) a[tt] = hsum32(a[tt]); } while (0)
                  RED8(sm);
#pragma unroll
                  for (int tt = 0; tt < 8; ++tt) { v[tt] = v[tt] - sm[tt] * (1.0f / 256); sq[tt] = (v[tt].x * v[tt].x + v[tt].y * v[tt].y) + (v[tt].z * v[tt].z + v[tt].w * v[tt].w); }
                  RED8(sq);
#undef RED8
                  const f32x4 gg = *(const f32x4*)(ln_g + lane * 4), bb = *(const f32x4*)(ln_b + lane * 4);
#pragma unroll
                  for (int tt = 0; tt < 8; ++tt) { const float rstd = 1.0f / sqrtf(sq[tt] * (1.0f / 256) + EPS);
                      const f32x4 y = v[tt] * rstd * gg + bb;
                      u32x2 wv; wv.x = pk2(silu_f(y.x), silu_f(y.y)); wv.y = pk2(silu_f(y.z), silu_f(y.w));
                      *(u32x2*)(MIXED + (size_t)(t0 + wave * 8 + tt) * DM + 512 + lane * 4) = wv; } }
            }
            __syncthreads();
        }
    }
#endif
    GRID_BAR();
#ifndef NO_P5
    { pg8::Gemm g{MIXED, W_OUT, MTOK, DM, DM}; pg8::StaticOrder S; S.init(MTOK, DM, G, (int)blockIdx.x);
      EpiExch<false> E{nullptr, AB, RN1, 1.0f, nullptr, nullptr, AB, RN2, (float*)(ws + WS_XBUF) + (size_t)MTOK * 4, (unsigned*)(ws + WS_CTL + CTL_CNT) + CTL_BANK};
      pg8::gemm_phase<EpiExch<false>, pg8::StaticOrder, false, true>(lds, g, S, E, wave); }
#endif
    GRID_BAR();
#ifndef NO_P6
    { pg8::Gemm g{AB, W_GU2, MTOK, 2 * DFF, DM}; pg8::StaticOrder S; S.init(MTOK, 2 * DFF, G, (int)blockIdx.x); EpiSwiGLU E{ACT, nullptr};
      pg8::gemm_phase<EpiSwiGLU, pg8::StaticOrder, true, true>(lds, g, S, E, wave);
#ifdef P6_TWICE
      pg8::gemm_phase<EpiSwiGLU, pg8::StaticOrder, true, true>(lds, g, S, E, wave);
#endif
    }
#endif
    GRID_BAR();
#ifndef NO_P7
    { pg8::Gemm g{ACT, W_D2, MTOK, DM, DFF}; pg8::StaticOrder S; S.init(MTOK, DM, G, (int)blockIdx.x);
      EpiExch<false> E{nullptr, AB, RN2, 0.5f, H, (const float*)(ws + WS_SMALL) + SM_FNG, nullptr, nullptr, (float*)(ws + WS_XBUF) + (size_t)MTOK * 8, (unsigned*)(ws + WS_CTL + CTL_CNT) + 2 * CTL_BANK};
      pg8::gemm_phase<EpiExch<false>, pg8::StaticOrder, false, true>(lds, g, S, E, wave); }
#endif
#if defined(CG_SYNC_AT_END)
    grid.sync();
#endif
}

extern "C" void kernel_launch(void* const* d_in, const int* in_sizes, int n_in, void* d_out, int out_size, void* d_ws, size_t ws_size, hipStream_t stream) {
    static int grid_blocks = 0;
    if (grid_blocks == 0) {
        if (n_in != 25 || ws_size < WS_END) { fprintf(stderr, "kernel_launch: unexpected inputs (n_in %d, ws %zu)\n", n_in, ws_size); grid_blocks = -1; return; }
        int dev = 0, cus = 0, per_cu = 0;
        hipGetDevice(&dev); hipDeviceGetAttribute(&cus, hipDeviceAttributeMultiprocessorCount, dev);
        if (hipFuncSetAttribute((const void*)fwd_megakernel, hipFuncAttributeMaxDynamicSharedMemorySize, LDS_BYTES) != hipSuccess) fprintf(stderr, "kernel_launch: hipFuncSetAttribute failed\n");
        if (hipOccupancyMaxActiveBlocksPerMultiprocessor(&per_cu, (const void*)fwd_megakernel, 512, LDS_BYTES) != hipSuccess || per_cu < 1) { fprintf(stderr, "kernel_launch: occupancy query failed (%d)\n", per_cu); per_cu = 1; }
        (void)hipGetLastError();
        grid_blocks = cus * 1;
        if (grid_blocks != 256) { fprintf(stderr, "kernel_launch: built for a 256-CU device (one 256x256 unit per workgroup in the fused final phase), found %d CUs; nothing launched\n", cus); grid_blocks = -1; return; }
        fprintf(stderr, "kernel_launch: cus %d per_cu %d grid %d\n", cus, per_cu, grid_blocks);
    }
    if (grid_blocks < 0) return;
    if (hipMemsetAsync((char*)d_ws + WS_CTL, 0, CTL_BYTES, stream) != hipSuccess) { fprintf(stderr, "kernel_launch: memset failed\n"); return; }
    Params p{};
    for (int i = 0; i < 25; ++i) p.in[i] = (const float*)d_in[i];
    p.out = (float*)d_out; p.ws = (unsigned char*)d_ws;
    void* args[] = {&p};
    hipError_t e = hipLaunchCooperativeKernel((const void*)fwd_megakernel, dim3(grid_blocks), dim3(512), args, LDS_BYTES, stream);
    if (e != hipSuccess) fprintf(stderr, "cooperative launch failed: %s (grid %d)\n", hipGetErrorString(e), grid_blocks);
}
```

```cpp
#include <hip/hip_runtime.h>
#include <hip/hip_cooperative_groups.h>
#include <cstdio>
#include <cstdint>
namespace cg = cooperative_groups;
namespace pg8 {
#define PG8_LAS __attribute__((address_space(3)))
typedef unsigned short bf16_t;
typedef short bf16x8 __attribute__((ext_vector_type(8)));
typedef float f32x4 __attribute__((ext_vector_type(4)));
typedef unsigned u32x4 __attribute__((ext_vector_type(4)));
constexpr int BM = 256, BK = 64, HALF = 128, HTB = HALF * BK * 2  , STAGE_BYTES = 8 * HTB, NXCD = 8, WGM = 8;

__host__ __device__ __forceinline__ int lds_byte(int r, int c) { const int st = (r >> 4) * 2 + (c >> 5), rr = r & 15, cc = c & 31, ob = rr * 64 + cc * 2; return st * 1024 + (ob ^ (((ob >> 9) & 1) << 5)); }
__host__ __device__ __forceinline__ void stage_rc(int b, int& R, int& C) { const int st = b / 1024, sb = b % 1024, swz = sb ^ (((sb >> 9) & 1) << 5); R = (st >> 1) * 16 + swz / 64; C = (st & 1) * 32 + (swz % 64) / 2; }
__host__ __device__ __forceinline__ int perm32(int rho) { const int n = rho >> 4, i = rho & 15; return 8 * (i >> 2) + 4 * n + (i & 3); }

struct Unit { int pm, pn; };
struct Gemm { const bf16_t* A; const bf16_t* Bt; int M, N, K; };

struct StaticOrder {
    int nM, nN, nwg, G, c;
    __host__ __device__ void init(int M, int N, int G_, int c_) { nM = M / BM; nN = N / BM; nwg = nM * nN; G = G_; c = c_; }
    __host__ __device__ bool next(int i, Unit& u) const {
        const long L = (long)i * G + c; if (L >= nwg) return false;
        int wgid = (int)L; { const int q = nwg / NXCD, r = nwg % NXCD, xcd = wgid % NXCD, off = wgid / NXCD; wgid = (xcd < r ? xcd * (q + 1) : r * (q + 1) + (xcd - r) * q) + off; }
        const int nig = WGM * nN, gid = wgid / nig, fm = gid * WGM, gsz = (nM - fm) < WGM ? (nM - fm) : WGM;
        u.pm = fm + ((wgid % nig) % gsz); u.pn = (wgid % nig) / gsz; return true;
    }
    __device__ __forceinline__ void a_ready(const Unit&) const {}
    __device__ __forceinline__ void done(const Unit&) const {}
};

__device__ __forceinline__ unsigned cvt_pk_bf16(float lo, float hi) { unsigned r; asm volatile("v_cvt_pk_bf16_f32 %0, %1, %2" : "=v"(r) : "v"(lo), "v"(hi)); return r; }
typedef float f32x2 __attribute__((ext_vector_type(2)));
template <class Epi, class Sched, bool ALIGN_EPI = false, bool SP2 = false>
__device__ __forceinline__ void gemm_phase(PG8_LAS unsigned char* lds, const Gemm g, const Sched& S, const Epi& E, int wave_id) {
    int tid_; asm volatile("v_mbcnt_lo_u32_b32 %0, -1, 0\n\tv_mbcnt_hi_u32_b32 %0, -1, %0" : "=v"(tid_)); tid_ += wave_id * 64;
    const int tid = tid_, wid = __builtin_amdgcn_readfirstlane(tid >> 6), lane = tid & 63, wr = wid >> 2, wc = wid & 3, fr = lane & 15, fq = lane >> 4;
    const int K = g.K, nt = K / BK;
    unsigned voffA[2], voffB[2];
#pragma unroll
    for (int i = 0; i < 2; ++i) { int R, C; stage_rc(tid * 16 + i * 8192, R, C); const int Rb = Epi::PERM ? ((R & ~31) + perm32(R & 31)) : R;
        voffA[i] = (unsigned)(R * K + C) * 2u; voffB[i] = (unsigned)(Rb * K + C) * 2u; }
    const size_t kstep = (size_t)(BK * 2);
    const size_t hstep = (size_t)HALF * K * 2;
    const size_t tstep = 2 * hstep;
    const unsigned ldsw = (unsigned)wid * 1024u;
    const int aoff = lds_byte(wr * 64 + fr, fq * 8), boff = lds_byte(wc * 32 + fr, fq * 8);
#define PG8_SA(b, h) (((b) * 2 + (h)) * HTB)
#define PG8_SB(b, h) ((4 + (b) * 2 + (h)) * HTB)
#define PG8_STAGE(bufoff, gbase, voff) do { _Pragma("unroll") for (int _i = 0; _i < 2; ++_i) \
        __builtin_amdgcn_global_load_lds((const unsigned*)((const char*)(gbase) + (voff)[_i]), (PG8_LAS unsigned*)(lds + (bufoff) + ldsw + _i * 8192), 16, 0, 0); } while (0)
#define PG8_LDA(dst, b, h) do { _Pragma("unroll") for (int m = 0; m < 4; ++m) _Pragma("unroll") for (int k = 0; k < 2; ++k) dst[m][k] = *(const PG8_LAS bf16x8*)(lds + PG8_SA(b, h) + aoff + m * 2048 + k * 1024); } while (0)
#define PG8_LDB(dst, b, h) do { _Pragma("unroll") for (int n = 0; n < 2; ++n) _Pragma("unroll") for (int k = 0; k < 2; ++k) dst[n][k] = *(const PG8_LAS bf16x8*)(lds + PG8_SB(b, h) + boff + n * 2048 + k * 1024); } while (0)
#define PG8_MMA(ai, bj, At, Bt) do { __builtin_amdgcn_s_setprio(1); _Pragma("unroll") for (int m = 0; m < 4; ++m) _Pragma("unroll") for (int n = 0; n < 2; ++n) _Pragma("unroll") for (int k = 0; k < 2; ++k) \
        acc[ai][bj][m][n] = __builtin_amdgcn_mfma_f32_16x16x32_bf16(Bt[n][k], At[m][k], acc[ai][bj][m][n], 0, 0, 0); __builtin_amdgcn_s_setprio(0); } while (0)
#define PG8_WAIT_V(n) asm volatile("s_waitcnt vmcnt(" #n ")" ::: "memory")
#define PG8_WAIT_L(n) asm volatile("s_waitcnt lgkmcnt(" #n ")" ::: "memory")
#define PG8_BAR __builtin_amdgcn_s_barrier()
#define PG8_SCHED __builtin_amdgcn_sched_barrier(0)
    Unit cur, nxt; int ui = 0;
    if (!S.next(0, cur)) return;
    f32x4 acc[2][2][4][2];
#pragma unroll
    for (int a = 0; a < 2; ++a)
#pragma unroll
        for (int b = 0; b < 2; ++b)
#pragma unroll
            for (int m = 0; m < 4; ++m)
#pragma unroll
                for (int n = 0; n < 2; ++n) acc[a][b][m][n] = (f32x4){0.f, 0.f, 0.f, 0.f};
    bf16x8 At[4][2], B0[2][2], B1[2][2];
    const char* cA = (const char*)g.A + (size_t)cur.pm * tstep; const char* cB = (const char*)g.Bt + (size_t)cur.pn * tstep;
    S.a_ready(cur);
    if constexpr (SP2) {
        PG8_STAGE(PG8_SB(0, 0), cB, voffB); PG8_STAGE(PG8_SB(0, 1), cB + hstep, voffB); PG8_STAGE(PG8_SA(0, 0), cA, voffA); PG8_STAGE(PG8_SA(0, 1), cA + hstep, voffA);
        if (wr == 1) PG8_BAR;
        PG8_WAIT_V(2); PG8_BAR;
        PG8_STAGE(PG8_SB(1, 0), cB + kstep, voffB); PG8_STAGE(PG8_SA(1, 0), cA + kstep, voffA); PG8_STAGE(PG8_SB(1, 1), cB + hstep + kstep, voffB);
        PG8_WAIT_V(6); PG8_BAR;
    } else {
        PG8_STAGE(PG8_SB(0, 0), cB, voffB); PG8_STAGE(PG8_SA(0, 0), cA, voffA); PG8_STAGE(PG8_SB(0, 1), cB + hstep, voffB); PG8_STAGE(PG8_SA(0, 1), cA + hstep, voffA);
        if (wr == 1) PG8_BAR;
        PG8_WAIT_V(4); PG8_BAR;
        PG8_STAGE(PG8_SB(1, 0), cB + kstep, voffB); PG8_STAGE(PG8_SA(1, 0), cA + kstep, voffA); PG8_STAGE(PG8_SB(1, 1), cB + hstep + kstep, voffB);
        PG8_WAIT_V(6); PG8_BAR;
    }
    for (;;) {
        const bool has_next = S.next(ui + 1, nxt);
        const char* nA = has_next ? (const char*)g.A + (size_t)nxt.pm * tstep : cA; const char* nB = has_next ? (const char*)g.Bt + (size_t)nxt.pn * tstep : cB;
        for (int t = 0; t < nt; t += 2) {
            const bool last = (t == nt - 2);
            const char* a1 = cA + (size_t)(t + 1) * kstep;
            const char* a2 = last ? nA : cA + (size_t)(t + 2) * kstep; const char* b2 = last ? nB : cB + (size_t)(t + 2) * kstep;
            const char* a3 = a2 + kstep; const char* b3 = b2 + kstep;
            if (last && has_next) S.a_ready(nxt);
            if constexpr (SP2) {
            PG8_LDB(B0, 0, 0); PG8_LDB(B1, 0, 1); PG8_SCHED; PG8_LDA(At, 0, 0); PG8_STAGE(PG8_SA(1, 1), a1 + hstep, voffA);
            PG8_WAIT_V(8); PG8_WAIT_L(0); PG8_BAR; PG8_MMA(0, 0, At, B0); PG8_MMA(0, 1, At, B1); PG8_BAR; PG8_SCHED;
            PG8_LDA(At, 0, 1); PG8_STAGE(PG8_SB(0, 0), b2, voffB); PG8_STAGE(PG8_SB(0, 1), b2 + hstep, voffB); PG8_STAGE(PG8_SA(0, 0), a2, voffA);
            PG8_WAIT_V(8); PG8_WAIT_L(0); PG8_BAR; PG8_MMA(1, 0, At, B0); PG8_MMA(1, 1, At, B1); PG8_BAR; PG8_SCHED;
            PG8_LDB(B0, 1, 0); PG8_LDB(B1, 1, 1); PG8_SCHED; PG8_LDA(At, 1, 0); PG8_STAGE(PG8_SA(0, 1), a2 + hstep, voffA);
            PG8_WAIT_V(8); PG8_WAIT_L(0); PG8_BAR; PG8_MMA(0, 0, At, B0); PG8_MMA(0, 1, At, B1); PG8_BAR; PG8_SCHED;
            PG8_LDA(At, 1, 1); PG8_STAGE(PG8_SB(1, 0), b3, voffB); PG8_STAGE(PG8_SB(1, 1), b3 + hstep, voffB); PG8_STAGE(PG8_SA(1, 0), a3, voffA);
            PG8_WAIT_V(8); PG8_WAIT_L(0); PG8_BAR; PG8_MMA(1, 0, At, B0); PG8_MMA(1, 1, At, B1); PG8_BAR; PG8_SCHED;
            } else {
            PG8_LDB(B0, 0, 0); PG8_SCHED; PG8_LDA(At, 0, 0); PG8_STAGE(PG8_SA(1, 1), a1 + hstep, voffA);
            PG8_WAIT_L(8); PG8_BAR; PG8_WAIT_L(0); PG8_MMA(0, 0, At, B0); PG8_BAR; PG8_SCHED;
            PG8_LDB(B1, 0, 1); PG8_STAGE(PG8_SB(0, 0), b2, voffB);
            PG8_BAR; PG8_WAIT_L(0); PG8_MMA(0, 1, At, B1); PG8_BAR;
            PG8_LDA(At, 0, 1); PG8_STAGE(PG8_SA(0, 0), a2, voffA);
            PG8_BAR; PG8_WAIT_L(0); PG8_MMA(1, 0, At, B0); PG8_BAR; PG8_SCHED;
            PG8_STAGE(PG8_SB(0, 1), b2 + hstep, voffB);
            PG8_WAIT_V(6); PG8_BAR; PG8_MMA(1, 1, At, B1); PG8_BAR;
            PG8_LDB(B0, 1, 0); PG8_SCHED; PG8_LDA(At, 1, 0); PG8_STAGE(PG8_SA(0, 1), a2 + hstep, voffA);
            PG8_WAIT_L(8); PG8_BAR; PG8_WAIT_L(0); PG8_MMA(0, 0, At, B0); PG8_BAR; PG8_SCHED;
            PG8_LDB(B1, 1, 1); PG8_STAGE(PG8_SB(1, 0), b3, voffB);
            PG8_BAR; PG8_WAIT_L(0); PG8_MMA(0, 1, At, B1); PG8_BAR;
            PG8_LDA(At, 1, 1); PG8_STAGE(PG8_SA(1, 0), a3, voffA);
            PG8_BAR; PG8_WAIT_L(0); PG8_MMA(1, 0, At, B0); PG8_BAR; PG8_SCHED;
            PG8_STAGE(PG8_SB(1, 1), b3 + hstep, voffB);
            PG8_WAIT_V(6); PG8_BAR; PG8_MMA(1, 1, At, B1); PG8_BAR;
            }
        }
        if constexpr (ALIGN_EPI) { if (wr == 0) PG8_BAR; }
        if constexpr (!Epi::AFTER_DRAIN) { E(acc, cur, wr, wc, fr, fq); S.done(cur); }
        if (!has_next) break;
#pragma unroll
        for (int a = 0; a < 2; ++a)
#pragma unroll
            for (int b = 0; b < 2; ++b)
#pragma unroll
                for (int m = 0; m < 4; ++m)
#pragma unroll
                    for (int n = 0; n < 2; ++n) acc[a][b][m][n] = (f32x4){0.f, 0.f, 0.f, 0.f};
        cur = nxt; cA = nA; cB = nB; ++ui;
        if constexpr (ALIGN_EPI) { if (wr == 1) PG8_BAR; }
    }
    PG8_WAIT_V(0);
    if constexpr (!ALIGN_EPI) { if (wr == 0) PG8_BAR; }
    PG8_BAR;
    if constexpr (Epi::AFTER_DRAIN) { E.fused(acc, cur, wr, wc, fr, fq, lds, wid, lane); S.done(cur); }
#undef PG8_SA
#undef PG8_SB
#undef PG8_STAGE
#undef PG8_LDA
#undef PG8_LDB
#undef PG8_MMA
#undef PG8_WAIT_V
#undef PG8_WAIT_L
#undef PG8_BAR
#undef PG8_SCHED
}
}

#define LAS __attribute__((address_space(3)))
__device__ __forceinline__ int lane_id_v() { int l; asm volatile("v_mbcnt_lo_u32_b32 %0, -1, 0\n\tv_mbcnt_hi_u32_b32 %0, -1, %0" : "=v"(l)); return l; }
#define LANE_ID() lane_id_v()
template <int M> __device__ __forceinline__ float sxor(float v) { return __builtin_bit_cast(float, __builtin_amdgcn_ds_swizzle(__builtin_bit_cast(int, v), (M << 10) | 0x1f)); }
__device__ __forceinline__ void swap32(float& a, float& b) { asm volatile("s_nop 1\n\tv_permlane32_swap_b32 %0, %1\n\ts_nop 3" : "+v"(a), "+v"(b)); }
__device__ __forceinline__ float hsum32(float v) { float a = v, b = v; swap32(a, b); return a + b; }
typedef unsigned short bf16_t;
typedef pg8::f32x4 f32x4;
typedef pg8::u32x4 u32x4;
typedef unsigned u32x2 __attribute__((ext_vector_type(2)));
constexpr int SEQ = 8192, NB = 2, MTOK = NB * SEQ, DM = 1024, DFF = 2816, NMEM = 256, INW = 2304;
constexpr float EPS = 1e-5f;
constexpr float QSCALE = 0.125f * 1.4426950408889634f;
constexpr size_t MiB = 1u << 20;
constexpr size_t WS_WGU1 = 0, WS_WD1 = 11 * MiB, WS_WIN = 16 * MiB + MiB / 2, WS_WMKV = 21 * MiB, WS_WOUT = 22 * MiB, WS_WGU2 = 24 * MiB, WS_WD2 = 35 * MiB;
constexpr size_t WS_ROPE = 41 * MiB, WS_SSQ = 43 * MiB, WS_MEMN = 44 * MiB, WS_MK = 45 * MiB, WS_MVT = 45 * MiB + MiB / 4;
constexpr size_t WS_SMALL = 45 * MiB + MiB / 2;
constexpr int SM_LAM = 0, SM_SUBLN = 256, SM_DWW = 384, SM_DWB = SM_DWW + 31 * 256, SM_LNG = SM_DWB + 256, SM_LNB = SM_LNG + 256, SM_FNG = SM_LNB + 256, SM_END = SM_FNG + 1024;
constexpr size_t WS_CTL = 45 * MiB + 3 * MiB / 4, CTL_BYTES = 65536, CTL_CNT = 16384, CTL_BANK = 4096;
constexpr size_t WS_AB = 46 * MiB, WS_ACT = 78 * MiB, WS_MIXED = 166 * MiB, WS_XBUF = 198 * MiB  , WS_END = 199 * MiB;
constexpr size_t WS_Q = WS_ACT, WS_K = WS_ACT + 16 * MiB, WS_VT = WS_ACT + 32 * MiB, WS_G = WS_ACT + 48 * MiB, WS_MQ = WS_ACT + 56 * MiB;
constexpr int LDS_BYTES = 131072 + 1024;

#ifndef DEFER_W
#define DEFER_W 1
#endif
struct Params { const float* in[25]; float* out; unsigned char* ws; };

__device__ __forceinline__ unsigned f2bf(float f) { unsigned u = __builtin_bit_cast(unsigned, f); return (u + 0x7fffu + ((u >> 16) & 1u)) >> 16; }
__device__ __forceinline__ float bf2f(unsigned short h) { return __builtin_bit_cast(float, (unsigned)h << 16); }
__device__ __forceinline__ unsigned pk2(float lo, float hi) { return pg8::cvt_pk_bf16(lo, hi); }
__device__ __forceinline__ int perm16(int k) { return (k & 3) | (((k >> 3) & 1) << 2) | (((k >> 2) & 1) << 3); }
__device__ __forceinline__ float wave_sum(float v) {
    v += sxor<1>(v); v += sxor<2>(v); v += sxor<4>(v); v += sxor<8>(v); v += sxor<16>(v); v = hsum32(v);
    return v;
}
__device__ __forceinline__ float row_rstd(const float* ssq, int row) {
    const f32x4* p = (const f32x4*)(ssq + (size_t)row * 16);
    const f32x4 a = p[0], b = p[1], c = p[2], d = p[3];
    const float s = ((a.x + a.y) + (a.z + a.w)) + ((b.x + b.y) + (b.z + b.w)) + ((c.x + c.y) + (c.z + c.w)) + ((d.x + d.y) + (d.z + d.w));
    return 1.0f / sqrtf(s * (1.0f / DM) + EPS);
}
__device__ __forceinline__ float row_rstd_q(const float* ssq, int row, int fq) {
    const f32x4 a = ((const f32x4*)(ssq + (size_t)row * 16))[fq];
    float s = (a.x + a.y) + (a.z + a.w);
    s += sxor<16>(s); s = hsum32(s);
    return __builtin_amdgcn_rsqf(s * (1.0f / DM) + EPS);
}
__device__ __forceinline__ float silu_f(float g) { return g * __builtin_amdgcn_rcpf(1.0f + __expf(-g)); }

__device__ __forceinline__ void rows_rstd8(const float* ssq, int row0, int fq, float (&rs)[8]) {
    f32x4 pv[8];
#pragma unroll
    for (int i = 0; i < 8; ++i) pv[i] = ((const f32x4*)(ssq + (size_t)(row0 + (i >> 2) * 128 + (i & 3) * 16) * 16))[fq];
#pragma unroll
    for (int i = 0; i < 8; ++i) { float t = (pv[i].x + pv[i].y) + (pv[i].z + pv[i].w); t += sxor<16>(t); t = hsum32(t); rs[i] = __builtin_amdgcn_rsqf(t * (1.0f / DM) + EPS); }
}

#ifndef EPI_FENCE
#define EPI_FENCE(m) ((m) == 3)
#endif
struct EpiSwiGLU {
    static constexpr bool PERM = true, AFTER_DRAIN = false;
    bf16_t* O; const float* ssq;
    __device__ __forceinline__ void operator()(const f32x4 (&acc)[2][2][4][2], const pg8::Unit& u, int wr, int wc, int fr, int fq) const {
        asm volatile("" : "+v"(fr), "+v"(fq));
        const int row0 = u.pm * 256 + wr * 64 + fr, col0 = u.pn * 128 + wc * 32 + fq * 8;
        float rs8[8];
        if (ssq) rows_rstd8(ssq, row0, fq, rs8); else {
#pragma unroll
            for (int i = 0; i < 8; ++i) rs8[i] = 1.0f; }
#pragma unroll
        for (int ai = 0; ai < 2; ++ai)
#pragma unroll
            for (int m = 0; m < 4; ++m) {
                const int row = row0 + ai * 128 + m * 16;
                const float rs = rs8[ai * 4 + m];
                float v[8];
#pragma unroll
                for (int n = 0; n < 2; ++n)
#pragma unroll
                    for (int i = 0; i < 4; ++i) v[n * 4 + i] = silu_f(acc[ai][0][m][n][i] * rs) * (acc[ai][1][m][n][i] * rs);
                u32x4 w; w.x = pk2(v[0], v[1]); w.y = pk2(v[2], v[3]); w.z = pk2(v[4], v[5]); w.w = pk2(v[6], v[7]);
                *(u32x4*)(O + (size_t)row * DFF + col0) = w;
                if (EPI_FENCE(m)) asm volatile("" ::: "memory");
            }
    }
};
struct EpiResid {
    static constexpr bool PERM = true, AFTER_DRAIN = false;
    const float* basef; const bf16_t* baseb; float* H; bf16_t* HB; float* ssq; float alpha;
    __device__ __forceinline__ void row_part(const f32x4& a0, const f32x4& a1, const f32x4& b0, const f32x4& b1, size_t off, float& ss) const {
        const f32x4 h0 = b0 + a0 * alpha, h1 = b1 + a1 * alpha;
        if (H) { *(f32x4*)(H + off) = h0; *(f32x4*)(H + off + 4) = h1; }
        if (HB) { u32x4 w; w.x = pk2(h0.x, h0.y); w.y = pk2(h0.z, h0.w); w.z = pk2(h1.x, h1.y); w.w = pk2(h1.z, h1.w); *(u32x4*)(HB + off) = w; }
        ss += (h0.x * h0.x + h0.y * h0.y) + (h0.z * h0.z + h0.w * h0.w) + (h1.x * h1.x + h1.y * h1.y) + (h1.z * h1.z + h1.w * h1.w);
    }
    __device__ __forceinline__ void row_end(float ss, int row, int pn, int wc, int fq) const {
        if (ssq) { ss += sxor<16>(ss); ss = hsum32(ss); if (fq == 0) ssq[(size_t)row * 16 + pn * 4 + wc] = ss; }
    }
    __device__ __forceinline__ void operator()(const f32x4 (&acc)[2][2][4][2], const pg8::Unit& u, int wr, int wc, int fr, int fq) const {
        asm volatile("" : "+v"(fr), "+v"(fq));
        const int row0 = u.pm * 256 + wr * 64 + fr, col0 = u.pn * 256 + wc * 32 + fq * 8;
        if (basef) {
#pragma unroll
            for (int g = 0; g < 4; ++g) {
                f32x4 pre[2][2][2];
#pragma unroll
                for (int k = 0; k < 2; ++k)
#pragma unroll
                    for (int bj = 0; bj < 2; ++bj) { const size_t off = (size_t)(row0 + (g >> 1) * 128 + ((g & 1) * 2 + k) * 16) * DM + col0 + bj * 128;
                        pre[k][bj][0] = *(const f32x4*)(basef + off); pre[k][bj][1] = *(const f32x4*)(basef + off + 4); }
#pragma unroll
                for (int k = 0; k < 2; ++k) { const int ai = g >> 1, m = (g & 1) * 2 + k, row = row0 + ai * 128 + m * 16; float ss = 0.f;
#pragma unroll
                    for (int bj = 0; bj < 2; ++bj) row_part(acc[ai][bj][m][0], acc[ai][bj][m][1], pre[k][bj][0], pre[k][bj][1], (size_t)row * DM + col0 + bj * 128, ss);
                    row_end(ss, row, u.pn, wc, fq); }
                asm volatile("" ::: "memory");
            }
        } else {
#pragma unroll
            for (int ai = 0; ai < 2; ++ai) {
                u32x4 pre[4][2];
#pragma unroll
                for (int m = 0; m < 4; ++m)
#pragma unroll
                    for (int bj = 0; bj < 2; ++bj) pre[m][bj] = *(const u32x4*)(baseb + (size_t)(row0 + ai * 128 + m * 16) * DM + col0 + bj * 128);
#pragma unroll
                for (int m = 0; m < 4; ++m) { const int row = row0 + ai * 128 + m * 16; float ss = 0.f;
#pragma unroll
                    for (int bj = 0; bj < 2; ++bj) { const u32x4 w = pre[m][bj];
                        const f32x4 b0 = (f32x4){__builtin_bit_cast(float, w.x << 16), __builtin_bit_cast(float, w.x & 0xffff0000u), __builtin_bit_cast(float, w.y << 16), __builtin_bit_cast(float, w.y & 0xffff0000u)};
                        const f32x4 b1 = (f32x4){__builtin_bit_cast(float, w.z << 16), __builtin_bit_cast(float, w.z & 0xffff0000u), __builtin_bit_cast(float, w.w << 16), __builtin_bit_cast(float, w.w & 0xffff0000u)};
                        row_part(acc[ai][bj][m][0], acc[ai][bj][m][1], b0, b1, (size_t)row * DM + col0 + bj * 128, ss); }
                    row_end(ss, row, u.pn, wc, fq); }
                asm volatile("" ::: "memory");
            }
        }
    }
};
template <bool F32BASE> struct EpiExch {
    static constexpr bool PERM = true, AFTER_DRAIN = true;
    const float* basef; const bf16_t* baseb; const float* rnin; float alpha; float* OUT; const float* gfin; bf16_t* HBN; float* rnout; float* xbuf; unsigned* cnt;
    __device__ __forceinline__ void fused(f32x4 (&acc)[2][2][4][2], const pg8::Unit& u, int wr, int wc, int fr, int fq, LAS unsigned char* lds, int wid, int lane) const {
        asm volatile("" : "+v"(fr), "+v"(fq), "+v"(lane));
        LAS float* Pp = (LAS float*)lds;
        LAS float* S = (LAS float*)(lds + 4096);
        const int col0 = u.pn * 256 + wc * 32 + fq * 8;
        const int rowl0 = wr * 64 + fr;
        if constexpr (F32BASE) {
            unsigned vofff = (unsigned)((rowl0 * DM + col0) * 4); asm volatile("" : "+v"(vofff));
#pragma unroll
            for (int g = 0; g < 8; ++g) {
                const int ai = g >> 2, m = g & 3; f32x4 pre[2][2];
#pragma unroll
                for (int bj = 0; bj < 2; ++bj) { const char* sb = (const char*)(basef + (size_t)(u.pm * 256 + ai * 128 + m * 16) * DM + bj * 128);
                    pre[bj][0] = __builtin_nontemporal_load((const f32x4*)(sb + vofff)); pre[bj][1] = __builtin_nontemporal_load((const f32x4*)(sb + vofff + 16)); }
                float ss = 0.f;
#pragma unroll
                for (int bj = 0; bj < 2; ++bj) { const f32x4 h0 = pre[bj][0] + acc[ai][bj][m][0] * alpha, h1 = pre[bj][1] + acc[ai][bj][m][1] * alpha;
                    acc[ai][bj][m][0] = h0; acc[ai][bj][m][1] = h1;
                    ss += (h0.x * h0.x + h0.y * h0.y) + (h0.z * h0.z + h0.w * h0.w) + (h1.x * h1.x + h1.y * h1.y) + (h1.z * h1.z + h1.w * h1.w); }
                ss += sxor<16>(ss); ss = hsum32(ss);
                if (fq == 0) Pp[(rowl0 + ai * 128 + m * 16) * 4 + wc] = ss;
                if (g & 1) asm volatile("" ::: "memory");
            }
        } else {
#pragma unroll
            for (int ai = 0; ai < 2; ++ai) {
                u32x4 pre[4][2]; float rn[4];
#pragma unroll
                for (int m = 0; m < 4; ++m) { const int row = u.pm * 256 + rowl0 + ai * 128 + m * 16; rn[m] = rnin ? rnin[row] : 1.0f;
#pragma unroll
                    for (int bj = 0; bj < 2; ++bj) pre[m][bj] = *(const u32x4*)(baseb + (size_t)row * DM + col0 + bj * 128); }
#pragma unroll
                for (int m = 0; m < 4; ++m) { float ss = 0.f;
#pragma unroll
                    for (int bj = 0; bj < 2; ++bj) {
                        const u32x4 w = pre[m][bj];
                        const f32x4 b0 = (f32x4){__builtin_bit_cast(float, w.x << 16), __builtin_bit_cast(float, w.x & 0xffff0000u), __builtin_bit_cast(float, w.y << 16), __builtin_bit_cast(float, w.y & 0xffff0000u)};
                        const f32x4 b1 = (f32x4){__builtin_bit_cast(float, w.z << 16), __builtin_bit_cast(float, w.z & 0xffff0000u), __builtin_bit_cast(float, w.w << 16), __builtin_bit_cast(float, w.w & 0xffff0000u)};
                        const f32x4 h0 = b0 * rn[m] + acc[ai][bj][m][0] * alpha, h1 = b1 * rn[m] + acc[ai][bj][m][1] * alpha;
                        acc[ai][bj][m][0] = h0; acc[ai][bj][m][1] = h1;
                        ss += (h0.x * h0.x + h0.y * h0.y) + (h0.z * h0.z + h0.w * h0.w) + (h1.x * h1.x + h1.y * h1.y) + (h1.z * h1.z + h1.w * h1.w);
                    }
                    ss += sxor<16>(ss); ss = hsum32(ss);
                    if (fq == 0) Pp[(rowl0 + ai * 128 + m * 16) * 4 + wc] = ss;
                }
                asm volatile("" ::: "memory");
            }
        }
        asm volatile("s_waitcnt lgkmcnt(0)" ::: "memory"); __builtin_amdgcn_s_barrier(); asm volatile("" ::: "memory");
        const int t = wid * 64 + lane;
        if (t < 256) { const f32x4 p = *(const LAS f32x4*)(Pp + t * 4);
            __hip_atomic_store(xbuf + (size_t)(u.pm * 256 + t) * 4 + u.pn, (p.x + p.y) + (p.z + p.w), __ATOMIC_RELAXED, __HIP_MEMORY_SCOPE_AGENT); }
        asm volatile("s_waitcnt vmcnt(0)" ::: "memory");
        if (lane == 0) __hip_atomic_fetch_add(cnt + 64 * u.pm, 1u, __ATOMIC_RELAXED, __HIP_MEMORY_SCOPE_AGENT);
        if (wid == 0) {
            unsigned spins = 0;
            while ((unsigned)__builtin_amdgcn_readfirstlane(__hip_atomic_load(cnt + 64 * u.pm, __ATOMIC_RELAXED, __HIP_MEMORY_SCOPE_AGENT)) < 32u) { __builtin_amdgcn_s_sleep(2); if (++spins > (1u << 22)) break; }
            __builtin_amdgcn_fence(__ATOMIC_ACQUIRE, "agent");
        }
        asm volatile("s_waitcnt vmcnt(0) lgkmcnt(0)" ::: "memory"); __builtin_amdgcn_s_barrier(); asm volatile("" ::: "memory");
        if (t < 256) { const float* sl = xbuf + (size_t)(u.pm * 256 + t) * 4; float q = 0.f;
#pragma unroll
            for (int k = 0; k < 4; ++k) q += __hip_atomic_load(sl + k, __ATOMIC_RELAXED, __HIP_MEMORY_SCOPE_AGENT);
            const float ms = q * (1.0f / DM) + EPS;
            S[t] = __builtin_amdgcn_rsqf(ms);
            if (rnout && u.pn == 0) rnout[u.pm * 256 + t] = sqrtf(ms); }
        asm volatile("s_waitcnt lgkmcnt(0)" ::: "memory"); __builtin_amdgcn_s_barrier(); asm volatile("" ::: "memory");
        if (OUT) {
#pragma unroll
            for (int bj = 0; bj < 2; ++bj) { const f32x4 g0 = *(const f32x4*)(gfin + col0 + bj * 128), g1 = *(const f32x4*)(gfin + col0 + bj * 128 + 4);
#pragma unroll
                for (int ai = 0; ai < 2; ++ai)
#pragma unroll
                    for (int m = 0; m < 4; ++m) { const int rl = rowl0 + ai * 128 + m * 16; const float rs = S[rl];
                        float* op = OUT + (size_t)(u.pm * 256 + rl) * DM + col0 + bj * 128;
                        *(f32x4*)op = acc[ai][bj][m][0] * rs * g0; *(f32x4*)(op + 4) = acc[ai][bj][m][1] * rs * g1; }
                asm volatile("" ::: "memory"); }
        } else {
#pragma unroll
            for (int ai = 0; ai < 2; ++ai)
#pragma unroll
                for (int m = 0; m < 4; ++m) { const int rl = rowl0 + ai * 128 + m * 16; const float rs = S[rl];
#pragma unroll
                    for (int bj = 0; bj < 2; ++bj) { const f32x4 a0 = acc[ai][bj][m][0] * rs, a1 = acc[ai][bj][m][1] * rs;
                        u32x4 w; w.x = pk2(a0.x, a0.y); w.y = pk2(a0.z, a0.w); w.z = pk2(a1.x, a1.y); w.w = pk2(a1.z, a1.w);
                        *(u32x4*)(HBN + (size_t)(u.pm * 256 + rl) * DM + col0 + bj * 128) = w; }
                    if (m & 1) asm volatile("" ::: "memory"); }
        }
    }
};
struct EpiInProj {
    static constexpr bool PERM = true, AFTER_DRAIN = false;
    const float* ssq; const float* ropec; const float* ropes; bf16_t *Q, *K, *VT, *G, *MQ;
    __device__ __forceinline__ void operator()(const f32x4 (&acc)[2][2][4][2], const pg8::Unit& u, int wr, int wc, int fr, int fq) const {
        asm volatile("" : "+v"(fr), "+v"(fq));
        const int row0 = u.pm * 256 + wr * 64 + fr; const int pn = u.pn;
        float rs8[8];
        if (ssq) rows_rstd8(ssq, row0, fq, rs8); else {
#pragma unroll
            for (int i = 0; i < 8; ++i) rs8[i] = 1.0f; }
        f32x4 rc[2][2], rsn[2][2];
#pragma unroll
        for (int ai = 0; ai < 2; ++ai)
#pragma unroll
            for (int m = 0; m < 4; ++m) {
                const int row = row0 + ai * 128 + m * 16;
                const float rs = rs8[ai * 4 + m];
                if (pn < 4) {
                    const int pos = row & (SEQ - 1);
                    const float sc = (pn < 2) ? QSCALE : 1.0f;
                    if ((m & 1) == 0) {
#pragma unroll
                        for (int k = 0; k < 2; ++k)
#pragma unroll
                            for (int n = 0; n < 2; ++n) { rc[k][n] = *(const f32x4*)(ropec + (pos + 16 * k) * 32 + fq * 8 + n * 4); rsn[k][n] = *(const f32x4*)(ropes + (pos + 16 * k) * 32 + fq * 8 + n * 4); } }
                    float o1[8], o2[8];
#pragma unroll
                    for (int n = 0; n < 2; ++n) {
                        const f32x4 c = rc[m & 1][n], s = rsn[m & 1][n];
#pragma unroll
                        for (int i = 0; i < 4; ++i) { const float x1 = acc[ai][0][m][n][i] * rs, x2 = acc[ai][1][m][n][i] * rs;
                            o1[n * 4 + i] = (x1 * c[i] - x2 * s[i]) * sc; o2[n * 4 + i] = (x2 * c[i] + x1 * s[i]) * sc; }
                    }
                    bf16_t* dst = ((pn < 2) ? Q : K) + (size_t)row * 512 + (pn & 1) * 256 + wc * 64 + fq * 8;
                    u32x4 w; w.x = pk2(o1[0], o1[1]); w.y = pk2(o1[2], o1[3]); w.z = pk2(o1[4], o1[5]); w.w = pk2(o1[6], o1[7]); *(u32x4*)dst = w;
                    w.x = pk2(o2[0], o2[1]); w.y = pk2(o2[2], o2[3]); w.z = pk2(o2[4], o2[5]); w.w = pk2(o2[6], o2[7]); *(u32x4*)(dst + 32) = w;
                } else if (pn < 6) {
                    const int b = u.pm >> 5, t = row & (SEQ - 1);
                    unsigned voff = (unsigned)((wc * 32 + fq * 8) * SEQ + ((t & ~15) | perm16(t & 15))); asm volatile("" : "+v"(voff));
#pragma unroll
                    for (int bj = 0; bj < 2; ++bj)
#pragma unroll
                        for (int n = 0; n < 2; ++n)
#pragma unroll
                            for (int i = 0; i < 4; ++i) { bf16_t* bp = VT + (size_t)((b * 4 + (pn - 4) * 2 + bj) * 128 + n * 4 + i) * SEQ;
                                bp[voff] = (bf16_t)f2bf(acc[ai][bj][m][n][i] * rs); }
                } else if (pn < 8) {
                    float v[8];
#pragma unroll
                    for (int n = 0; n < 2; ++n)
#pragma unroll
                        for (int i = 0; i < 4; ++i) { const float a = acc[ai][0][m][n][i] * rs, g = acc[ai][1][m][n][i] * rs; v[n * 4 + i] = a * __builtin_amdgcn_rcpf(1.0f + __expf(-g)); }
                    u32x4 w; w.x = pk2(v[0], v[1]); w.y = pk2(v[2], v[3]); w.z = pk2(v[4], v[5]); w.w = pk2(v[6], v[7]);
                    *(u32x4*)(G + (size_t)row * 256 + (pn - 6) * 128 + wc * 32 + fq * 8) = w;
                } else {
#pragma unroll
                    for (int bj = 0; bj < 2; ++bj) { const f32x4 a0 = acc[ai][bj][m][0] * (rs * QSCALE), a1 = acc[ai][bj][m][1] * (rs * QSCALE);
                        u32x4 w; w.x = pk2(a0.x, a0.y); w.y = pk2(a0.z, a0.w); w.z = pk2(a1.x, a1.y); w.w = pk2(a1.z, a1.w);
                        *(u32x4*)(MQ + (size_t)row * 256 + bj * 128 + wc * 32 + fq * 8) = w; }
                }
                if (EPI_FENCE(m)) asm volatile("" ::: "memory");
            }
    }
};
struct EpiMemKV {
    static constexpr bool PERM = true, AFTER_DRAIN = false;
    bf16_t *MK, *MVT;
    __device__ __forceinline__ void operator()(const f32x4 (&acc)[2][2][4][2], const pg8::Unit& u, int wr, int wc, int fr, int fq) const {
        asm volatile("" : "+v"(fr), "+v"(fq));
        const int row0 = u.pm * 256 + wr * 64 + fr;
#pragma unroll
        for (int ai = 0; ai < 2; ++ai)
#pragma unroll
            for (int m = 0; m < 4; ++m) {
                const int row = row0 + ai * 128 + m * 16;
                if (u.pn == 0) {
#pragma unroll
                    for (int bj = 0; bj < 2; ++bj) { const f32x4 a0 = acc[ai][bj][m][0], a1 = acc[ai][bj][m][1];
                        u32x4 w; w.x = pk2(a0.x, a0.y); w.y = pk2(a0.z, a0.w); w.z = pk2(a1.x, a1.y); w.w = pk2(a1.z, a1.w);
                        *(u32x4*)(MK + (size_t)row * 256 + bj * 128 + wc * 32 + fq * 8) = w; }
                } else {
                    const int b = u.pm, mi = row & 255;
                    unsigned voff = (unsigned)((wc * 32 + fq * 8) * NMEM + ((mi & ~15) | perm16(mi & 15))); asm volatile("" : "+v"(voff));
#pragma unroll
                    for (int bj = 0; bj < 2; ++bj)
#pragma unroll
                        for (int n = 0; n < 2; ++n)
#pragma unroll
                            for (int i = 0; i < 4; ++i) { bf16_t* bp = MVT + (size_t)((b * 4 + bj * 2) * 64 + n * 4 + i) * NMEM;
                                bp[voff] = (bf16_t)f2bf(acc[ai][bj][m][n][i]); }
                }
                if (EPI_FENCE(m)) asm volatile("" ::: "memory");
            }
    }
};

__device__ __forceinline__ void transpose_item(const float* W, int ldw, int s0, const float* gain, bf16_t* WT, int K, int p0, int k0, LAS float* scr, int lane) {
    float v[32];
    const float* wp = W + (size_t)(k0 + (lane >> 5)) * ldw + s0 + (lane & 31);
#pragma unroll
    for (int i = 0; i < 32; ++i) v[i] = __builtin_nontemporal_load(wp + (size_t)(2 * i) * ldw);
    const int c = lane & 7;
    f32x4 g0 = {1.f, 1.f, 1.f, 1.f}, g1 = g0;
    if (gain) { g0 = *(const f32x4*)(gain + k0 + 8 * c); g1 = *(const f32x4*)(gain + k0 + 8 * c + 4); }
#pragma unroll
    for (int i = 0; i < 32; ++i) scr[(2 * i + (lane >> 5)) * 33 + (lane & 31)] = v[i];
    asm volatile("s_waitcnt lgkmcnt(0)" ::: "memory");
#pragma unroll
    for (int j = 0; j < 4; ++j) { const int n = (lane >> 3) + 8 * j; const LAS float* s = scr + (8 * c) * 33 + n;
        u32x4 o; o.x = pk2(s[0 * 33] * g0.x, s[1 * 33] * g0.y); o.y = pk2(s[2 * 33] * g0.z, s[3 * 33] * g0.w); o.z = pk2(s[4 * 33] * g1.x, s[5 * 33] * g1.y); o.w = pk2(s[6 * 33] * g1.z, s[7 * 33] * g1.w);
        *(u32x4*)(WT + (size_t)(p0 + n) * K + k0 + 8 * c) = o; }
    asm volatile("s_waitcnt lgkmcnt(0)" ::: "memory");
}
__device__ __forceinline__ int in_src_col(int p0) {
    const int pn = p0 >> 8, p = p0 & 255, bj = p >> 7, wc = (p >> 5) & 3;
    if (pn < 4) return 256 * pn + 64 * wc + 32 * bj;
    if (pn == 6 || pn == 7) return (bj ? 1792 : 1536) + 128 * (pn - 6) + (p & 127);
    return p0;
}
__device__ __forceinline__ void rms_row_to_bf16(const float* xrow, const float* g, bf16_t* orow, int lane) {
    const f32x4* xr = (const f32x4*)xrow + lane; const f32x4* gr = (const f32x4*)g + lane;
    f32x4 v[4]; float s = 0.f;
#pragma unroll
    for (int j = 0; j < 4; ++j) { v[j] = __builtin_nontemporal_load(&xr[64 * j]); s += (v[j].x * v[j].x + v[j].y * v[j].y) + (v[j].z * v[j].z + v[j].w * v[j].w); }
    const float rstd = 1.0f / sqrtf(wave_sum(s) * (1.0f / DM) + EPS);
    u32x2* o8 = (u32x2*)orow + lane;
#pragma unroll
    for (int j = 0; j < 4; ++j) { const f32x4 gg = gr[64 * j]; u32x2 w; w.x = pk2(v[j].x * rstd * gg.x, v[j].y * rstd * gg.y); w.y = pk2(v[j].z * rstd * gg.z, v[j].w * rstd * gg.w); o8[64 * j] = w; }
}
__device__ __forceinline__ void rms_row2_to_bf16(const float* xa, const float* xb, const float* g, bf16_t* oa, bf16_t* ob, int lane) {
    const f32x4* ra = (const f32x4*)xa + lane; const f32x4* rb = (const f32x4*)xb + lane; const f32x4* gr = (const f32x4*)g + lane;
    f32x4 va[4], vb[4]; float sa = 0.f, sb = 0.f;
#pragma unroll
    for (int j = 0; j < 4; ++j) { va[j] = __builtin_nontemporal_load(&ra[64 * j]); vb[j] = __builtin_nontemporal_load(&rb[64 * j]); }
#pragma unroll
    for (int j = 0; j < 4; ++j) { sa += (va[j].x * va[j].x + va[j].y * va[j].y) + (va[j].z * va[j].z + va[j].w * va[j].w); sb += (vb[j].x * vb[j].x + vb[j].y * vb[j].y) + (vb[j].z * vb[j].z + vb[j].w * vb[j].w); }
    sa += sxor<1>(sa); sb += sxor<1>(sb); sa += sxor<2>(sa); sb += sxor<2>(sb); sa += sxor<4>(sa); sb += sxor<4>(sb); sa += sxor<8>(sa); sb += sxor<8>(sb); sa += sxor<16>(sa); sb += sxor<16>(sb);
    sa = hsum32(sa); sb = hsum32(sb);
    const float rsa = 1.0f / sqrtf(sa * (1.0f / DM) + EPS), rsb = 1.0f / sqrtf(sb * (1.0f / DM) + EPS);
    u32x2* pa = (u32x2*)oa + lane; u32x2* pb = (u32x2*)ob + lane;
#pragma unroll
    for (int j = 0; j < 4; ++j) { const f32x4 gg = gr[64 * j]; u32x2 w;
        w.x = pk2(va[j].x * rsa * gg.x, va[j].y * rsa * gg.y); w.y = pk2(va[j].z * rsa * gg.z, va[j].w * rsa * gg.w); pa[64 * j] = w;
        w.x = pk2(vb[j].x * rsb * gg.x, vb[j].y * rsb * gg.y); w.y = pk2(vb[j].z * rsb * gg.z, vb[j].w * rsb * gg.w); pb[64 * j] = w; }
}

template <int NJ>
__device__ __forceinline__ void naive_stream(const bf16_t* qp, const bf16_t* Kb, int kpitch, const bf16_t* Vt, int vpitch, int nkeys, float (&o)[NJ]) {
    u32x4 q[8];
#pragma unroll
    for (int j = 0; j < 8; ++j) q[j] = *(const u32x4*)(qp + 8 * j);
#define BLO(w) __builtin_bit_cast(float, (w) << 16)
#define BHI(w) __builtin_bit_cast(float, (w) & 0xffff0000u)
    float mx = -INFINITY, l = 0.f; int zoff = 0; asm volatile("" : "+v"(zoff));
#pragma unroll
    for (int j = 0; j < NJ; ++j) o[j] = 0.f;
    for (int kb = 0; kb < nkeys; kb += 16) {
        float s[16];
#pragma unroll
        for (int kk = 0; kk < 16; ++kk) {
            const bf16_t* kp = Kb + (size_t)(kb + kk) * kpitch + zoff; float a = 0.f;
#pragma unroll
            for (int j = 0; j < 8; ++j) { const u32x4 w = *(const u32x4*)(kp + 8 * j);
                a += BLO(q[j].x) * BLO(w.x) + BHI(q[j].x) * BHI(w.x); a += BLO(q[j].y) * BLO(w.y) + BHI(q[j].y) * BHI(w.y);
                a += BLO(q[j].z) * BLO(w.z) + BHI(q[j].z) * BHI(w.z); a += BLO(q[j].w) * BLO(w.w) + BHI(q[j].w) * BHI(w.w); }
            s[kk] = a;
        }
        float bm = s[0];
#pragma unroll
        for (int kk = 1; kk < 16; ++kk) bm = fmaxf(bm, s[kk]);
        const float mn = fmaxf(mx, bm), sc = exp2f(mx - mn); mx = mn;
        float ps = 0.f;
#pragma unroll
        for (int kk = 0; kk < 16; ++kk) { s[kk] = exp2f(s[kk] - mn); ps += s[kk]; }
        l = l * sc + ps;
#pragma unroll
        for (int j = 0; j < NJ; ++j) {
            const bf16_t* vp = Vt + (size_t)j * vpitch + kb;
            const u32x4 w0 = *(const u32x4*)vp, w1 = *(const u32x4*)(vp + 8);
            float a = 0.f;
            a += s[0] * __builtin_bit_cast(float, w0.x << 16) + s[1] * __builtin_bit_cast(float, w0.x & 0xffff0000u);
            a += s[2] * __builtin_bit_cast(float, w0.y << 16) + s[3] * __builtin_bit_cast(float, w0.y & 0xffff0000u);
            a += s[8] * __builtin_bit_cast(float, w0.z << 16) + s[9] * __builtin_bit_cast(float, w0.z & 0xffff0000u);
            a += s[10] * __builtin_bit_cast(float, w0.w << 16) + s[11] * __builtin_bit_cast(float, w0.w & 0xffff0000u);
            a += s[4] * __builtin_bit_cast(float, w1.x << 16) + s[5] * __builtin_bit_cast(float, w1.x & 0xffff0000u);
            a += s[6] * __builtin_bit_cast(float, w1.y << 16) + s[7] * __builtin_bit_cast(float, w1.y & 0xffff0000u);
            a += s[12] * __builtin_bit_cast(float, w1.z << 16) + s[13] * __builtin_bit_cast(float, w1.z & 0xffff0000u);
            a += s[14] * __builtin_bit_cast(float, w1.w << 16) + s[15] * __builtin_bit_cast(float, w1.w & 0xffff0000u);
            o[j] = o[j] * sc + a;
        }
    }
    const float rl = 1.0f / l;
#pragma unroll
    for (int j = 0; j < NJ; ++j) o[j] *= rl;
}


typedef short bf16x8 __attribute__((ext_vector_type(8)));
typedef float f32x16 __attribute__((ext_vector_type(16)));
typedef float f32x2_t __attribute__((ext_vector_type(2)));
typedef __bf16 bf16x2_t __attribute__((ext_vector_type(2)));
__device__ __forceinline__ unsigned cvtpk_s(float lo, float hi) { f32x2_t v = {lo, hi}; bf16x2_t b = __builtin_convertvector(v, bf16x2_t); return __builtin_bit_cast(unsigned, b); }
__device__ __forceinline__ int crow(int r, int hi) { return (r & 3) + 8 * (r >> 2) + 4 * hi; }
#define MFMA32(a, b, c) __builtin_amdgcn_mfma_f32_32x32x16_bf16((a), (b), (c), 0, 0, 0)
constexpr int KST = 144;
constexpr int DA_KSLOT = 16384, DA_VSLOT = 16384, DA_V0 = 3 * DA_KSLOT;
constexpr int DA_WSF = DA_V0 + 3 * DA_VSLOT;
constexpr int MA_VST = 528, MA_VT = 256 * KST;
static_assert(DA_WSF >= 65536 && DA_WSF + 1024 <= 131072 && MA_VT + 64 * MA_VST <= DA_WSF, "attention LDS map");

__device__ __forceinline__ void qk_tile(const LAS unsigned char* Kt, int kst, const bf16x8 (&qr)[4], f32x16& p0, f32x16& p1, int r32, int hi) {
#pragma unroll
    for (int r = 0; r < 16; ++r) { p0[r] = 0.f; p1[r] = 0.f; }
    const LAS unsigned char* ka = Kt + r32 * kst + hi * 16;
#pragma unroll
    for (int ds = 0; ds < 4; ++ds) {
        const bf16x8 a0 = *(const LAS bf16x8*)(ka + ds * 32), a1 = *(const LAS bf16x8*)(ka + 32 * kst + ds * 32);
        p0 = MFMA32(a0, qr[ds], p0); p1 = MFMA32(a1, qr[ds], p1);
    }
}
__device__ __forceinline__ float half_max(float v) { float a = v, b = v; swap32(a, b); return fmaxf(a, b); }
__device__ __forceinline__ float half_sum(float v) { return hsum32(v); }
template <int NDB>
__device__ __forceinline__ void soft_max_rescale(const f32x16& p0, const f32x16& p1, f32x16 (&o)[NDB], float& m, float& l, LAS float* wsf, int r32, int hi) {
    float ra = fmaxf(p0[0], p1[0]), rb = fmaxf(p0[1], p1[1]);
#pragma unroll
    for (int r = 2; r < 16; r += 2) { ra = fmaxf(ra, fmaxf(p0[r], p1[r])); rb = fmaxf(rb, fmaxf(p0[r + 1], p1[r + 1])); }
    const float rm = half_max(fmaxf(ra, rb));
    if (__any(rm > m + 8.0f)) {
        const float mn = (rm > m + 8.0f) ? rm : m;
        const float alpha = __builtin_amdgcn_exp2f(m - mn); l *= alpha; m = mn;
        asm volatile("" ::: "memory");
        if (hi == 0) wsf[r32] = alpha;
        asm volatile("" ::: "memory");
        float al[16];
#pragma unroll
        for (int r = 0; r < 16; ++r) al[r] = wsf[crow(r, hi)];
#pragma unroll
        for (int blk = 0; blk < NDB; ++blk)
#pragma unroll
            for (int r = 0; r < 16; ++r) o[blk][r] *= al[r];
        asm volatile("" ::: "memory");
    }
}
__device__ __forceinline__ void soft_exp_pack(f32x16& p0, f32x16& p1, float m, float& l, bf16x8 (&pa)[4]) {
    float ps0 = 0.f, ps1 = 0.f;
#pragma unroll
    for (int r = 0; r < 16; ++r) { p0[r] = __builtin_amdgcn_exp2f(p0[r] - m); p1[r] = __builtin_amdgcn_exp2f(p1[r] - m); ps0 += p0[r]; ps1 += p1[r]; }
    l += ps0 + ps1;
    u32x4 w;
    w.x = cvtpk_s(p0[0], p0[1]); w.y = cvtpk_s(p0[2], p0[3]); w.z = cvtpk_s(p0[4], p0[5]); w.w = cvtpk_s(p0[6], p0[7]); pa[0] = __builtin_bit_cast(bf16x8, w);
    w.x = cvtpk_s(p0[8], p0[9]); w.y = cvtpk_s(p0[10], p0[11]); w.z = cvtpk_s(p0[12], p0[13]); w.w = cvtpk_s(p0[14], p0[15]); pa[1] = __builtin_bit_cast(bf16x8, w);
    w.x = cvtpk_s(p1[0], p1[1]); w.y = cvtpk_s(p1[2], p1[3]); w.z = cvtpk_s(p1[4], p1[5]); w.w = cvtpk_s(p1[6], p1[7]); pa[2] = __builtin_bit_cast(bf16x8, w);
    w.x = cvtpk_s(p1[8], p1[9]); w.y = cvtpk_s(p1[10], p1[11]); w.z = cvtpk_s(p1[12], p1[13]); w.w = cvtpk_s(p1[14], p1[15]); pa[3] = __builtin_bit_cast(bf16x8, w);
}
template <int NDB>
__device__ __forceinline__ void pv_tile(const LAS unsigned char* Vt, int vst, const bf16x8 (&pa)[4], f32x16 (&o)[NDB], int r32, int hi) {
    const LAS unsigned char* va = Vt + r32 * vst + hi * 16;
#pragma unroll
    for (int st = 0; st < 4; ++st)
#pragma unroll
        for (int blk = 0; blk < NDB; ++blk) {
            const bf16x8 vb = *(const LAS bf16x8*)(va + blk * 32 * vst + st * 32);
            o[blk] = MFMA32(pa[st], vb, o[blk]);
        }
}
template <int NDB>
__device__ __forceinline__ void attn_tile(const LAS unsigned char* Kt, int kst, const LAS unsigned char* Vt, int vst, const bf16x8 (&qr)[4], f32x16 (&o)[NDB], float& m, float& l, LAS float* wsf, int r32, int hi) {
    f32x16 p0, p1; bf16x8 pa[4];
    qk_tile(Kt, kst, qr, p0, p1, r32, hi);
    soft_max_rescale<NDB>(p0, p1, o, m, l, wsf, r32, hi);
    soft_exp_pack(p0, p1, m, l, pa);
    pv_tile<NDB>(Vt, vst, pa, o, r32, hi);
}

#define SB() __builtin_amdgcn_sched_barrier(0)
#define LDF(p) (*(const LAS bf16x8*)(p))
__device__ __forceinline__ float row_max32(const f32x16& p0, const f32x16& p1) {
    float ra = fmaxf(fmaxf(p0[0], p0[1]), p1[0]), rb = fmaxf(fmaxf(p0[2], p0[3]), p1[1]); ra = fmaxf(fmaxf(ra, p1[2]), p1[3]);
#pragma unroll
    for (int r = 4; r < 16; r += 4) { ra = fmaxf(fmaxf(ra, p0[r]), p0[r + 1]); rb = fmaxf(fmaxf(rb, p0[r + 2]), p0[r + 3]); ra = fmaxf(fmaxf(ra, p1[r]), p1[r + 1]); rb = fmaxf(fmaxf(rb, p1[r + 2]), p1[r + 3]); }
    return half_max(fmaxf(ra, rb));
}
__device__ __forceinline__ void da_shift(float d, f32x16& n0, f32x16& n1, f32x16 (&o)[4], float& m, float& l, LAS float* wsf, int r32, int hi) {
    m += d;
#pragma unroll
    for (int r = 0; r < 16; ++r) { n0[r] -= d; n1[r] -= d; }
    const float alpha = __builtin_amdgcn_exp2f(-d); l *= alpha;
    asm volatile("" ::: "memory");
    if (hi == 0) wsf[r32] = alpha;
    asm volatile("" ::: "memory");
    float al[16];
#pragma unroll
    for (int r = 0; r < 16; ++r) al[r] = wsf[crow(r, hi)];
#pragma unroll
    for (int blk = 0; blk < 4; ++blk)
#pragma unroll
        for (int r = 0; r < 16; ++r) o[blk][r] *= al[r];
    asm volatile("" ::: "memory");
}
__device__ __forceinline__ bf16x8 pack8(const f32x16& p, int b) { u32x4 w; w.x = cvtpk_s(p[b], p[b + 1]); w.y = cvtpk_s(p[b + 2], p[b + 3]); w.z = cvtpk_s(p[b + 4], p[b + 5]); w.w = cvtpk_s(p[b + 6], p[b + 7]); return __builtin_bit_cast(bf16x8, w); }
template <bool DOQK>
__device__ __forceinline__ void da_step(const LAS unsigned char* Kt, const LAS unsigned char* Vt, const unsigned (&swo)[4], const bf16x8 (&qr)[4], f32x16& c0, f32x16& c1, f32x16& n0, f32x16& n1, float ninit,
                                        f32x16 (&o)[4], float& l, float& rmn) {
    constexpr int VPF = 3;
    bf16x8 kf[2][2], vf[VPF + 1], pa[4];
    float psa = 0.f, psb = 0.f, one = 1.0f; asm volatile("" : "+v"(one));
    if (DOQK) { kf[0][0] = LDF(Kt + swo[0]); kf[0][1] = LDF(Kt + swo[0] + 32 * 128);
#pragma unroll
        for (int r = 0; r < 16; ++r) { n0[r] = ninit; n1[r] = ninit; } }
    SB();
#define VFA(j) (Vt + swo[(j) >> 2] + ((j) & 3) * 32 * 128)
#pragma unroll
    for (int ds = 0; ds < 4; ++ds) {
        if (DOQK && ds < 3) { kf[(ds + 1) & 1][0] = LDF(Kt + swo[ds + 1]); kf[(ds + 1) & 1][1] = LDF(Kt + swo[ds + 1] + 32 * 128); }
        if (ds + VPF >= 4) vf[ds + VPF - 4] = LDF(VFA(ds + VPF - 4));
        if (DOQK) n0 = MFMA32(kf[ds & 1][0], qr[ds], n0);
        c0[4 * ds + 0] = __builtin_amdgcn_exp2f(c0[4 * ds + 0]); c0[4 * ds + 1] = __builtin_amdgcn_exp2f(c0[4 * ds + 1]);
        if (DOQK) n1 = MFMA32(kf[ds & 1][1], qr[ds], n1);
        c0[4 * ds + 2] = __builtin_amdgcn_exp2f(c0[4 * ds + 2]); c0[4 * ds + 3] = __builtin_amdgcn_exp2f(c0[4 * ds + 3]);
        psa = __builtin_fmaf(c0[4 * ds + 0], one, psa); psb += c0[4 * ds + 1]; psa = __builtin_fmaf(c0[4 * ds + 2], one, psa); psb += c0[4 * ds + 3];
        if (ds == 1) pa[0] = pack8(c0, 0);
        if (ds == 3) pa[1] = pack8(c0, 8);
        SB();
    }
    float ra = -INFINITY;
#pragma unroll
    for (int j = 0; j < 16; ++j) {
        const int st = j >> 2, blk = j & 3;
        if (j + VPF < 16) vf[(j + VPF) % (VPF + 1)] = LDF(VFA(j + VPF));
        o[blk] = MFMA32(pa[st], vf[j % (VPF + 1)], o[blk]);
        if (st < 2) { const int e = 8 * st + 2 * blk;
            c1[e] = __builtin_amdgcn_exp2f(c1[e]); c1[e + 1] = __builtin_amdgcn_exp2f(c1[e + 1]); psa = __builtin_fmaf(c1[e], one, psa); psb += c1[e + 1];
            if (blk == 3) pa[2 + st] = pack8(c1, 8 * st);
        } else if (DOQK) {
            if (st == 2) ra = fmaxf(fmaxf(fmaxf(ra, n0[4 * blk]), fmaxf(n0[4 * blk + 1], n0[4 * blk + 2])), n0[4 * blk + 3]);
            else         ra = fmaxf(fmaxf(fmaxf(ra, n1[4 * blk]), fmaxf(n1[4 * blk + 1], n1[4 * blk + 2])), n1[4 * blk + 3]);
        }
        SB();
    }
#undef VFA
    l += psa + psb;
    if (DOQK) rmn = half_max(ra);
}
__device__ __forceinline__ void qk_tile_sw(const LAS unsigned char* Kt, const unsigned (&swo)[4], const bf16x8 (&qr)[4], f32x16& p0, f32x16& p1) {
#pragma unroll
    for (int r = 0; r < 16; ++r) { p0[r] = 0.f; p1[r] = 0.f; }
#pragma unroll
    for (int ds = 0; ds < 4; ++ds) {
        const bf16x8 a0 = LDF(Kt + swo[ds]), a1 = LDF(Kt + swo[ds] + 32 * 128);
        p0 = MFMA32(a0, qr[ds], p0); p1 = MFMA32(a1, qr[ds], p1);
    }
}

#define XB_TMO      128
#define XB_XCNT(j)  (256  + 64 * (j))
#define XB_XSUB(j)  (1280 + 64 * (j))
#define XB_XGEN(j)  (2304 + 64 * (j))
#define XB_TOP      3328
#define XB_TOPGEN   3392
#define XCD_BAR_WORDS 3456
#define XB_SPIN_CAP (1u << 18)

__device__ __forceinline__ unsigned xb_ld(unsigned* p)              { return __hip_atomic_load(p, __ATOMIC_RELAXED, __HIP_MEMORY_SCOPE_AGENT); }
__device__ __forceinline__ unsigned xb_add(unsigned* p, unsigned v) { return __hip_atomic_fetch_add(p, v, __ATOMIC_RELAXED, __HIP_MEMORY_SCOPE_AGENT); }
__device__ __forceinline__ unsigned xb_xcc_id() { return (unsigned)__builtin_amdgcn_s_getreg((3 << 11) | 20) & 0xFu; }
#define XB_SPIN(cond, bar) do { unsigned _sp = 0; while (cond) { __builtin_amdgcn_s_sleep(1); \
    if ((++_sp & 255u) == 0u) { if (xb_ld(&(bar)[XB_TMO])) break; if (_sp > XB_SPIN_CAP) { atomicAdd(&(bar)[XB_TMO], 1u); break; } } } } while (0)

struct XcdBarrier {
    unsigned* bar; unsigned x; bool w0;
    volatile LAS unsigned* st;
};

__device__ __forceinline__ XcdBarrier xcd_barrier_post(unsigned* bar, volatile LAS unsigned* st) {
    XcdBarrier b; b.bar = bar; b.x = xb_xcc_id(); b.st = st;
    if (threadIdx.x == 0) (void)xb_add(&bar[XB_XCNT(b.x)], 1u);
    return b;
}
__device__ __forceinline__ void xcd_barrier_complete(unsigned* bar, unsigned x, unsigned& nloc, unsigned& nx) {
    const unsigned G = gridDim.x * gridDim.y * gridDim.z;
    unsigned sum, cnt, mine, sp = 0u;
    for (;;) {
        sum = 0u; cnt = 0u; mine = 0u;
#pragma unroll
        for (unsigned j = 0; j < 16; ++j) { const unsigned c = xb_ld(&bar[XB_XCNT(j)]); sum += c; cnt += (c > 0u) ? 1u : 0u; mine = (j == x) ? c : mine; }
        if (sum == G) break;
        __builtin_amdgcn_s_sleep(1);
        if ((++sp & 255u) == 0u) { if (xb_ld(&bar[XB_TMO])) break; if (sp > XB_SPIN_CAP) { atomicAdd(&bar[XB_TMO], 1u); break; } }
    }
    nloc = mine > 0u ? mine : 1u; nx = cnt > 0u ? cnt : 1u;
}

__device__ __forceinline__ void xcd_barrier(const XcdBarrier& b) {
    asm volatile("s_waitcnt vmcnt(0)" ::: "memory");
    __syncthreads();
    if (b.w0 && LANE_ID() == 0) {
        unsigned* bar = b.bar;
        __builtin_amdgcn_s_waitcnt(0);
        unsigned nloc = b.st[0], nx = b.st[1];
        if (nloc == 0u) { xcd_barrier_complete(bar, b.x, nloc, nx); b.st[0] = nloc; b.st[1] = nx; }
        const unsigned old = xb_add(&bar[XB_XSUB(b.x)], 1u);
        const unsigned gen = old / nloc;
        if (old + 1u == (gen + 1u) * nloc) {
            __builtin_amdgcn_fence(__ATOMIC_RELEASE, "agent");
            asm volatile("s_waitcnt vmcnt(0)" ::: "memory");
            const unsigned og = xb_add(&bar[XB_TOP], 1u);
            const unsigned tg = og / nx;
            if (og + 1u == (tg + 1u) * nx) xb_add(&bar[XB_TOPGEN], 1u);
            else XB_SPIN(xb_ld(&bar[XB_TOPGEN]) == tg, bar);
            __builtin_amdgcn_fence(__ATOMIC_ACQUIRE, "agent");
            xb_add(&bar[XB_XGEN(b.x)], 1u);
            asm volatile("s_waitcnt vmcnt(0)" ::: "memory");
        } else {
            XB_SPIN(xb_ld(&bar[XB_XGEN(b.x)]) == gen, bar);
            __builtin_amdgcn_fence(__ATOMIC_ACQUIRE, "agent");
            asm volatile("s_waitcnt vmcnt(0)" ::: "memory");
        }
    }
    __syncthreads();
}

__global__ void __launch_bounds__(512, 2) fwd_megakernel(Params P) {
    extern __shared__ __attribute__((aligned(16))) unsigned char lds_raw[];
    LAS unsigned char* lds = (LAS unsigned char*)lds_raw;
    cg::grid_group grid = cg::this_grid();
    const int tid = threadIdx.x, lane = tid & 63, wave = __builtin_amdgcn_readfirstlane(tid >> 6);
    const int G = gridDim.x, gw = blockIdx.x * 8 + wave, NGW = G * 8;
    unsigned char* ws = P.ws;
    const float* x = P.in[0]; float* H = P.out;
    volatile LAS unsigned* bst = (volatile LAS unsigned*)(lds + 131072);
    if (tid < 2) bst[tid] = 0u;
    __syncthreads();
    XcdBarrier xbar = xcd_barrier_post((unsigned*)(ws + WS_CTL), bst); xbar.w0 = (wave == 0);
#if !defined(NO_CG_SYNC) && !defined(CG_SYNC_AT_END)
    grid.sync();
#endif
#define GRID_BAR() xcd_barrier(xbar)
    bf16_t* W_GU1 = (bf16_t*)(ws + WS_WGU1); bf16_t* W_D1 = (bf16_t*)(ws + WS_WD1); bf16_t* W_IN = (bf16_t*)(ws + WS_WIN); bf16_t* W_MKV = (bf16_t*)(ws + WS_WMKV);
    bf16_t* W_OUT = (bf16_t*)(ws + WS_WOUT); bf16_t* W_GU2 = (bf16_t*)(ws + WS_WGU2); bf16_t* W_D2 = (bf16_t*)(ws + WS_WD2);
    float* ROPEC = (float*)(ws + WS_ROPE); float* ROPES = ROPEC + SEQ * 32; float* SSQ = (float*)(ws + WS_SSQ); float* RN1 = SSQ; float* RN2 = SSQ + MTOK;
    bf16_t* MEMN = (bf16_t*)(ws + WS_MEMN); bf16_t* MK = (bf16_t*)(ws + WS_MK); bf16_t* MVT = (bf16_t*)(ws + WS_MVT);
    bf16_t* AB = (bf16_t*)(ws + WS_AB); bf16_t* ACT = (bf16_t*)(ws + WS_ACT); bf16_t* MIXED = (bf16_t*)(ws + WS_MIXED);
    bf16_t* Qb = (bf16_t*)(ws + WS_Q); bf16_t* Kb = (bf16_t*)(ws + WS_K); bf16_t* VT = (bf16_t*)(ws + WS_VT); bf16_t* Gb = (bf16_t*)(ws + WS_G); bf16_t* MQ = (bf16_t*)(ws + WS_MQ);

#ifndef P0_REPS
#define P0_REPS 1
#endif
    {
        LAS float* scr = (LAS float*)(lds + wave * 16384);
        constexpr int I_GU = (5632 / 32) * (DM / 64), I_D = DEFER_W ? 0 : (DM / 32) * (DFF / 64), I_IN = (INW / 32) * (DM / 64), I_MKV = (512 / 32) * (DM / 64);
        constexpr int NITEMS = I_GU + I_D + I_IN + I_MKV;
        for (int it = gw; it < NITEMS * P0_REPS; it += NGW) {
            int r = it % NITEMS;
            if (r < I_GU) {
                const int kb = r % (DM / 64), pb = r / (DM / 64), p0 = pb * 32, pn = p0 >> 8, bj = (p0 >> 7) & 1, j0 = p0 & 127;
                transpose_item(bj ? P.in[4] : P.in[3], DFF, 128 * pn + j0, nullptr, W_GU1, DM, p0, kb * 64, scr, lane); continue; }
            r -= I_GU;
            if (r < I_D) { const int kb = r % (DFF / 64), pb = r / (DFF / 64);
                transpose_item(P.in[5], DM, pb * 32, nullptr, W_D1, DFF, pb * 32, kb * 64, scr, lane); continue; }
            r -= I_D;
            if (r < I_IN) { const int kb = r % (DM / 64), pb = r / (DM / 64);
                transpose_item(P.in[8], INW, in_src_col(pb * 32), P.in[6], W_IN, DM, pb * 32, kb * 64, scr, lane); continue; }
            r -= I_IN;
            { const int kb = r % (DM / 64), pb = r / (DM / 64);
                transpose_item(P.in[18], 512, pb * 32, nullptr, W_MKV, DM, pb * 32, kb * 64, scr, lane); }
        }
#if !DEFER_W
        { constexpr int I_OUT = (DM / 32) * (DM / 64);
          for (int it = gw; it < I_GU + I_D + I_OUT; it += NGW) { int r = it;
            if (r < I_GU) { const int kb = r % (DM / 64), pb = r / (DM / 64), p0 = pb * 32, pn = p0 >> 8, bj = (p0 >> 7) & 1, j0 = p0 & 127;
                transpose_item(bj ? P.in[22] : P.in[21], DFF, 128 * pn + j0, P.in[20], W_GU2, DM, p0, kb * 64, scr, lane); continue; }
            r -= I_GU;
            if (r < I_D) { const int kb = r % (DFF / 64), pb = r / (DFF / 64);
                transpose_item(P.in[23], DM, pb * 32, nullptr, W_D2, DFF, pb * 32, kb * 64, scr, lane); continue; }
            r -= I_D;
            { const int kb = r % (DM / 64), pb = r / (DM / 64);
                transpose_item(P.in[19], DM, pb * 32, nullptr, W_OUT, DM, pb * 32, kb * 64, scr, lane); } } }
#endif
        for (int m = gw; m < MTOK; m += 2 * NGW) {
            if (m + NGW < MTOK) rms_row2_to_bf16(x + (size_t)m * DM, x + (size_t)(m + NGW) * DM, P.in[2], AB + (size_t)m * DM, AB + (size_t)(m + NGW) * DM, lane);
            else rms_row_to_bf16(x + (size_t)m * DM, P.in[2], AB + (size_t)m * DM, lane); }
        for (int m = gw; m < NB * NMEM; m += NGW) rms_row_to_bf16(P.in[1] + (size_t)m * DM, P.in[7], MEMN + (size_t)m * DM, lane);
        { float* SM = (float*)(ws + WS_SMALL);
          for (int e = blockIdx.x * 512 + tid; e < SM_END; e += G * 512) {
            float v;
            if (e < 64) v = P.in[9][e]; else if (e < 128) v = P.in[10][e - 64]; else if (e < 192) v = P.in[11][e - 128]; else if (e < SM_SUBLN) v = P.in[12][e - 192];
            else if (e < SM_DWW) v = P.in[13][e - SM_SUBLN];
            else if (e < SM_DWB) v = P.in[14][e - SM_DWW];
            else if (e < SM_LNG) v = P.in[15][e - SM_DWB];
            else if (e < SM_LNB) v = P.in[16][e - SM_LNG];
            else if (e < SM_FNG) v = P.in[17][e - SM_LNB];
            else v = P.in[24][e - SM_FNG];
            SM[e] = v; } }
        for (int e = blockIdx.x * 512 + tid; e < SEQ * 32; e += G * 512) {
            const int pos = e >> 5, i = e & 31;
            const float invf = (float)exp2(-(double)(2 * i) / 64.0 * 13.287712379549449);
            const float ang = (float)pos * invf;
            const double xd = (double)ang, kd = rint(xd * 0.63661977236758134), rr = fma(-kd, 1.5707963267948966, xd) - kd * 6.123233995736766e-17, r2 = rr * rr;
            const double sn = rr * (1.0 + r2 * (-1.0 / 6 + r2 * (1.0 / 120 + r2 * (-1.0 / 5040 + r2 * (1.0 / 362880 + r2 * (-1.0 / 39916800 + r2 * (1.0 / 6227020800.0)))))));
            const double cs = 1.0 + r2 * (-0.5 + r2 * (1.0 / 24 + r2 * (-1.0 / 720 + r2 * (1.0 / 40320 + r2 * (-1.0 / 3628800 + r2 * (1.0 / 479001600.0 + r2 * (-1.0 / 87178291200.0)))))));
            const int qd = ((int)kd) & 3;
            const double sv = (qd == 0) ? sn : (qd == 1) ? cs : (qd == 2) ? -sn : -cs;
            const double cv = (qd == 0) ? cs : (qd == 1) ? -sn : (qd == 2) ? -cs : sn;
            ROPEC[e] = (float)cv; ROPES[e] = (float)sv;
        }
    }
    GRID_BAR();
#ifndef NO_P1
    { pg8::Gemm g{AB, W_GU1, MTOK, 2 * DFF, DM}; pg8::StaticOrder S; S.init(MTOK, 2 * DFF, G, (int)blockIdx.x); EpiSwiGLU E{ACT, nullptr};
      pg8::gemm_phase<EpiSwiGLU, pg8::StaticOrder, true, true>(lds, g, S, E, wave);
#ifdef P1_TWICE
      pg8::gemm_phase<EpiSwiGLU, pg8::StaticOrder, true, true>(lds, g, S, E, wave);
#endif
    }
#if DEFER_W
    if ((int)blockIdx.x >= G / 2) {
        int lane_t = LANE_ID(); asm volatile("" : "+v"(lane_t)); const int lane = lane_t;
        LAS float* scr = (LAS float*)(lds + wave * 16384);
        constexpr int I_D1 = (DM / 32) * (DFF / 64);
        for (int r = ((int)blockIdx.x - G / 2) * 8 + wave; r < I_D1; r += (G - G / 2) * 8) {
            const int kb = r % (DFF / 64), pb = r / (DFF / 64);
            transpose_item(P.in[5], DM, pb * 32, nullptr, W_D1, DFF, pb * 32, kb * 64, scr, lane); }
    }
#endif
#endif
    GRID_BAR();
#ifdef SYNC_EXTRA
    for (int i = 0; i < SYNC_EXTRA; ++i) GRID_BAR();
#endif
#ifndef NO_P2
    { pg8::Gemm g{ACT, W_D1, MTOK, DM, DFF}; pg8::StaticOrder S; S.init(MTOK, DM, G, (int)blockIdx.x);
      EpiExch<true> E{x, nullptr, nullptr, 0.5f, nullptr, nullptr, AB, RN1, (float*)(ws + WS_XBUF), (unsigned*)(ws + WS_CTL + CTL_CNT)};
      pg8::gemm_phase<EpiExch<true>, pg8::StaticOrder, false, true>(lds, g, S, E, wave);
    }
#endif
    GRID_BAR();
#ifndef NO_P3
    { pg8::Gemm g{AB, W_IN, MTOK, INW, DM}; pg8::StaticOrder S; S.init(MTOK, INW, G, (int)blockIdx.x); EpiInProj E{nullptr, ROPEC, ROPES, Qb, Kb, VT, Gb, MQ};
      pg8::gemm_phase<EpiInProj, pg8::StaticOrder, true, true>(lds, g, S, E, wave);
#ifdef P3_TWICE
      pg8::gemm_phase<EpiInProj, pg8::StaticOrder, true, true>(lds, g, S, E, wave);
#endif
      pg8::Gemm g2{MEMN, W_MKV, NB * NMEM, 512, DM}; pg8::StaticOrder S2; S2.init(NB * NMEM, 512, G, ((int)blockIdx.x >= G - 4) ? (int)blockIdx.x - (G - 4) : 1 << 20); EpiMemKV E2{MK, MVT};
      pg8::gemm_phase<EpiMemKV, pg8::StaticOrder, true, true>(lds, g2, S2, E2, wave); }
#if DEFER_W
    if ((int)blockIdx.x >= G / 4 && (int)blockIdx.x < G - 4) {
        int lane_t = LANE_ID(); asm volatile("" : "+v"(lane_t)); const int lane = lane_t;
        LAS float* scr = (LAS float*)(lds + wave * 16384);
        constexpr int I_D = (DM / 32) * (DFF / 64), I_OUT = (DM / 32) * (DM / 64), I_GUH = (5632 / 32) * (DM / 64);
        for (int r0 = ((int)blockIdx.x - G / 4) * 8 + wave; r0 < I_D + I_OUT + I_GUH; r0 += (G - 4 - G / 4) * 8) {
            int r = r0;
            if (r < I_GUH) {
                const int kb = r % (DM / 64), pb = r / (DM / 64), p0 = pb * 32, pn = p0 >> 8, bj = (p0 >> 7) & 1, j0 = p0 & 127;
                transpose_item(bj ? P.in[22] : P.in[21], DFF, 128 * pn + j0, P.in[20], W_GU2, DM, p0, kb * 64, scr, lane); continue; }
            r -= I_GUH;
            if (r < I_OUT) { const int kb = r % (DM / 64), pb = r / (DM / 64);
                transpose_item(P.in[19], DM, pb * 32, nullptr, W_OUT, DM, pb * 32, kb * 64, scr, lane); continue; }
            r -= I_OUT;
            { const int kb = r % (DFF / 64), pb = r / (DFF / 64);
                transpose_item(P.in[23], DM, pb * 32, nullptr, W_D2, DFF, pb * 32, kb * 64, scr, lane); }
        }
    }
#endif
#endif
    GRID_BAR();
#ifndef NO_P4
    {
        const float* SM = (const float*)(ws + WS_SMALL);
#define LAM_COMPUTE(lamv) do { const int ll_ = LANE_ID(); const float a_ = SM[ll_] * SM[64 + ll_], b_ = SM[128 + ll_] * SM[192 + ll_]; lamv = __expf(wave_sum(a_)) - __expf(wave_sum(b_)) + 0.2f; } while (0)
#ifdef NAIVE_ATT
        float lam; LAM_COMPUTE(lam);
        {
            const int qi = lane >> 2, dq = lane & 3;
            for (int item = gw, rnd = 0; item < 4096; item += NGW, ++rnd) {
                const int bh = item & 7, rest = item >> 3, qsub = rest & 3; int ch = rest >> 2; if ((rnd & 1) && NGW == 2048) ch = 191 - ch;
                const int b = bh >> 2, h = bh & 3, row = b * SEQ + ch * 64 + qsub * 16 + qi, nkeys = (ch + 1) * 64;
                float o1[32], o2[32];
                naive_stream<32>(Qb + (size_t)row * 512 + h * 128, Kb + (size_t)b * SEQ * 512 + h * 128, 512, VT + ((size_t)(bh) * 128 + dq * 32) * SEQ, SEQ, nkeys, o1);
                naive_stream<32>(Qb + (size_t)row * 512 + h * 128 + 64, Kb + (size_t)b * SEQ * 512 + h * 128 + 64, 512, VT + ((size_t)(bh) * 128 + dq * 32) * SEQ, SEQ, nkeys, o2);
                float ss = 0.f;
#pragma unroll
                for (int j = 0; j < 32; ++j) { o1[j] -= lam * o2[j]; ss += o1[j] * o1[j]; }
                ss += sxor<1>(ss); ss += sxor<2>(ss);
                const float rs = 0.8f / sqrtf(ss * (1.0f / 128) + EPS);
                bf16_t* dst = MIXED + (size_t)row * DM + h * 128 + dq * 32;
#pragma unroll
                for (int j = 0; j < 32; j += 8) { u32x4 w;
                    w.x = pk2(o1[j] * rs * SM[SM_SUBLN + dq * 32 + j], o1[j + 1] * rs * SM[SM_SUBLN + dq * 32 + j + 1]); w.y = pk2(o1[j + 2] * rs * SM[SM_SUBLN + dq * 32 + j + 2], o1[j + 3] * rs * SM[SM_SUBLN + dq * 32 + j + 3]);
                    w.z = pk2(o1[j + 4] * rs * SM[SM_SUBLN + dq * 32 + j + 4], o1[j + 5] * rs * SM[SM_SUBLN + dq * 32 + j + 5]); w.w = pk2(o1[j + 6] * rs * SM[SM_SUBLN + dq * 32 + j + 6], o1[j + 7] * rs * SM[SM_SUBLN + dq * 32 + j + 7]);
                    *(u32x4*)(dst + j) = w; }
            }
        }
        {
            const int qi = lane >> 2, dq = lane & 3;
            for (int item = gw; item < MTOK / 16 * 4; item += NGW) {
                const int hm = item & 3, rb = item >> 2, row = rb * 16 + qi, b = row >> 13;
                float o[16];
                naive_stream<16>(MQ + (size_t)row * 256 + hm * 64, MK + (size_t)b * NMEM * 256 + hm * 64, 256, MVT + ((size_t)(b * 4 + hm) * 64 + dq * 16) * NMEM, NMEM, NMEM, o);
                bf16_t* dst = MIXED + (size_t)row * DM + 768 + hm * 64 + dq * 16;
                u32x4 w; w.x = pk2(o[0], o[1]); w.y = pk2(o[2], o[3]); w.z = pk2(o[4], o[5]); w.w = pk2(o[6], o[7]); *(u32x4*)dst = w;
                w.x = pk2(o[8], o[9]); w.y = pk2(o[10], o[11]); w.z = pk2(o[12], o[13]); w.w = pk2(o[14], o[15]); *(u32x4*)(dst + 8) = w;
            }
        }
#else
        {
            int lane_d = LANE_ID(); asm volatile("" : "+v"(lane_d)); const int lane = lane_d;
            const int r32 = lane & 31, hi = lane >> 5, c = wave >> 2, wq = wave & 3;
            LAS float* wsf = (LAS float*)(lds + DA_WSF) + wave * 32;
            unsigned swo[4];
            { const int sw = (r32 >> 1) & 7;
#pragma unroll
              for (int x = 0; x < 4; ++x) swo[x] = (unsigned)(r32 * 128 + (((2 * x + hi) ^ sw) << 4)); }
            const int rin = 8 * wave + (lane >> 3), lc = (lane & 7) ^ ((rin >> 1) & 7);
            const unsigned kvoff = (unsigned)((rin * 512 + lc * 8) * 2), vvoff = (unsigned)((rin * SEQ + lc * 8) * 2);
            const unsigned qoff = (unsigned)(((wq * 32 + r32) * 512 + c * 64 + hi * 8) * 2);
            const unsigned ldsb = (unsigned)(size_t)lds_raw + (unsigned)wave * 1024u;
#ifndef DA_REPS
#define DA_REPS 1
#endif
            for (int pair_ = blockIdx.x; pair_ < 256 * DA_REPS; pair_ += G)
            for (int half = 0; half < 2; ++half) {
                const int pair = pair_ & 255, bh = pair & 7, sidx = pair >> 3, qb = half ? 63 - sidx : sidx, b = bh >> 2, h = bh & 3;
                const int q0 = qb * 128, NT = 2 * qb + 2;
                const char* kbase = (const char*)(Kb + (size_t)b * SEQ * 512 + h * 128);
                const char* vbase = (const char*)(VT + (size_t)bh * 128 * SEQ);
#define DA_GLDS(voff, sbase, dst, imm) do { unsigned keep_; const char* ga_ = (sbase) + (voff); asm volatile("s_mov_b32 %0, m0\n\ts_mov_b32 m0, %2\n\ts_nop 0\n\tglobal_load_lds_dwordx4 %1, off\n\ts_mov_b32 m0, %0" \
                    : "=&s"(keep_) : "v"(ga_), "s"(dst) : "memory"); } while (0)
#define DA_DMA_K(tt, sl) do { const int tt_ = (tt) < NT ? (tt) : NT - 1; const char* kb_ = kbase + (size_t)tt_ * (64 * 512 * 2); const unsigned d_ = (unsigned)__builtin_amdgcn_readfirstlane(ldsb + (sl) * DA_KSLOT); \
                    DA_GLDS(kvoff, kb_, d_, 0); const unsigned d2_ = d_ + 8192u; const char* kb2_ = kb_ + 128; DA_GLDS(kvoff, kb2_, d2_, 0); } while (0)
#define DA_DMA_V(tt, sl) do { const int tt_ = (tt) < NT ? (tt) : NT - 1; const char* vb_ = vbase + (size_t)tt_ * 128; const char* vb2_ = vb_ + (size_t)64 * SEQ * 2; const unsigned d_ = (unsigned)__builtin_amdgcn_readfirstlane(ldsb + DA_V0 + (sl) * DA_VSLOT); \
                    DA_GLDS(vvoff, vb_, d_, 0); const unsigned d2_ = d_ + 8192u; DA_GLDS(vvoff, vb2_, d2_, 0); } while (0)
#define DA_BAR(N) asm volatile("s_waitcnt vmcnt(" #N ") lgkmcnt(0)\n\ts_barrier" ::: "memory")
#define DA_KB(t) (lds + ((t) % 3) * DA_KSLOT + c * 8192)
#define DA_VB(t) (lds + DA_V0 + ((t) % 3) * DA_VSLOT)
#define DA_SHIFTCHK(N0, N1) do { if (__any(rmn > 8.0f)) da_shift((rmn > 8.0f) ? rmn : 0.f, N0, N1, o, m, l, wsf, r32, hi); } while (0)
                DA_DMA_K(0, 0); DA_DMA_V(0, 0); DA_DMA_K(1, 1);
                bf16x8 qr[4];
                { const char* qbase = (const char*)(Qb + ((size_t)(b * SEQ + q0)) * 512 + h * 128);
                  asm volatile("global_load_dwordx4 %0, %4, %5 offset:0\n\tglobal_load_dwordx4 %1, %4, %5 offset:32\n\tglobal_load_dwordx4 %2, %4, %5 offset:64\n\tglobal_load_dwordx4 %3, %4, %5 offset:96"
                               : "=&v"(qr[0]), "=&v"(qr[1]), "=&v"(qr[2]), "=&v"(qr[3]) : "v"(qoff), "s"(qbase) : "memory"); }
                f32x16 o[4];
#pragma unroll
                for (int blk = 0; blk < 4; ++blk)
#pragma unroll
                    for (int r = 0; r < 16; ++r) o[blk][r] = 0.f;
                float m = 0.f, l = 0.f;
                DA_BAR(0);
                DA_DMA_K(2, 2); DA_DMA_V(1, 1);
                f32x16 pA0, pA1, pB0, pB1; float rmn;
                qk_tile_sw(DA_KB(0), swo, qr, pA0, pA1);
                { const float rm0 = row_max32(pA0, pA1); m = rm0;
#pragma unroll
                  for (int r = 0; r < 16; ++r) { pA0[r] -= rm0; pA1[r] -= rm0; } }
                DA_BAR(4);
                const bool masklast = (wq < 2);
                int t = 0;
                for (; t + 2 < NT; t += 2) {
                    DA_DMA_K(t + 3, t % 3); DA_DMA_V(t + 2, (t + 2) % 3);
                    da_step<true>(DA_KB(t + 1), DA_VB(t), swo, qr, pA0, pA1, pB0, pB1, -m, o, l, rmn); DA_SHIFTCHK(pB0, pB1);
                    DA_BAR(4);
                    DA_DMA_K(t + 4, (t + 1) % 3); DA_DMA_V(t + 3, (t + 3) % 3);
                    da_step<true>(DA_KB(t + 2), DA_VB(t + 1), swo, qr, pB0, pB1, pA0, pA1, -m, o, l, rmn); DA_SHIFTCHK(pA0, pA1);
                    DA_BAR(4);
                }
                DA_DMA_K(t + 3, t % 3); DA_DMA_V(t + 2, (t + 2) % 3);
                da_step<true>(DA_KB(t + 1), DA_VB(t), swo, qr, pA0, pA1, pB0, pB1, masklast ? -INFINITY : -m, o, l, rmn); DA_SHIFTCHK(pB0, pB1);
                DA_BAR(4);
                da_step<false>(DA_KB(t), DA_VB(t + 1), swo, qr, pB0, pB1, pA0, pA1, 0.f, o, l, rmn);
                DA_BAR(0);
#undef DA_GLDS
#undef DA_DMA_K
#undef DA_DMA_V
#undef DA_BAR
#undef DA_KB
#undef DA_VB
#undef DA_SHIFTCHK
                int r32f = r32, lanef = lane; asm volatile("" : "+v"(r32f), "+v"(lanef));
                { float inv = 1.0f / half_sum(l); if (c) { float lam; LAM_COMPUTE(lam); inv *= lam; }
                  asm volatile("" ::: "memory");
                  if (hi == 0) wsf[r32] = inv;
                  asm volatile("" ::: "memory");
                  float sc[16];
#pragma unroll
                  for (int r = 0; r < 16; ++r) sc[r] = wsf[crow(r, hi)];
#pragma unroll
                  for (int blk = 0; blk < 4; ++blk)
#pragma unroll
                      for (int r = 0; r < 16; ++r) o[blk][r] *= sc[r]; }
                LAS float* cb = (LAS float*)lds + wq * 4096 + lanef;
                if (c) {
#pragma unroll
                    for (int blk = 0; blk < 4; ++blk)
#pragma unroll
                        for (int r = 0; r < 16; ++r) cb[(blk * 16 + r) * 64] = o[blk][r];
                }
                __syncthreads();
                if (!c) {
                    float ss[16];
#pragma unroll
                    for (int r = 0; r < 16; ++r) ss[r] = 0.f;
#pragma unroll
                    for (int blk = 0; blk < 4; ++blk)
#pragma unroll
                        for (int r = 0; r < 16; ++r) { o[blk][r] -= cb[(blk * 16 + r) * 64]; ss[r] += o[blk][r] * o[blk][r]; }
#pragma unroll
                    for (int r = 0; r < 16; ++r) {
                        ss[r] += sxor<1>(ss[r]); ss[r] += sxor<2>(ss[r]); ss[r] += sxor<4>(ss[r]); ss[r] += sxor<8>(ss[r]); ss[r] += sxor<16>(ss[r]);
                        ss[r] = 0.8f / sqrtf(ss[r] * (1.0f / 128) + EPS); }
                    unsigned voffm = (unsigned)((4 * hi * DM + r32f) * 2); asm volatile("" : "+v"(voffm));
                    const char* mbase = (const char*)(MIXED + ((size_t)(b * SEQ + q0 + wq * 32)) * DM + h * 128);
#pragma unroll
                    for (int blk = 0; blk < 4; ++blk) { const float gsub = SM[SM_SUBLN + blk * 32 + r32f];
#pragma unroll
                        for (int r = 0; r < 16; ++r) *(bf16_t*)(mbase + (size_t)(((r & 3) + 8 * (r >> 2)) * DM + blk * 32) * 2 + voffm) = (bf16_t)f2bf(o[blk][r] * ss[r] * gsub); }
                }
                __syncthreads();
            }
        }
        {
            int tidm = wave * 64 + LANE_ID(); asm volatile("" : "+v"(tidm));
            const int tid = tidm, lane = tid & 63, r32 = lane & 31, hi = lane >> 5;
            LAS float* wsf = (LAS float*)(lds + DA_WSF) + wave * 32;
#ifndef MEM_REPS
#define MEM_REPS 1
#endif
            for (int u_ = blockIdx.x; u_ < 256 * MEM_REPS; u_ += G) {
                const int u = u_ & 255, hm = u & 3, b = (u >> 2) & 1, qb = u >> 3;
#pragma unroll
                for (int i = 0; i < 4; ++i) { const int idx = tid + 512 * i;
                    { const int row = idx >> 3, ch = idx & 7; *(LAS u32x4*)(lds + row * KST + ch * 16) = *(const u32x4*)(MK + ((size_t)(b * NMEM + row)) * 256 + hm * 64 + ch * 8); }
                    { const int d = idx >> 5, ch = idx & 31; *(LAS u32x4*)(lds + MA_VT + d * MA_VST + ch * 16) = *(const u32x4*)(MVT + ((size_t)((b * 4 + hm) * 64 + d)) * NMEM + ch * 8); } }
                const int row0 = b * SEQ + qb * 256 + wave * 32;
                bf16x8 qr[4];
                { const bf16_t* qp = MQ + ((size_t)(row0 + r32)) * 256 + hm * 64 + hi * 8;
#pragma unroll
                  for (int ds = 0; ds < 4; ++ds) qr[ds] = *(const bf16x8*)(qp + ds * 16); }
                f32x16 o[2];
#pragma unroll
                for (int blk = 0; blk < 2; ++blk)
#pragma unroll
                    for (int r = 0; r < 16; ++r) o[blk][r] = 0.f;
                float m = -INFINITY, l = 0.f;
                __syncthreads();
                for (int t = 0; t < 4; ++t) attn_tile<2>(lds + t * 64 * KST, KST, lds + MA_VT + t * 128, MA_VST, qr, o, m, l, wsf, r32, hi);
                { const float inv = 1.0f / half_sum(l);
                  asm volatile("" ::: "memory");
                  if (hi == 0) wsf[r32] = inv;
                  asm volatile("" ::: "memory");
                  unsigned voffm = (unsigned)((4 * hi * DM + r32) * 2); asm volatile("" : "+v"(voffm));
                  const char* mbase = (const char*)(MIXED + (size_t)row0 * DM + 768 + hm * 64);
#pragma unroll
                  for (int r = 0; r < 16; ++r) { const float sc = wsf[crow(r, hi)]; const char* rb = mbase + (size_t)(((r & 3) + 8 * (r >> 2)) * DM) * 2;
                      *(bf16_t*)(rb + voffm) = (bf16_t)f2bf(o[0][r] * sc); *(bf16_t*)(rb + 64 + voffm) = (bf16_t)f2bf(o[1][r] * sc); } }
                __syncthreads();
            }
        }
#endif
        {
            int tidc = wave * 64 + LANE_ID(); asm volatile("" : "+v"(tidc));
            const int tid = tidc, lane = tid & 63;
            bf16_t* Gs = (bf16_t*)lds_raw;
            float* Y = (float*)(lds_raw + 49152);
            const float* dw_w = SM + SM_DWW; const float* dw_b = SM + SM_DWB; const float* ln_g = SM + SM_LNG; const float* ln_b = SM + SM_LNB;
            #ifndef CONV_REPS
#define CONV_REPS 1
#endif
            for (int unit_ = blockIdx.x; unit_ < MTOK / 64 * CONV_REPS; unit_ += G) {
                const int unit = unit_ & (MTOK / 64 - 1), t0 = unit * 64, bstart = t0 & ~(SEQ - 1);
                __syncthreads();
                for (int c = tid; c < 94 * 32; c += 512) { const int r = c >> 5, cc = c & 31, t = t0 - 30 + r;
                    u32x4 v = {0u, 0u, 0u, 0u}; if (t >= bstart) v = *(const u32x4*)(Gb + (size_t)t * 256 + cc * 8);
                    *(u32x4*)(Gs + r * 256 + cc * 8) = v; }
                __syncthreads();
                { const int cp = tid & 127, tq = tid >> 7; float w0[31], w1[31];
#pragma unroll
                    for (int j = 0; j < 31; ++j) { w0[j] = dw_w[j * 256 + 2 * cp]; w1[j] = dw_w[j * 256 + 2 * cp + 1]; }
                    const float bias0 = dw_b[2 * cp], bias1 = dw_b[2 * cp + 1];
                    const unsigned* Gs32 = (const unsigned*)Gs;
                    for (int tt = 0; tt < 16; ++tt) { const int t = tq * 16 + tt; float a0 = bias0, a1 = bias1;
#pragma unroll
                        for (int j = 0; j < 31; ++j) { const unsigned g2 = Gs32[(t + j) * 128 + cp];
                            a0 += __builtin_bit_cast(float, g2 << 16) * w0[j]; a1 += __builtin_bit_cast(float, g2 & 0xffff0000u) * w1[j]; }
                        *(f32x2_t*)(Y + t * 256 + 2 * cp) = (f32x2_t){a0, a1}; } }
                __syncthreads();
                { f32x4 v[8]; float sm[8], sq[8];
#pragma unroll
                  for (int tt = 0; tt < 8; ++tt) { v[tt] = *(const f32x4*)(Y + (wave * 8 + tt) * 256 + lane * 4); sm[tt] = (v[tt].x + v[tt].y) + (v[tt].z + v[tt].w); }
#define RED8(a) do { _Pragma("unroll") for (int tt = 0; tt < 8; ++tt) a[tt] += sxor<1>(a[tt]); _Pragma("unroll") for (int tt = 0; tt < 8; ++tt) a[tt] += sxor<2>(a[tt]); \
                     _Pragma("unroll") for (int tt = 0; tt < 8; ++tt) a[tt] += sxor<4>(a[tt]); _Pragma("unroll") for (int tt = 0; tt < 8; ++tt) a[tt] += sxor<8>(a[tt]); \
                     _Pragma("unroll") for (int tt = 0; tt < 8; ++tt) a[tt] += sxor<16>(a[tt]); _Pragma("unroll") for (int tt = 0; tt < 8; ++tt) a[tt] = hsum32(a[tt]); } while (0)
                  RED8(sm);
#pragma unroll
                  for (int tt = 0; tt < 8; ++tt) { v[tt] = v[tt] - sm[tt] * (1.0f / 256); sq[tt] = (v[tt].x * v[tt].x + v[tt].y * v[tt].y) + (v[tt].z * v[tt].z + v[tt].w * v[tt].w); }
                  RED8(sq);
#undef RED8
                  const f32x4 gg = *(const f32x4*)(ln_g + lane * 4), bb = *(const f32x4*)(ln_b + lane * 4);
#pragma unroll
                  for (int tt = 0; tt < 8; ++tt) { const float rstd = 1.0f / sqrtf(sq[tt] * (1.0f / 256) + EPS);
                      const f32x4 y = v[tt] * rstd * gg + bb;
                      u32x2 wv; wv.x = pk2(silu_f(y.x), silu_f(y.y)); wv.y = pk2(silu_f(y.z), silu_f(y.w));
                      *(u32x2*)(MIXED + (size_t)(t0 + wave * 8 + tt) * DM + 512 + lane * 4) = wv; } }
            }
            __syncthreads();
        }
    }
#endif
    GRID_BAR();
#ifndef NO_P5
    { pg8::Gemm g{MIXED, W_OUT, MTOK, DM, DM}; pg8::StaticOrder S; S.init(MTOK, DM, G, (int)blockIdx.x);
      EpiExch<false> E{nullptr, AB, RN1, 1.0f, nullptr, nullptr, AB, RN2, (float*)(ws + WS_XBUF) + (size_t)MTOK * 4, (unsigned*)(ws + WS_CTL + CTL_CNT) + CTL_BANK};
      pg8::gemm_phase<EpiExch<false>, pg8::StaticOrder, false, true>(lds, g, S, E, wave); }
#endif
    GRID_BAR();
#ifndef NO_P6
    { pg8::Gemm g{AB, W_GU2, MTOK, 2 * DFF, DM}; pg8::StaticOrder S; S.init(MTOK, 2 * DFF, G, (int)blockIdx.x); EpiSwiGLU E{ACT, nullptr};
      pg8::gemm_phase<EpiSwiGLU, pg8::StaticOrder, true, true>(lds, g, S, E, wave);
#ifdef P6_TWICE
      pg8::gemm_phase<EpiSwiGLU, pg8::StaticOrder, true, true>(lds, g, S, E, wave);
#endif
    }
#endif
    GRID_BAR();
#ifndef NO_P7
    { pg8::Gemm g{ACT, W_D2, MTOK, DM, DFF}; pg8::StaticOrder S; S.init(MTOK, DM, G, (int)blockIdx.x);
      EpiExch<false> E{nullptr, AB, RN2, 0.5f, H, (const float*)(ws + WS_SMALL) + SM_FNG, nullptr, nullptr, (float*)(ws + WS_XBUF) + (size_t)MTOK * 8, (unsigned*)(ws + WS_CTL + CTL_CNT) + 2 * CTL_BANK};
      pg8::gemm_phase<EpiExch<false>, pg8::StaticOrder, false, true>(lds, g, S, E, wave); }
#endif
#if defined(CG_SYNC_AT_END)
    grid.sync();
#endif
}

extern "C" void kernel_launch(void* const* d_in, const int* in_sizes, int n_in, void* d_out, int out_size, void* d_ws, size_t ws_size, hipStream_t stream) {
    static int grid_blocks = 0;
    if (grid_blocks == 0) {
        if (n_in != 25 || ws_size < WS_END) { fprintf(stderr, "kernel_launch: unexpected inputs (n_in %d, ws %zu)\n", n_in, ws_size); grid_blocks = -1; return; }
        int dev = 0, cus = 0, per_cu = 0;
        hipGetDevice(&dev); hipDeviceGetAttribute(&cus, hipDeviceAttributeMultiprocessorCount, dev);
        if (hipFuncSetAttribute((const void*)fwd_megakernel, hipFuncAttributeMaxDynamicSharedMemorySize, LDS_BYTES) != hipSuccess) fprintf(stderr, "kernel_launch: hipFuncSetAttribute failed\n");
        if (hipOccupancyMaxActiveBlocksPerMultiprocessor(&per_cu, (const void*)fwd_megakernel, 512, LDS_BYTES) != hipSuccess || per_cu < 1) { fprintf(stderr, "kernel_launch: occupancy query failed (%d)\n", per_cu); per_cu = 1; }
        (void)hipGetLastError();
        grid_blocks = cus * 1;
        if (grid_blocks != 256) { fprintf(stderr, "kernel_launch: built for a 256-CU device (one 256x256 unit per workgroup in the fused final phase), found %d CUs; nothing launched\n", cus); grid_blocks = -1; return; }
        fprintf(stderr, "kernel_launch: cus %d per_cu %d grid %d\n", cus, per_cu, grid_blocks);
    }
    if (grid_blocks < 0) return;
    if (hipMemsetAsync((char*)d_ws + WS_CTL, 0, CTL_BYTES, stream) != hipSuccess) { fprintf(stderr, "kernel_launch: memset failed\n"); return; }
    Params p{};
    for (int i = 0; i < 25; ++i) p.in[i] = (const float*)d_in[i];
    p.out = (float*)d_out; p.ws = (unsigned char*)d_ws;
    void* args[] = {&p};
    hipError_t e = hipLaunchCooperativeKernel((const void*)fwd_megakernel, dim3(grid_blocks), dim3(512), args, LDS_BYTES, stream);
    if (e != hipSuccess) fprintf(stderr, "cooperative launch failed: %s (grid %d)\n", hipGetErrorString(e), grid_blocks);
}
```

```cpp
#include <hip/hip_runtime.h>
#include <hip/hip_cooperative_groups.h>
#include <cstdio>
#include <cstdint>
namespace cg = cooperative_groups;
namespace pg8 {
#define PG8_LAS __attribute__((address_space(3)))
typedef unsigned short bf16_t;
typedef short bf16x8 __attribute__((ext_vector_type(8)));
typedef float f32x4 __attribute__((ext_vector_type(4)));
typedef unsigned u32x4 __attribute__((ext_vector_type(4)));
constexpr int BM = 256, BK = 64, HALF = 128, HTB = HALF * BK * 2  , STAGE_BYTES = 8 * HTB, NXCD = 8, WGM = 8;

__host__ __device__ __forceinline__ int lds_byte(int r, int c) { const int st = (r >> 4) * 2 + (c >> 5), rr = r & 15, cc = c & 31, ob = rr * 64 + cc * 2; return st * 1024 + (ob ^ (((ob >> 9) & 1) << 5)); }
__host__ __device__ __forceinline__ void stage_rc(int b, int& R, int& C) { const int st = b / 1024, sb = b % 1024, swz = sb ^ (((sb >> 9) & 1) << 5); R = (st >> 1) * 16 + swz / 64; C = (st & 1) * 32 + (swz % 64) / 2; }
__host__ __device__ __forceinline__ int perm32(int rho) { const int n = rho >> 4, i = rho & 15; return 8 * (i >> 2) + 4 * n + (i & 3); }

struct Unit { int pm, pn; };
struct Gemm { const bf16_t* A; const bf16_t* Bt; int M, N, K; };

struct StaticOrder {
    int nM, nN, nwg, G, c;
    __host__ __device__ void init(int M, int N, int G_, int c_) { nM = M / BM; nN = N / BM; nwg = nM * nN; G = G_; c = c_; }
    __host__ __device__ bool next(int i, Unit& u) const {
        const long L = (long)i * G + c; if (L >= nwg) return false;
        int wgid = (int)L; { const int q = nwg / NXCD, r = nwg % NXCD, xcd = wgid % NXCD, off = wgid / NXCD; wgid = (xcd < r ? xcd * (q + 1) : r * (q + 1) + (xcd - r) * q) + off; }
        const int nig = WGM * nN, gid = wgid / nig, fm = gid * WGM, gsz = (nM - fm) < WGM ? (nM - fm) : WGM;
        u.pm = fm + ((wgid % nig) % gsz); u.pn = (wgid % nig) / gsz; return true;
    }
    __device__ __forceinline__ void a_ready(const Unit&) const {}
    __device__ __forceinline__ void done(const Unit&) const {}
};

__device__ __forceinline__ unsigned cvt_pk_bf16(float lo, float hi) { unsigned r; asm volatile("v_cvt_pk_bf16_f32 %0, %1, %2" : "=v"(r) : "v"(lo), "v"(hi)); return r; }
typedef float f32x2 __attribute__((ext_vector_type(2)));
template <class Epi, class Sched, bool ALIGN_EPI = false, bool SP2 = false>
__device__ __forceinline__ void gemm_phase(PG8_LAS unsigned char* lds, const Gemm g, const Sched& S, const Epi& E, int wave_id) {
    int tid_; asm volatile("v_mbcnt_lo_u32_b32 %0, -1, 0\n\tv_mbcnt_hi_u32_b32 %0, -1, %0" : "=v"(tid_)); tid_ += wave_id * 64;
    const int tid = tid_, wid = __builtin_amdgcn_readfirstlane(tid >> 6), lane = tid & 63, wr = wid >> 2, wc = wid & 3, fr = lane & 15, fq = lane >> 4;
    const int K = g.K, nt = K / BK;
    unsigned voffA[2], voffB[2];
#pragma unroll
    for (int i = 0; i < 2; ++i) { int R, C; stage_rc(tid * 16 + i * 8192, R, C); const int Rb = Epi::PERM ? ((R & ~31) + perm32(R & 31)) : R;
        voffA[i] = (unsigned)(R * K + C) * 2u; voffB[i] = (unsigned)(Rb * K + C) * 2u; }
    const size_t kstep = (size_t)(BK * 2);
    const size_t hstep = (size_t)HALF * K * 2;
    const size_t tstep = 2 * hstep;
    const unsigned ldsw = (unsigned)wid * 1024u;
    const int aoff = lds_byte(wr * 64 + fr, fq * 8), boff = lds_byte(wc * 32 + fr, fq * 8);
#define PG8_SA(b, h) (((b) * 2 + (h)) * HTB)
#define PG8_SB(b, h) ((4 + (b) * 2 + (h)) * HTB)
#define PG8_STAGE(bufoff, gbase, voff) do { _Pragma("unroll") for (int _i = 0; _i < 2; ++_i) \
        __builtin_amdgcn_global_load_lds((const unsigned*)((const char*)(gbase) + (voff)[_i]), (PG8_LAS unsigned*)(lds + (bufoff) + ldsw + _i * 8192), 16, 0, 0); } while (0)
#define PG8_LDA(dst, b, h) do { _Pragma("unroll") for (int m = 0; m < 4; ++m) _Pragma("unroll") for (int k = 0; k < 2; ++k) dst[m][k] = *(const PG8_LAS bf16x8*)(lds + PG8_SA(b, h) + aoff + m * 2048 + k * 1024); } while (0)
#define PG8_LDB(dst, b, h) do { _Pragma("unroll") for (int n = 0; n < 2; ++n) _Pragma("unroll") for (int k = 0; k < 2; ++k) dst[n][k] = *(const PG8_LAS bf16x8*)(lds + PG8_SB(b, h) + boff + n * 2048 + k * 1024); } while (0)
#define PG8_MMA(ai, bj, At, Bt) do { __builtin_amdgcn_s_setprio(1); _Pragma("unroll") for (int m = 0; m < 4; ++m) _Pragma("unroll") for (int n = 0; n < 2; ++n) _Pragma("unroll") for (int k = 0; k < 2; ++k) \
        acc[ai][bj][m][n] = __builtin_amdgcn_mfma_f32_16x16x32_bf16(Bt[n][k], At[m][k], acc[ai][bj][m][n], 0, 0, 0); __builtin_amdgcn_s_setprio(0); } while (0)
#define PG8_WAIT_V(n) asm volatile("s_waitcnt vmcnt(" #n ")" ::: "memory")
#define PG8_WAIT_L(n) asm volatile("s_waitcnt lgkmcnt(" #n ")" ::: "memory")
#define PG8_BAR __builtin_amdgcn_s_barrier()
#define PG8_SCHED __builtin_amdgcn_sched_barrier(0)
    Unit cur, nxt; int ui = 0;
    if (!S.next(0, cur)) return;
    f32x4 acc[2][2][4][2];
#pragma unroll
    for (int a = 0; a < 2; ++a)
#pragma unroll
        for (int b = 0; b < 2; ++b)
#pragma unroll
            for (int m = 0; m < 4; ++m)
#pragma unroll
                for (int n = 0; n < 2; ++n) acc[a][b][m][n] = (f32x4){0.f, 0.f, 0.f, 0.f};
    bf16x8 At[4][2], B0[2][2], B1[2][2];
    const char* cA = (const char*)g.A + (size_t)cur.pm * tstep; const char* cB = (const char*)g.Bt + (size_t)cur.pn * tstep;
    S.a_ready(cur);
    if constexpr (SP2) {
        PG8_STAGE(PG8_SB(0, 0), cB, voffB); PG8_STAGE(PG8_SB(0, 1), cB + hstep, voffB); PG8_STAGE(PG8_SA(0, 0), cA, voffA); PG8_STAGE(PG8_SA(0, 1), cA + hstep, voffA);
        if (wr == 1) PG8_BAR;
        PG8_WAIT_V(2); PG8_BAR;
        PG8_STAGE(PG8_SB(1, 0), cB + kstep, voffB); PG8_STAGE(PG8_SA(1, 0), cA + kstep, voffA); PG8_STAGE(PG8_SB(1, 1), cB + hstep + kstep, voffB);
        PG8_WAIT_V(6); PG8_BAR;
    } else {
        PG8_STAGE(PG8_SB(0, 0), cB, voffB); PG8_STAGE(PG8_SA(0, 0), cA, voffA); PG8_STAGE(PG8_SB(0, 1), cB + hstep, voffB); PG8_STAGE(PG8_SA(0, 1), cA + hstep, voffA);
        if (wr == 1) PG8_BAR;
        PG8_WAIT_V(4); PG8_BAR;
        PG8_STAGE(PG8_SB(1, 0), cB + kstep, voffB); PG8_STAGE(PG8_SA(1, 0), cA + kstep, voffA); PG8_STAGE(PG8_SB(1, 1), cB + hstep + kstep, voffB);
        PG8_WAIT_V(6); PG8_BAR;
    }
    for (;;) {
        const bool has_next = S.next(ui + 1, nxt);
        const char* nA = has_next ? (const char*)g.A + (size_t)nxt.pm * tstep : cA; const char* nB = has_next ? (const char*)g.Bt + (size_t)nxt.pn * tstep : cB;
        for (int t = 0; t < nt; t += 2) {
            const bool last = (t == nt - 2);
            const char* a1 = cA + (size_t)(t + 1) * kstep;
            const char* a2 = last ? nA : cA + (size_t)(t + 2) * kstep; const char* b2 = last ? nB : cB + (size_t)(t + 2) * kstep;
            const char* a3 = a2 + kstep; const char* b3 = b2 + kstep;
            if (last && has_next) S.a_ready(nxt);
            if constexpr (SP2) {
            PG8_LDB(B0, 0, 0); PG8_LDB(B1, 0, 1); PG8_SCHED; PG8_LDA(At, 0, 0); PG8_STAGE(PG8_SA(1, 1), a1 + hstep, voffA);
            PG8_WAIT_V(8); PG8_WAIT_L(0); PG8_BAR; PG8_MMA(0, 0, At, B0); PG8_MMA(0, 1, At, B1); PG8_BAR; PG8_SCHED;
            PG8_LDA(At, 0, 1); PG8_STAGE(PG8_SB(0, 0), b2, voffB); PG8_STAGE(PG8_SB(0, 1), b2 + hstep, voffB); PG8_STAGE(PG8_SA(0, 0), a2, voffA);
            PG8_WAIT_V(8); PG8_WAIT_L(0); PG8_BAR; PG8_MMA(1, 0, At, B0); PG8_MMA(1, 1, At, B1); PG8_BAR; PG8_SCHED;
            PG8_LDB(B0, 1, 0); PG8_LDB(B1, 1, 1); PG8_SCHED; PG8_LDA(At, 1, 0); PG8_STAGE(PG8_SA(0, 1), a2 + hstep, voffA);
            PG8_WAIT_V(8); PG8_WAIT_L(0); PG8_BAR; PG8_MMA(0, 0, At, B0); PG8_MMA(0, 1, At, B1); PG8_BAR; PG8_SCHED;
            PG8_LDA(At, 1, 1); PG8_STAGE(PG8_SB(1, 0), b3, voffB); PG8_STAGE(PG8_SB(1, 1), b3 + hstep, voffB); PG8_STAGE(PG8_SA(1, 0), a3, voffA);
            PG8_WAIT_V(8); PG8_WAIT_L(0); PG8_BAR; PG8_MMA(1, 0, At, B0); PG8_MMA(1, 1, At, B1); PG8_BAR; PG8_SCHED;
            } else {
            PG8_LDB(B0, 0, 0); PG8_SCHED; PG8_LDA(At, 0, 0); PG8_STAGE(PG8_SA(1, 1), a1 + hstep, voffA);
            PG8_WAIT_L(8); PG8_BAR; PG8_WAIT_L(0); PG8_MMA(0, 0, At, B0); PG8_BAR; PG8_SCHED;
            PG8_LDB(B1, 0, 1); PG8_STAGE(PG8_SB(0, 0), b2, voffB);
            PG8_BAR; PG8_WAIT_L(0); PG8_MMA(0, 1, At, B1); PG8_BAR;
            PG8_LDA(At, 0, 1); PG8_STAGE(PG8_SA(0, 0), a2, voffA);
            PG8_BAR; PG8_WAIT_L(0); PG8_MMA(1, 0, At, B0); PG8_BAR; PG8_SCHED;
            PG8_STAGE(PG8_SB(0, 1), b2 + hstep, voffB);
            PG8_WAIT_V(6); PG8_BAR; PG8_MMA(1, 1, At, B1); PG8_BAR;
            PG8_LDB(B0, 1, 0); PG8_SCHED; PG8_LDA(At, 1, 0); PG8_STAGE(PG8_SA(0, 1), a2 + hstep, voffA);
            PG8_WAIT_L(8); PG8_BAR; PG8_WAIT_L(0); PG8_MMA(0, 0, At, B0); PG8_BAR; PG8_SCHED;
            PG8_LDB(B1, 1, 1); PG8_STAGE(PG8_SB(1, 0), b3, voffB);
            PG8_BAR; PG8_WAIT_L(0); PG8_MMA(0, 1, At, B1); PG8_BAR;
            PG8_LDA(At, 1, 1); PG8_STAGE(PG8_SA(1, 0), a3, voffA);
            PG8_BAR; PG8_WAIT_L(0); PG8_MMA(1, 0, At, B0); PG8_BAR; PG8_SCHED;
            PG8_STAGE(PG8_SB(1, 1), b3 + hstep, voffB);
            PG8_WAIT_V(6); PG8_BAR; PG8_MMA(1, 1, At, B1); PG8_BAR;
            }
        }
        if constexpr (ALIGN_EPI) { if (wr == 0) PG8_BAR; }
        if constexpr (!Epi::AFTER_DRAIN) { E(acc, cur, wr, wc, fr, fq); S.done(cur); }
        if (!has_next) break;
#pragma unroll
        for (int a = 0; a < 2; ++a)
#pragma unroll
            for (int b = 0; b < 2; ++b)
#pragma unroll
                for (int m = 0; m < 4; ++m)
#pragma unroll
                    for (int n = 0; n < 2; ++n) acc[a][b][m][n] = (f32x4){0.f, 0.f, 0.f, 0.f};
        cur = nxt; cA = nA; cB = nB; ++ui;
        if constexpr (ALIGN_EPI) { if (wr == 1) PG8_BAR; }
    }
    PG8_WAIT_V(0);
    if constexpr (!ALIGN_EPI) { if (wr == 0) PG8_BAR; }
    PG8_BAR;
    if constexpr (Epi::AFTER_DRAIN) { E.fused(acc, cur, wr, wc, fr, fq, lds, wid, lane); S.done(cur); }
#undef PG8_SA
#undef PG8_SB
#undef PG8_STAGE
#undef PG8_LDA
#undef PG8_LDB
#undef PG8_MMA
#undef PG8_WAIT_V
#undef PG8_WAIT_L
#undef PG8_BAR
#undef PG8_SCHED
}
}

#define LAS __attribute__((address_space(3)))
__device__ __forceinline__ int lane_id_v() { int l; asm volatile("v_mbcnt_lo_u32_b32 %0, -1, 0\n\tv_mbcnt_hi_u32_b32 %0, -1, %0" : "=v"(l)); return l; }
#define LANE_ID() lane_id_v()
template <int M> __device__ __forceinline__ float sxor(float v) { return __builtin_bit_cast(float, __builtin_amdgcn_ds_swizzle(__builtin_bit_cast(int, v), (M << 10) | 0x1f)); }
__device__ __forceinline__ void swap32(float& a, float& b) { asm volatile("s_nop 1\n\tv_permlane32_swap_b32 %0, %1\n\ts_nop 3" : "+v"(a), "+v"(b)); }
__device__ __forceinline__ float hsum32(float v) { float a = v, b = v; swap32(a, b); return a + b; }
typedef unsigned short bf16_t;
typedef pg8::f32x4 f32x4;
typedef pg8::u32x4 u32x4;
typedef unsigned u32x2 __attribute__((ext_vector_type(2)));
constexpr int SEQ = 8192, NB = 2, MTOK = NB * SEQ, DM = 1024, DFF = 2816, NMEM = 256, INW = 2304;
constexpr float EPS = 1e-5f;
constexpr float QSCALE = 0.125f * 1.4426950408889634f;
constexpr size_t MiB = 1u << 20;
constexpr size_t WS_WGU1 = 0, WS_WD1 = 11 * MiB, WS_WIN = 16 * MiB + MiB / 2, WS_WMKV = 21 * MiB, WS_WOUT = 22 * MiB, WS_WGU2 = 24 * MiB, WS_WD2 = 35 * MiB;
constexpr size_t WS_ROPE = 41 * MiB, WS_SSQ = 43 * MiB, WS_MEMN = 44 * MiB, WS_MK = 45 * MiB, WS_MVT = 45 * MiB + MiB / 4;
constexpr size_t WS_SMALL = 45 * MiB + MiB / 2;
constexpr int SM_LAM = 0, SM_SUBLN = 256, SM_DWW = 384, SM_DWB = SM_DWW + 31 * 256, SM_LNG = SM_DWB + 256, SM_LNB = SM_LNG + 256, SM_FNG = SM_LNB + 256, SM_END = SM_FNG + 1024;
constexpr size_t WS_CTL = 45 * MiB + 3 * MiB / 4, CTL_BYTES = 65536, CTL_CNT = 16384, CTL_BANK = 4096;
constexpr size_t WS_AB = 46 * MiB, WS_ACT = 78 * MiB, WS_MIXED = 166 * MiB, WS_XBUF = 198 * MiB  , WS_END = 199 * MiB;
constexpr size_t WS_Q = WS_ACT, WS_K = WS_ACT + 16 * MiB, WS_VT = WS_ACT + 32 * MiB, WS_G = WS_ACT + 48 * MiB, WS_MQ = WS_ACT + 56 * MiB;
constexpr int LDS_BYTES = 131072 + 1024;

#ifndef DEFER_W
#define DEFER_W 1
#endif
struct Params { const float* in[25]; float* out; unsigned char* ws; };

__device__ __forceinline__ unsigned f2bf(float f) { unsigned u = __builtin_bit_cast(unsigned, f); return (u + 0x7fffu + ((u >> 16) & 1u)) >> 16; }
__device__ __forceinline__ float bf2f(unsigned short h) { return __builtin_bit_cast(float, (unsigned)h << 16); }
__device__ __forceinline__ unsigned pk2(float lo, float hi) { return pg8::cvt_pk_bf16(lo, hi); }
__device__ __forceinline__ int perm16(int k) { return (k & 3) | (((k >> 3) & 1) << 2) | (((k >> 2) & 1) << 3); }
__device__ __forceinline__ float wave_sum(float v) {
    v += sxor<1>(v); v += sxor<2>(v); v += sxor<4>(v); v += sxor<8>(v); v += sxor<16>(v); v = hsum32(v);
    return v;
}
__device__ __forceinline__ float row_rstd(const float* ssq, int row) {
    const f32x4* p = (const f32x4*)(ssq + (size_t)row * 16);
    const f32x4 a = p[0], b = p[1], c = p[2], d = p[3];
    const float s = ((a.x + a.y) + (a.z + a.w)) + ((b.x + b.y) + (b.z + b.w)) + ((c.x + c.y) + (c.z + c.w)) + ((d.x + d.y) + (d.z + d.w));
    return 1.0f / sqrtf(s * (1.0f / DM) + EPS);
}
__device__ __forceinline__ float row_rstd_q(const float* ssq, int row, int fq) {
    const f32x4 a = ((const f32x4*)(ssq + (size_t)row * 16))[fq];
    float s = (a.x + a.y) + (a.z + a.w);
    s += sxor<16>(s); s = hsum32(s);
    return __builtin_amdgcn_rsqf(s * (1.0f / DM) + EPS);
}
__device__ __forceinline__ float silu_f(float g) { return g * __builtin_amdgcn_rcpf(1.0f + __expf(-g)); }

__device__ __forceinline__ void rows_rstd8(const float* ssq, int row0, int fq, float (&rs)[8]) {
    f32x4 pv[8];
#pragma unroll
    for (int i = 0; i < 8; ++i) pv[i] = ((const f32x4*)(ssq + (size_t)(row0 + (i >> 2) * 128 + (i & 3) * 16) * 16))[fq];
#pragma unroll
    for (int i = 0; i < 8; ++i) { float t = (pv[i].x + pv[i].y) + (pv[i].z + pv[i].w); t += sxor<16>(t); t = hsum32(t); rs[i] = __builtin_amdgcn_rsqf(t * (1.0f / DM) + EPS); }
}

#ifndef EPI_FENCE
#define EPI_FENCE(m) ((m) == 3)
#endif
struct EpiSwiGLU {
    static constexpr bool PERM = true, AFTER_DRAIN = false;
    bf16_t* O; const float* ssq;
    __device__ __forceinline__ void operator()(const f32x4 (&acc)[2][2][4][2], const pg8::Unit& u, int wr, int wc, int fr, int fq) const {
        asm volatile("" : "+v"(fr), "+v"(fq));
        const int row0 = u.pm * 256 + wr * 64 + fr, col0 = u.pn * 128 + wc * 32 + fq * 8;
        float rs8[8];
        if (ssq) rows_rstd8(ssq, row0, fq, rs8); else {
#pragma unroll
            for (int i = 0; i < 8; ++i) rs8[i] = 1.0f; }
#pragma unroll
        for (int ai = 0; ai < 2; ++ai)
#pragma unroll
            for (int m = 0; m < 4; ++m) {
                const int row = row0 + ai * 128 + m * 16;
                const float rs = rs8[ai * 4 + m];
                float v[8];
#pragma unroll
                for (int n = 0; n < 2; ++n)
#pragma unroll
                    for (int i = 0; i < 4; ++i) v[n * 4 + i] = silu_f(acc[ai][0][m][n][i] * rs) * (acc[ai][1][m][n][i] * rs);
                u32x4 w; w.x = pk2(v[0], v[1]); w.y = pk2(v[2], v[3]); w.z = pk2(v[4], v[5]); w.w = pk2(v[6], v[7]);
                *(u32x4*)(O + (size_t)row * DFF + col0) = w;
                if (EPI_FENCE(m)) asm volatile("" ::: "memory");
            }
    }
};
struct EpiResid {
    static constexpr bool PERM = true, AFTER_DRAIN = false;
    const float* basef; const bf16_t* baseb; float* H; bf16_t* HB; float* ssq; float alpha;
    __device__ __forceinline__ void row_part(const f32x4& a0, const f32x4& a1, const f32x4& b0, const f32x4& b1, size_t off, float& ss) const {
        const f32x4 h0 = b0 + a0 * alpha, h1 = b1 + a1 * alpha;
        if (H) { *(f32x4*)(H + off) = h0; *(f32x4*)(H + off + 4) = h1; }
        if (HB) { u32x4 w; w.x = pk2(h0.x, h0.y); w.y = pk2(h0.z, h0.w); w.z = pk2(h1.x, h1.y); w.w = pk2(h1.z, h1.w); *(u32x4*)(HB + off) = w; }
        ss += (h0.x * h0.x + h0.y * h0.y) + (h0.z * h0.z + h0.w * h0.w) + (h1.x * h1.x + h1.y * h1.y) + (h1.z * h1.z + h1.w * h1.w);
    }
    __device__ __forceinline__ void row_end(float ss, int row, int pn, int wc, int fq) const {
        if (ssq) { ss += sxor<16>(ss); ss = hsum32(ss); if (fq == 0) ssq[(size_t)row * 16 + pn * 4 + wc] = ss; }
    }
    __device__ __forceinline__ void operator()(const f32x4 (&acc)[2][2][4][2], const pg8::Unit& u, int wr, int wc, int fr, int fq) const {
        asm volatile("" : "+v"(fr), "+v"(fq));
        const int row0 = u.pm * 256 + wr * 64 + fr, col0 = u.pn * 256 + wc * 32 + fq * 8;
        if (basef) {
#pragma unroll
            for (int g = 0; g < 4; ++g) {
                f32x4 pre[2][2][2];
#pragma unroll
                for (int k = 0; k < 2; ++k)
#pragma unroll
                    for (int bj = 0; bj < 2; ++bj) { const size_t off = (size_t)(row0 + (g >> 1) * 128 + ((g & 1) * 2 + k) * 16) * DM + col0 + bj * 128;
                        pre[k][bj][0] = *(const f32x4*)(basef + off); pre[k][bj][1] = *(const f32x4*)(basef + off + 4); }
#pragma unroll
                for (int k = 0; k < 2; ++k) { const int ai = g >> 1, m = (g & 1) * 2 + k, row = row0 + ai * 128 + m * 16; float ss = 0.f;
#pragma unroll
                    for (int bj = 0; bj < 2; ++bj) row_part(acc[ai][bj][m][0], acc[ai][bj][m][1], pre[k][bj][0], pre[k][bj][1], (size_t)row * DM + col0 + bj * 128, ss);
                    row_end(ss, row, u.pn, wc, fq); }
                asm volatile("" ::: "memory");
            }
        } else {
#pragma unroll
            for (int ai = 0; ai < 2; ++ai) {
                u32x4 pre[4][2];
#pragma unroll
                for (int m = 0; m < 4; ++m)
#pragma unroll
                    for (int bj = 0; bj < 2; ++bj) pre[m][bj] = *(const u32x4*)(baseb + (size_t)(row0 + ai * 128 + m * 16) * DM + col0 + bj * 128);
#pragma unroll
                for (int m = 0; m < 4; ++m) { const int row = row0 + ai * 128 + m * 16; float ss = 0.f;
#pragma unroll
                    for (int bj = 0; bj < 2; ++bj) { const u32x4 w = pre[m][bj];
                        const f32x4 b0 = (f32x4){__builtin_bit_cast(float, w.x << 16), __builtin_bit_cast(float, w.x & 0xffff0000u), __builtin_bit_cast(float, w.y << 16), __builtin_bit_cast(float, w.y & 0xffff0000u)};
                        const f32x4 b1 = (f32x4){__builtin_bit_cast(float, w.z << 16), __builtin_bit_cast(float, w.z & 0xffff0000u), __builtin_bit_cast(float, w.w << 16), __builtin_bit_cast(float, w.w & 0xffff0000u)};
                        row_part(acc[ai][bj][m][0], acc[ai][bj][m][1], b0, b1, (size_t)row * DM + col0 + bj * 128, ss); }
                    row_end(ss, row, u.pn, wc, fq); }
                asm volatile("" ::: "memory");
            }
        }
    }
};
template <bool F32BASE> struct EpiExch {
    static constexpr bool PERM = true, AFTER_DRAIN = true;
    const float* basef; const bf16_t* baseb; const float* rnin; float alpha; float* OUT; const float* gfin; bf16_t* HBN; float* rnout; float* xbuf; unsigned* cnt;
    __device__ __forceinline__ void fused(f32x4 (&acc)[2][2][4][2], const pg8::Unit& u, int wr, int wc, int fr, int fq, LAS unsigned char* lds, int wid, int lane) const {
        asm volatile("" : "+v"(fr), "+v"(fq), "+v"(lane));
        LAS float* Pp = (LAS float*)lds;
        LAS float* S = (LAS float*)(lds + 4096);
        const int col0 = u.pn * 256 + wc * 32 + fq * 8;
        const int rowl0 = wr * 64 + fr;
        if constexpr (F32BASE) {
            unsigned vofff = (unsigned)((rowl0 * DM + col0) * 4); asm volatile("" : "+v"(vofff));
#pragma unroll
            for (int g = 0; g < 8; ++g) {
                const int ai = g >> 2, m = g & 3; f32x4 pre[2][2];
#pragma unroll
                for (int bj = 0; bj < 2; ++bj) { const char* sb = (const char*)(basef + (size_t)(u.pm * 256 + ai * 128 + m * 16) * DM + bj * 128);
                    pre[bj][0] = __builtin_nontemporal_load((const f32x4*)(sb + vofff)); pre[bj][1] = __builtin_nontemporal_load((const f32x4*)(sb + vofff + 16)); }
                float ss = 0.f;
#pragma unroll
                for (int bj = 0; bj < 2; ++bj) { const f32x4 h0 = pre[bj][0] + acc[ai][bj][m][0] * alpha, h1 = pre[bj][1] + acc[ai][bj][m][1] * alpha;
                    acc[ai][bj][m][0] = h0; acc[ai][bj][m][1] = h1;
                    ss += (h0.x * h0.x + h0.y * h0.y) + (h0.z * h0.z + h0.w * h0.w) + (h1.x * h1.x + h1.y * h1.y) + (h1.z * h1.z + h1.w * h1.w); }
                ss += sxor<16>(ss); ss = hsum32(ss);
                if (fq == 0) Pp[(rowl0 + ai * 128 + m * 16) * 4 + wc] = ss;
                if (g & 1) asm volatile("" ::: "memory");
            }
        } else {
#pragma unroll
            for (int ai = 0; ai < 2; ++ai) {
                u32x4 pre[4][2]; float rn[4];
#pragma unroll
                for (int m = 0; m < 4; ++m) { const int row = u.pm * 256 + rowl0 + ai * 128 + m * 16; rn[m] = rnin ? rnin[row] : 1.0f;
#pragma unroll
                    for (int bj = 0; bj < 2; ++bj) pre[m][bj] = *(const u32x4*)(baseb + (size_t)row * DM + col0 + bj * 128); }
#pragma unroll
                for (int m = 0; m < 4; ++m) { float ss = 0.f;
#pragma unroll
                    for (int bj = 0; bj < 2; ++bj) {
                        const u32x4 w = pre[m][bj];
                        const f32x4 b0 = (f32x4){__builtin_bit_cast(float, w.x << 16), __builtin_bit_cast(float, w.x & 0xffff0000u), __builtin_bit_cast(float, w.y << 16), __builtin_bit_cast(float, w.y & 0xffff0000u)};
                        const f32x4 b1 = (f32x4){__builtin_bit_cast(float, w.z << 16), __builtin_bit_cast(float, w.z & 0xffff0000u), __builtin_bit_cast(float, w.w << 16), __builtin_bit_cast(float, w.w & 0xffff0000u)};
                        const f32x4 h0 = b0 * rn[m] + acc[ai][bj][m][0] * alpha, h1 = b1 * rn[m] + acc[ai][bj][m][1] * alpha;
                        acc[ai][bj][m][0] = h0; acc[ai][bj][m][1] = h1;
                        ss += (h0.x * h0.x + h0.y * h0.y) + (h0.z * h0.z + h0.w * h0.w) + (h1.x * h1.x + h1.y * h1.y) + (h1.z * h1.z + h1.w * h1.w);
                    }
                    ss += sxor<16>(ss); ss = hsum32(ss);
                    if (fq == 0) Pp[(rowl0 + ai * 128 + m * 16) * 4 + wc] = ss;
                }
                asm volatile("" ::: "memory");
            }
        }
        asm volatile("s_waitcnt lgkmcnt(0)" ::: "memory"); __builtin_amdgcn_s_barrier(); asm volatile("" ::: "memory");
        const int t = wid * 64 + lane;
        if (t < 256) { const f32x4 p = *(const LAS f32x4*)(Pp + t * 4);
            __hip_atomic_store(xbuf + (size_t)(u.pm * 256 + t) * 4 + u.pn, (p.x + p.y) + (p.z + p.w), __ATOMIC_RELAXED, __HIP_MEMORY_SCOPE_AGENT); }
        asm volatile("s_waitcnt vmcnt(0)" ::: "memory");
        if (lane == 0) __hip_atomic_fetch_add(cnt + 64 * u.pm, 1u, __ATOMIC_RELAXED, __HIP_MEMORY_SCOPE_AGENT);
        if (wid == 0) {
            unsigned spins = 0;
            while ((unsigned)__builtin_amdgcn_readfirstlane(__hip_atomic_load(cnt + 64 * u.pm, __ATOMIC_RELAXED, __HIP_MEMORY_SCOPE_AGENT)) < 32u) { __builtin_amdgcn_s_sleep(2); if (++spins > (1u << 22)) break; }
            __builtin_amdgcn_fence(__ATOMIC_ACQUIRE, "agent");
        }
        asm volatile("s_waitcnt vmcnt(0) lgkmcnt(0)" ::: "memory"); __builtin_amdgcn_s_barrier(); asm volatile("" ::: "memory");
        if (t < 256) { const float* sl = xbuf + (size_t)(u.pm * 256 + t) * 4; float q = 0.f;
#pragma unroll
            for (int k = 0; k < 4; ++k) q += __hip_atomic_load(sl + k, __ATOMIC_RELAXED, __HIP_MEMORY_SCOPE_AGENT);
            const float ms = q * (1.0f / DM) + EPS;
            S[t] = __builtin_amdgcn_rsqf(ms);
            if (rnout && u.pn == 0) rnout[u.pm * 256 + t] = sqrtf(ms); }
        asm volatile("s_waitcnt lgkmcnt(0)" ::: "memory"); __builtin_amdgcn_s_barrier(); asm volatile("" ::: "memory");
        if (OUT) {
#pragma unroll
            for (int bj = 0; bj < 2; ++bj) { const f32x4 g0 = *(const f32x4*)(gfin + col0 + bj * 128), g1 = *(const f32x4*)(gfin + col0 + bj * 128 + 4);
#pragma unroll
                for (int ai = 0; ai < 2; ++ai)
#pragma unroll
                    for (int m = 0; m < 4; ++m) { const int rl = rowl0 + ai * 128 + m * 16; const float rs = S[rl];
                        float* op = OUT + (size_t)(u.pm * 256 + rl) * DM + col0 + bj * 128;
                        *(f32x4*)op = acc[ai][bj][m][0] * rs * g0; *(f32x4*)(op + 4) = acc[ai][bj][m][1] * rs * g1; }
                asm volatile("" ::: "memory"); }
        } else {
#pragma unroll
            for (int ai = 0; ai < 2; ++ai)
#pragma unroll
                for (int m = 0; m < 4; ++m) { const int rl = rowl0 + ai * 128 + m * 16; const float rs = S[rl];
#pragma unroll
                    for (int bj = 0; bj < 2; ++bj) { const f32x4 a0 = acc[ai][bj][m][0] * rs, a1 = acc[ai][bj][m][1] * rs;
                        u32x4 w; w.x = pk2(a0.x, a0.y); w.y = pk2(a0.z, a0.w); w.z = pk2(a1.x, a1.y); w.w = pk2(a1.z, a1.w);
                        *(u32x4*)(HBN + (size_t)(u.pm * 256 + rl) * DM + col0 + bj * 128) = w; }
                    if (m & 1) asm volatile("" ::: "memory"); }
        }
    }
};
struct EpiInProj {
    static constexpr bool PERM = true, AFTER_DRAIN = false;
    const float* ssq; const float* ropec; const float* ropes; bf16_t *Q, *K, *VT, *G, *MQ;
    __device__ __forceinline__ void operator()(const f32x4 (&acc)[2][2][4][2], const pg8::Unit& u, int wr, int wc, int fr, int fq) const {
        asm volatile("" : "+v"(fr), "+v"(fq));
        const int row0 = u.pm * 256 + wr * 64 + fr; const int pn = u.pn;
        float rs8[8];
        if (ssq) rows_rstd8(ssq, row0, fq, rs8); else {
#pragma unroll
            for (int i = 0; i < 8; ++i) rs8[i] = 1.0f; }
        f32x4 rc[2][2], rsn[2][2];
#pragma unroll
        for (int ai = 0; ai < 2; ++ai)
#pragma unroll
            for (int m = 0; m < 4; ++m) {
                const int row = row0 + ai * 128 + m * 16;
                const float rs = rs8[ai * 4 + m];
                if (pn < 4) {
                    const int pos = row & (SEQ - 1);
                    const float sc = (pn < 2) ? QSCALE : 1.0f;
                    if ((m & 1) == 0) {
#pragma unroll
                        for (int k = 0; k < 2; ++k)
#pragma unroll
                            for (int n = 0; n < 2; ++n) { rc[k][n] = *(const f32x4*)(ropec + (pos + 16 * k) * 32 + fq * 8 + n * 4); rsn[k][n] = *(const f32x4*)(ropes + (pos + 16 * k) * 32 + fq * 8 + n * 4); } }
                    float o1[8], o2[8];
#pragma unroll
                    for (int n = 0; n < 2; ++n) {
                        const f32x4 c = rc[m & 1][n], s = rsn[m & 1][n];
#pragma unroll
                        for (int i = 0; i < 4; ++i) { const float x1 = acc[ai][0][m][n][i] * rs, x2 = acc[ai][1][m][n][i] * rs;
                            o1[n * 4 + i] = (x1 * c[i] - x2 * s[i]) * sc; o2[n * 4 + i] = (x2 * c[i] + x1 * s[i]) * sc; }
                    }
                    bf16_t* dst = ((pn < 2) ? Q : K) + (size_t)row * 512 + (pn & 1) * 256 + wc * 64 + fq * 8;
                    u32x4 w; w.x = pk2(o1[0], o1[1]); w.y = pk2(o1[2], o1[3]); w.z = pk2(o1[4], o1[5]); w.w = pk2(o1[6], o1[7]); *(u32x4*)dst = w;
                    w.x = pk2(o2[0], o2[1]); w.y = pk2(o2[2], o2[3]); w.z = pk2(o2[4], o2[5]); w.w = pk2(o2[6], o2[7]); *(u32x4*)(dst + 32) = w;
                } else if (pn < 6) {
                    const int b = u.pm >> 5, t = row & (SEQ - 1);
                    unsigned voff = (unsigned)((wc * 32 + fq * 8) * SEQ + ((t & ~15) | perm16(t & 15))); asm volatile("" : "+v"(voff));
#pragma unroll
                    for (int bj = 0; bj < 2; ++bj)
#pragma unroll
                        for (int n = 0; n < 2; ++n)
#pragma unroll
                            for (int i = 0; i < 4; ++i) { bf16_t* bp = VT + (size_t)((b * 4 + (pn - 4) * 2 + bj) * 128 + n * 4 + i) * SEQ;
                                bp[voff] = (bf16_t)f2bf(acc[ai][bj][m][n][i] * rs); }
                } else if (pn < 8) {
                    float v[8];
#pragma unroll
                    for (int n = 0; n < 2; ++n)
#pragma unroll
                        for (int i = 0; i < 4; ++i) { const float a = acc[ai][0][m][n][i] * rs, g = acc[ai][1][m][n][i] * rs; v[n * 4 + i] = a * __builtin_amdgcn_rcpf(1.0f + __expf(-g)); }
                    u32x4 w; w.x = pk2(v[0], v[1]); w.y = pk2(v[2], v[3]); w.z = pk2(v[4], v[5]); w.w = pk2(v[6], v[7]);
                    *(u32x4*)(G + (size_t)row * 256 + (pn - 6) * 128 + wc * 32 + fq * 8) = w;
                } else {
#pragma unroll
                    for (int bj = 0; bj < 2; ++bj) { const f32x4 a0 = acc[ai][bj][m][0] * (rs * QSCALE), a1 = acc[ai][bj][m][1] * (rs * QSCALE);
                        u32x4 w; w.x = pk2(a0.x, a0.y); w.y = pk2(a0.z, a0.w); w.z = pk2(a1.x, a1.y); w.w = pk2(a1.z, a1.w);
                        *(u32x4*)(MQ + (size_t)row * 256 + bj * 128 + wc * 32 + fq * 8) = w; }
                }
                if (EPI_FENCE(m)) asm volatile("" ::: "memory");
            }
    }
};
struct EpiMemKV {
    static constexpr bool PERM = true, AFTER_DRAIN = false;
    bf16_t *MK, *MVT;
    __device__ __forceinline__ void operator()(const f32x4 (&acc)[2][2][4][2], const pg8::Unit& u, int wr, int wc, int fr, int fq) const {
        asm volatile("" : "+v"(fr), "+v"(fq));
        const int row0 = u.pm * 256 + wr * 64 + fr;
#pragma unroll
        for (int ai = 0; ai < 2; ++ai)
#pragma unroll
            for (int m = 0; m < 4; ++m) {
                const int row = row0 + ai * 128 + m * 16;
                if (u.pn == 0) {
#pragma unroll
                    for (int bj = 0; bj < 2; ++bj) { const f32x4 a0 = acc[ai][bj][m][0], a1 = acc[ai][bj][m][1];
                        u32x4 w; w.x = pk2(a0.x, a0.y); w.y = pk2(a0.z, a0.w); w.z = pk2(a1.x, a1.y); w.w = pk2(a1.z, a1.w);
                        *(u32x4*)(MK + (size_t)row * 256 + bj * 128 + wc * 32 + fq * 8) = w; }
                } else {
                    const int b = u.pm, mi = row & 255;
                    unsigned voff = (unsigned)((wc * 32 + fq * 8) * NMEM + ((mi & ~15) | perm16(mi & 15))); asm volatile("" : "+v"(voff));
#pragma unroll
                    for (int bj = 0; bj < 2; ++bj)
#pragma unroll
                        for (int n = 0; n < 2; ++n)
#pragma unroll
                            for (int i = 0; i < 4; ++i) { bf16_t* bp = MVT + (size_t)((b * 4 + bj * 2) * 64 + n * 4 + i) * NMEM;
                                bp[voff] = (bf16_t)f2bf(acc[ai][bj][m][n][i]); }
                }
                if (EPI_FENCE(m)) asm volatile("" ::: "memory");
            }
    }
};

__device__ __forceinline__ void transpose_item(const float* W, int ldw, int s0, const float* gain, bf16_t* WT, int K, int p0, int k0, LAS float* scr, int lane) {
    float v[32];
    const float* wp = W + (size_t)(k0 + (lane >> 5)) * ldw + s0 + (lane & 31);
#pragma unroll
    for (int i = 0; i < 32; ++i) v[i] = __builtin_nontemporal_load(wp + (size_t)(2 * i) * ldw);
    const int c = lane & 7;
    f32x4 g0 = {1.f, 1.f, 1.f, 1.f}, g1 = g0;
    if (gain) { g0 = *(const f32x4*)(gain + k0 + 8 * c); g1 = *(const f32x4*)(gain + k0 + 8 * c + 4); }
#pragma unroll
    for (int i = 0; i < 32; ++i) scr[(2 * i + (lane >> 5)) * 33 + (lane & 31)] = v[i];
    asm volatile("s_waitcnt lgkmcnt(0)" ::: "memory");
#pragma unroll
    for (int j = 0; j < 4; ++j) { const int n = (lane >> 3) + 8 * j; const LAS float* s = scr + (8 * c) * 33 + n;
        u32x4 o; o.x = pk2(s[0 * 33] * g0.x, s[1 * 33] * g0.y); o.y = pk2(s[2 * 33] * g0.z, s[3 * 33] * g0.w); o.z = pk2(s[4 * 33] * g1.x, s[5 * 33] * g1.y); o.w = pk2(s[6 * 33] * g1.z, s[7 * 33] * g1.w);
        *(u32x4*)(WT + (size_t)(p0 + n) * K + k0 + 8 * c) = o; }
    asm volatile("s_waitcnt lgkmcnt(0)" ::: "memory");
}
__device__ __forceinline__ int in_src_col(int p0) {
    const int pn = p0 >> 8, p = p0 & 255, bj = p >> 7, wc = (p >> 5) & 3;
    if (pn < 4) return 256 * pn + 64 * wc + 32 * bj;
    if (pn == 6 || pn == 7) return (bj ? 1792 : 1536) + 128 * (pn - 6) + (p & 127);
    return p0;
}
__device__ __forceinline__ void rms_row_to_bf16(const float* xrow, const float* g, bf16_t* orow, int lane) {
    const f32x4* xr = (const f32x4*)xrow + lane; const f32x4* gr = (const f32x4*)g + lane;
    f32x4 v[4]; float s = 0.f;
#pragma unroll
    for (int j = 0; j < 4; ++j) { v[j] = __builtin_nontemporal_load(&xr[64 * j]); s += (v[j].x * v[j].x + v[j].y * v[j].y) + (v[j].z * v[j].z + v[j].w * v[j].w); }
    const float rstd = 1.0f / sqrtf(wave_sum(s) * (1.0f / DM) + EPS);
    u32x2* o8 = (u32x2*)orow + lane;
#pragma unroll
    for (int j = 0; j < 4; ++j) { const f32x4 gg = gr[64 * j]; u32x2 w; w.x = pk2(v[j].x * rstd * gg.x, v[j].y * rstd * gg.y); w.y = pk2(v[j].z * rstd * gg.z, v[j].w * rstd * gg.w); o8[64 * j] = w; }
}
__device__ __forceinline__ void rms_row2_to_bf16(const float* xa, const float* xb, const float* g, bf16_t* oa, bf16_t* ob, int lane) {
    const f32x4* ra = (const f32x4*)xa + lane; const f32x4* rb = (const f32x4*)xb + lane; const f32x4* gr = (const f32x4*)g + lane;
    f32x4 va[4], vb[4]; float sa = 0.f, sb = 0.f;
#pragma unroll
    for (int j = 0; j < 4; ++j) { va[j] = __builtin_nontemporal_load(&ra[64 * j]); vb[j] = __builtin_nontemporal_load(&rb[64 * j]); }
#pragma unroll
    for (int j = 0; j < 4; ++j) { sa += (va[j].x * va[j].x + va[j].y * va[j].y) + (va[j].z * va[j].z + va[j].w * va[j].w); sb += (vb[j].x * vb[j].x + vb[j].y * vb[j].y) + (vb[j].z * vb[j].z + vb[j].w * vb[j].w); }
    sa += sxor<1>(sa); sb += sxor<1>(sb); sa += sxor<2>(sa); sb += sxor<2>(sb); sa += sxor<4>(sa); sb += sxor<4>(sb); sa += sxor<8>(sa); sb += sxor<8>(sb); sa += sxor<16>(sa); sb += sxor<16>(sb);
    sa = hsum32(sa); sb = hsum32(sb);
    const float rsa = 1.0f / sqrtf(sa * (1.0f / DM) + EPS), rsb = 1.0f / sqrtf(sb * (1.0f / DM) + EPS);
    u32x2* pa = (u32x2*)oa + lane; u32x2* pb = (u32x2*)ob + lane;
#pragma unroll
    for (int j = 0; j < 4; ++j) { const f32x4 gg = gr[64 * j]; u32x2 w;
        w.x = pk2(va[j].x * rsa * gg.x, va[j].y * rsa * gg.y); w.y = pk2(va[j].z * rsa * gg.z, va[j].w * rsa * gg.w); pa[64 * j] = w;
        w.x = pk2(vb[j].x * rsb * gg.x, vb[j].y * rsb * gg.y); w.y = pk2(vb[j].z * rsb * gg.z, vb[j].w * rsb * gg.w); pb[64 * j] = w; }
}

template <int NJ>
__device__ __forceinline__ void naive_stream(const bf16_t* qp, const bf16_t* Kb, int kpitch, const bf16_t* Vt, int vpitch, int nkeys, float (&o)[NJ]) {
    u32x4 q[8];
#pragma unroll
    for (int j = 0; j < 8; ++j) q[j] = *(const u32x4*)(qp + 8 * j);
#define BLO(w) __builtin_bit_cast(float, (w) << 16)
#define BHI(w) __builtin_bit_cast(float, (w) & 0xffff0000u)
    float mx = -INFINITY, l = 0.f; int zoff = 0; asm volatile("" : "+v"(zoff));
#pragma unroll
    for (int j = 0; j < NJ; ++j) o[j] = 0.f;
    for (int kb = 0; kb < nkeys; kb += 16) {
        float s[16];
#pragma unroll
        for (int kk = 0; kk < 16; ++kk) {
            const bf16_t* kp = Kb + (size_t)(kb + kk) * kpitch + zoff; float a = 0.f;
#pragma unroll
            for (int j = 0; j < 8; ++j) { const u32x4 w = *(const u32x4*)(kp + 8 * j);
                a += BLO(q[j].x) * BLO(w.x) + BHI(q[j].x) * BHI(w.x); a += BLO(q[j].y) * BLO(w.y) + BHI(q[j].y) * BHI(w.y);
                a += BLO(q[j].z) * BLO(w.z) + BHI(q[j].z) * BHI(w.z); a += BLO(q[j].w) * BLO(w.w) + BHI(q[j].w) * BHI(w.w); }
            s[kk] = a;
        }
        float bm = s[0];
#pragma unroll
        for (int kk = 1; kk < 16; ++kk) bm = fmaxf(bm, s[kk]);
        const float mn = fmaxf(mx, bm), sc = exp2f(mx - mn); mx = mn;
        float ps = 0.f;
#pragma unroll
        for (int kk = 0; kk < 16; ++kk) { s[kk] = exp2f(s[kk] - mn); ps += s[kk]; }
        l = l * sc + ps;
#pragma unroll
        for (int j = 0; j < NJ; ++j) {
            const bf16_t* vp = Vt + (size_t)j * vpitch + kb;
            const u32x4 w0 = *(const u32x4*)vp, w1 = *(const u32x4*)(vp + 8);
            float a = 0.f;
            a += s[0] * __builtin_bit_cast(float, w0.x << 16) + s[1] * __builtin_bit_cast(float, w0.x & 0xffff0000u);
            a += s[2] * __builtin_bit_cast(float, w0.y << 16) + s[3] * __builtin_bit_cast(float, w0.y & 0xffff0000u);
            a += s[8] * __builtin_bit_cast(float, w0.z << 16) + s[9] * __builtin_bit_cast(float, w0.z & 0xffff0000u);
            a += s[10] * __builtin_bit_cast(float, w0.w << 16) + s[11] * __builtin_bit_cast(float, w0.w & 0xffff0000u);
            a += s[4] * __builtin_bit_cast(float, w1.x << 16) + s[5] * __builtin_bit_cast(float, w1.x & 0xffff0000u);
            a += s[6] * __builtin_bit_cast(float, w1.y << 16) + s[7] * __builtin_bit_cast(float, w1.y & 0xffff0000u);
            a += s[12] * __builtin_bit_cast(float, w1.z << 16) + s[13] * __builtin_bit_cast(float, w1.z & 0xffff0000u);
            a += s[14] * __builtin_bit_cast(float, w1.w << 16) + s[15] * __builtin_bit_cast(float, w1.w & 0xffff0000u);
            o[j] = o[j] * sc + a;
        }
    }
    const float rl = 1.0f / l;
#pragma unroll
    for (int j = 0; j < NJ; ++j) o[j] *= rl;
}


typedef short bf16x8 __attribute__((ext_vector_type(8)));
typedef float f32x16 __attribute__((ext_vector_type(16)));
typedef float f32x2_t __attribute__((ext_vector_type(2)));
typedef __bf16 bf16x2_t __attribute__((ext_vector_type(2)));
__device__ __forceinline__ unsigned cvtpk_s(float lo, float hi) { f32x2_t v = {lo, hi}; bf16x2_t b = __builtin_convertvector(v, bf16x2_t); return __builtin_bit_cast(unsigned, b); }
__device__ __forceinline__ int crow(int r, int hi) { return (r & 3) + 8 * (r >> 2) + 4 * hi; }
#define MFMA32(a, b, c) __builtin_amdgcn_mfma_f32_32x32x16_bf16((a), (b), (c), 0, 0, 0)
constexpr int KST = 144;
constexpr int DA_KSLOT = 16384, DA_VSLOT = 16384, DA_V0 = 3 * DA_KSLOT;
constexpr int DA_WSF = DA_V0 + 3 * DA_VSLOT;
constexpr int MA_VST = 528, MA_VT = 256 * KST;
static_assert(DA_WSF >= 65536 && DA_WSF + 1024 <= 131072 && MA_VT + 64 * MA_VST <= DA_WSF, "attention LDS map");

__device__ __forceinline__ void qk_tile(const LAS unsigned char* Kt, int kst, const bf16x8 (&qr)[4], f32x16& p0, f32x16& p1, int r32, int hi) {
#pragma unroll
    for (int r = 0; r < 16; ++r) { p0[r] = 0.f; p1[r] = 0.f; }
    const LAS unsigned char* ka = Kt + r32 * kst + hi * 16;
#pragma unroll
    for (int ds = 0; ds < 4; ++ds) {
        const bf16x8 a0 = *(const LAS bf16x8*)(ka + ds * 32), a1 = *(const LAS bf16x8*)(ka + 32 * kst + ds * 32);
        p0 = MFMA32(a0, qr[ds], p0); p1 = MFMA32(a1, qr[ds], p1);
    }
}
__device__ __forceinline__ float half_max(float v) { float a = v, b = v; swap32(a, b); return fmaxf(a, b); }
__device__ __forceinline__ float half_sum(float v) { return hsum32(v); }
template <int NDB>
__device__ __forceinline__ void soft_max_rescale(const f32x16& p0, const f32x16& p1, f32x16 (&o)[NDB], float& m, float& l, LAS float* wsf, int r32, int hi) {
    float ra = fmaxf(p0[0], p1[0]), rb = fmaxf(p0[1], p1[1]);
#pragma unroll
    for (int r = 2; r < 16; r += 2) { ra = fmaxf(ra, fmaxf(p0[r], p1[r])); rb = fmaxf(rb, fmaxf(p0[r + 1], p1[r + 1])); }
    const float rm = half_max(fmaxf(ra, rb));
    if (__any(rm > m + 8.0f)) {
        const float mn = (rm > m + 8.0f) ? rm : m;
        const float alpha = __builtin_amdgcn_exp2f(m - mn); l *= alpha; m = mn;
        asm volatile("" ::: "memory");
        if (hi == 0) wsf[r32] = alpha;
        asm volatile("" ::: "memory");
        float al[16];
#pragma unroll
        for (int r = 0; r < 16; ++r) al[r] = wsf[crow(r, hi)];
#pragma unroll
        for (int blk = 0; blk < NDB; ++blk)
#pragma unroll
            for (int r = 0; r < 16; ++r) o[blk][r] *= al[r];
        asm volatile("" ::: "memory");
    }
}
__device__ __forceinline__ void soft_exp_pack(f32x16& p0, f32x16& p1, float m, float& l, bf16x8 (&pa)[4]) {
    float ps0 = 0.f, ps1 = 0.f;
#pragma unroll
    for (int r = 0; r < 16; ++r) { p0[r] = __builtin_amdgcn_exp2f(p0[r] - m); p1[r] = __builtin_amdgcn_exp2f(p1[r] - m); ps0 += p0[r]; ps1 += p1[r]; }
    l += ps0 + ps1;
    u32x4 w;
    w.x = cvtpk_s(p0[0], p0[1]); w.y = cvtpk_s(p0[2], p0[3]); w.z = cvtpk_s(p0[4], p0[5]); w.w = cvtpk_s(p0[6], p0[7]); pa[0] = __builtin_bit_cast(bf16x8, w);
    w.x = cvtpk_s(p0[8], p0[9]); w.y = cvtpk_s(p0[10], p0[11]); w.z = cvtpk_s(p0[12], p0[13]); w.w = cvtpk_s(p0[14], p0[15]); pa[1] = __builtin_bit_cast(bf16x8, w);
    w.x = cvtpk_s(p1[0], p1[1]); w.y = cvtpk_s(p1[2], p1[3]); w.z = cvtpk_s(p1[4], p1[5]); w.w = cvtpk_s(p1[6], p1[7]); pa[2] = __builtin_bit_cast(bf16x8, w);
    w.x = cvtpk_s(p1[8], p1[9]); w.y = cvtpk_s(p1[10], p1[11]); w.z = cvtpk_s(p1[12], p1[13]); w.w = cvtpk_s(p1[14], p1[15]); pa[3] = __builtin_bit_cast(bf16x8, w);
}
template <int NDB>
__device__ __forceinline__ void pv_tile(const LAS unsigned char* Vt, int vst, const bf16x8 (&pa)[4], f32x16 (&o)[NDB], int r32, int hi) {
    const LAS unsigned char* va = Vt + r32 * vst + hi * 16;
#pragma unroll
    for (int st = 0; st < 4; ++st)
#pragma unroll
        for (int blk = 0; blk < NDB; ++blk) {
            const bf16x8 vb = *(const LAS bf16x8*)(va + blk * 32 * vst + st * 32);
            o[blk] = MFMA32(pa[st], vb, o[blk]);
        }
}
template <int NDB>
__device__ __forceinline__ void attn_tile(const LAS unsigned char* Kt, int kst, const LAS unsigned char* Vt, int vst, const bf16x8 (&qr)[4], f32x16 (&o)[NDB], float& m, float& l, LAS float* wsf, int r32, int hi) {
    f32x16 p0, p1; bf16x8 pa[4];
    qk_tile(Kt, kst, qr, p0, p1, r32, hi);
    soft_max_rescale<NDB>(p0, p1, o, m, l, wsf, r32, hi);
    soft_exp_pack(p0, p1, m, l, pa);
    pv_tile<NDB>(Vt, vst, pa, o, r32, hi);
}

#define SB() __builtin_amdgcn_sched_barrier(0)
#define LDF(p) (*(const LAS bf16x8*)(p))
__device__ __forceinline__ float row_max32(const f32x16& p0, const f32x16& p1) {
    float ra = fmaxf(fmaxf(p0[0], p0[1]), p1[0]), rb = fmaxf(fmaxf(p0[2], p0[3]), p1[1]); ra = fmaxf(fmaxf(ra, p1[2]), p1[3]);
#pragma unroll
    for (int r = 4; r < 16; r += 4) { ra = fmaxf(fmaxf(ra, p0[r]), p0[r + 1]); rb = fmaxf(fmaxf(rb, p0[r + 2]), p0[r + 3]); ra = fmaxf(fmaxf(ra, p1[r]), p1[r + 1]); rb = fmaxf(fmaxf(rb, p1[r + 2]), p1[r + 3]); }
    return half_max(fmaxf(ra, rb));
}
__device__ __forceinline__ void da_shift(float d, f32x16& n0, f32x16& n1, f32x16 (&o)[4], float& m, float& l, LAS float* wsf, int r32, int hi) {
    m += d;
#pragma unroll
    for (int r = 0; r < 16; ++r) { n0[r] -= d; n1[r] -= d; }
    const float alpha = __builtin_amdgcn_exp2f(-d); l *= alpha;
    asm volatile("" ::: "memory");
    if (hi == 0) wsf[r32] = alpha;
    asm volatile("" ::: "memory");
    float al[16];
#pragma unroll
    for (int r = 0; r < 16; ++r) al[r] = wsf[crow(r, hi)];
#pragma unroll
    for (int blk = 0; blk < 4; ++blk)
#pragma unroll
        for (int r = 0; r < 16; ++r) o[blk][r] *= al[r];
    asm volatile("" ::: "memory");
}
__device__ __forceinline__ bf16x8 pack8(const f32x16& p, int b) { u32x4 w; w.x = cvtpk_s(p[b], p[b + 1]); w.y = cvtpk_s(p[b + 2], p[b + 3]); w.z = cvtpk_s(p[b + 4], p[b + 5]); w.w = cvtpk_s(p[b + 6], p[b + 7]); return __builtin_bit_cast(bf16x8, w); }
template <bool DOQK>
__device__ __forceinline__ void da_step(const LAS unsigned char* Kt, const LAS unsigned char* Vt, const unsigned (&swo)[4], const bf16x8 (&qr)[4], f32x16& c0, f32x16& c1, f32x16& n0, f32x16& n1, float ninit,
                                        f32x16 (&o)[4], float& l, float& rmn) {
    constexpr int VPF = 3;
    bf16x8 kf[2][2], vf[VPF + 1], pa[4];
    float psa = 0.f, psb = 0.f, one = 1.0f; asm volatile("" : "+v"(one));
    if (DOQK) { kf[0][0] = LDF(Kt + swo[0]); kf[0][1] = LDF(Kt + swo[0] + 32 * 128);
#pragma unroll
        for (int r = 0; r < 16; ++r) { n0[r] = ninit; n1[r] = ninit; } }
    SB();
#define VFA(j) (Vt + swo[(j) >> 2] + ((j) & 3) * 32 * 128)
#pragma unroll
    for (int ds = 0; ds < 4; ++ds) {
        if (DOQK && ds < 3) { kf[(ds + 1) & 1][0] = LDF(Kt + swo[ds + 1]); kf[(ds + 1) & 1][1] = LDF(Kt + swo[ds + 1] + 32 * 128); }
        if (ds + VPF >= 4) vf[ds + VPF - 4] = LDF(VFA(ds + VPF - 4));
        if (DOQK) n0 = MFMA32(kf[ds & 1][0], qr[ds], n0);
        c0[4 * ds + 0] = __builtin_amdgcn_exp2f(c0[4 * ds + 0]); c0[4 * ds + 1] = __builtin_amdgcn_exp2f(c0[4 * ds + 1]);
        if (DOQK) n1 = MFMA32(kf[ds & 1][1], qr[ds], n1);
        c0[4 * ds + 2] = __builtin_amdgcn_exp2f(c0[4 * ds + 2]); c0[4 * ds + 3] = __builtin_amdgcn_exp2f(c0[4 * ds + 3]);
        psa = __builtin_fmaf(c0[4 * ds + 0], one, psa); psb += c0[4 * ds + 1]; psa = __builtin_fmaf(c0[4 * ds + 2], one, psa); psb += c0[4 * ds + 3];
        if (ds == 1) pa[0] = pack8(c0, 0);
        if (ds == 3) pa[1] = pack8(c0, 8);
        SB();
    }
    float ra = -INFINITY;
#pragma unroll
    for (int j = 0; j < 16; ++j) {
        const int st = j >> 2, blk = j & 3;
        if (j + VPF < 16) vf[(j + VPF) % (VPF + 1)] = LDF(VFA(j + VPF));
        o[blk] = MFMA32(pa[st], vf[j % (VPF + 1)], o[blk]);
        if (st < 2) { const int e = 8 * st + 2 * blk;
            c1[e] = __builtin_amdgcn_exp2f(c1[e]); c1[e + 1] = __builtin_amdgcn_exp2f(c1[e + 1]); psa = __builtin_fmaf(c1[e], one, psa); psb += c1[e + 1];
            if (blk == 3) pa[2 + st] = pack8(c1, 8 * st);
        } else if (DOQK) {
            if (st == 2) ra = fmaxf(fmaxf(fmaxf(ra, n0[4 * blk]), fmaxf(n0[4 * blk + 1], n0[4 * blk + 2])), n0[4 * blk + 3]);
            else         ra = fmaxf(fmaxf(fmaxf(ra, n1[4 * blk]), fmaxf(n1[4 * blk + 1], n1[4 * blk + 2])), n1[4 * blk + 3]);
        }
        SB();
    }
#undef VFA
    l += psa + psb;
    if (DOQK) rmn = half_max(ra);
}
__device__ __forceinline__ void qk_tile_sw(const LAS unsigned char* Kt, const unsigned (&swo)[4], const bf16x8 (&qr)[4], f32x16& p0, f32x16& p1) {
#pragma unroll
    for (int r = 0; r < 16; ++r) { p0[r] = 0.f; p1[r] = 0.f; }
#pragma unroll
    for (int ds = 0; ds < 4; ++ds) {
        const bf16x8 a0 = LDF(Kt + swo[ds]), a1 = LDF(Kt + swo[ds] + 32 * 128);
        p0 = MFMA32(a0, qr[ds], p0); p1 = MFMA32(a1, qr[ds], p1);
    }
}

#define XB_TMO      128
#define XB_XCNT(j)  (256  + 64 * (j))
#define XB_XSUB(j)  (1280 + 64 * (j))
#define XB_XGEN(j)  (2304 + 64 * (j))
#define XB_TOP      3328
#define XB_TOPGEN   3392
#define XCD_BAR_WORDS 3456
#define XB_SPIN_CAP (1u << 18)

__device__ __forceinline__ unsigned xb_ld(unsigned* p)              { return __hip_atomic_load(p, __ATOMIC_RELAXED, __HIP_MEMORY_SCOPE_AGENT); }
__device__ __forceinline__ unsigned xb_add(unsigned* p, unsigned v) { return __hip_atomic_fetch_add(p, v, __ATOMIC_RELAXED, __HIP_MEMORY_SCOPE_AGENT); }
__device__ __forceinline__ unsigned xb_xcc_id() { return (unsigned)__builtin_amdgcn_s_getreg((3 << 11) | 20) & 0xFu; }
#define XB_SPIN(cond, bar) do { unsigned _sp = 0; while (cond) { __builtin_amdgcn_s_sleep(1); \
    if ((++_sp & 255u) == 0u) { if (xb_ld(&(bar)[XB_TMO])) break; if (_sp > XB_SPIN_CAP) { atomicAdd(&(bar)[XB_TMO], 1u); break; } } } } while (0)

struct XcdBarrier {
    unsigned* bar; unsigned x; bool w0;
    volatile LAS unsigned* st;
};

__device__ __forceinline__ XcdBarrier xcd_barrier_post(unsigned* bar, volatile LAS unsigned* st) {
    XcdBarrier b; b.bar = bar; b.x = xb_xcc_id(); b.st = st;
    if (threadIdx.x == 0) (void)xb_add(&bar[XB_XCNT(b.x)], 1u);
    return b;
}
__device__ __forceinline__ void xcd_barrier_complete(unsigned* bar, unsigned x, unsigned& nloc, unsigned& nx) {
    const unsigned G = gridDim.x * gridDim.y * gridDim.z;
    unsigned sum, cnt, mine, sp = 0u;
    for (;;) {
        sum = 0u; cnt = 0u; mine = 0u;
#pragma unroll
        for (unsigned j = 0; j < 16; ++j) { const unsigned c = xb_ld(&bar[XB_XCNT(j)]); sum += c; cnt += (c > 0u) ? 1u : 0u; mine = (j == x) ? c : mine; }
        if (sum == G) break;
        __builtin_amdgcn_s_sleep(1);
        if ((++sp & 255u) == 0u) { if (xb_ld(&bar[XB_TMO])) break; if (sp > XB_SPIN_CAP) { atomicAdd(&bar[XB_TMO], 1u); break; } }
    }
    nloc = mine > 0u ? mine : 1u; nx = cnt > 0u ? cnt : 1u;
}

__device__ __forceinline__ void xcd_barrier(const XcdBarrier& b) {
    asm volatile("s_waitcnt vmcnt(0)" ::: "memory");
    __syncthreads();
    if (b.w0 && LANE_ID() == 0) {
        unsigned* bar = b.bar;
        __builtin_amdgcn_s_waitcnt(0);
        unsigned nloc = b.st[0], nx = b.st[1];
        if (nloc == 0u) { xcd_barrier_complete(bar, b.x, nloc, nx); b.st[0] = nloc; b.st[1] = nx; }
        const unsigned old = xb_add(&bar[XB_XSUB(b.x)], 1u);
        const unsigned gen = old / nloc;
        if (old + 1u == (gen + 1u) * nloc) {
            __builtin_amdgcn_fence(__ATOMIC_RELEASE, "agent");
            asm volatile("s_waitcnt vmcnt(0)" ::: "memory");
            const unsigned og = xb_add(&bar[XB_TOP], 1u);
            const unsigned tg = og / nx;
            if (og + 1u == (tg + 1u) * nx) xb_add(&bar[XB_TOPGEN], 1u);
            else XB_SPIN(xb_ld(&bar[XB_TOPGEN]) == tg, bar);
            __builtin_amdgcn_fence(__ATOMIC_ACQUIRE, "agent");
            xb_add(&bar[XB_XGEN(b.x)], 1u);
            asm volatile("s_waitcnt vmcnt(0)" ::: "memory");
        } else {
            XB_SPIN(xb_ld(&bar[XB_XGEN(b.x)]) == gen, bar);
            __builtin_amdgcn_fence(__ATOMIC_ACQUIRE, "agent");
            asm volatile("s_waitcnt vmcnt(0)" ::: "memory");
        }
    }
    __syncthreads();
}

__global__ void __launch_bounds__(512, 2) fwd_megakernel(Params P) {
    extern __shared__ __attribute__((aligned(16))) unsigned char lds_raw[];
    LAS unsigned char* lds = (LAS unsigned char*)lds_raw;
    cg::grid_group grid = cg::this_grid();
    const int tid = threadIdx.x, lane = tid & 63, wave = __builtin_amdgcn_readfirstlane(tid >> 6);
    const int G = gridDim.x, gw = blockIdx.x * 8 + wave, NGW = G * 8;
    unsigned char* ws = P.ws;
    const float* x = P.in[0]; float* H = P.out;
    volatile LAS unsigned* bst = (volatile LAS unsigned*)(lds + 131072);
    if (tid < 2) bst[tid] = 0u;
    __syncthreads();
    XcdBarrier xbar = xcd_barrier_post((unsigned*)(ws + WS_CTL), bst); xbar.w0 = (wave == 0);
#if !defined(NO_CG_SYNC) && !defined(CG_SYNC_AT_END)
    grid.sync();
#endif
#define GRID_BAR() xcd_barrier(xbar)
    bf16_t* W_GU1 = (bf16_t*)(ws + WS_WGU1); bf16_t* W_D1 = (bf16_t*)(ws + WS_WD1); bf16_t* W_IN = (bf16_t*)(ws + WS_WIN); bf16_t* W_MKV = (bf16_t*)(ws + WS_WMKV);
    bf16_t* W_OUT = (bf16_t*)(ws + WS_WOUT); bf16_t* W_GU2 = (bf16_t*)(ws + WS_WGU2); bf16_t* W_D2 = (bf16_t*)(ws + WS_WD2);
    float* ROPEC = (float*)(ws + WS_ROPE); float* ROPES = ROPEC + SEQ * 32; float* SSQ = (float*)(ws + WS_SSQ); float* RN1 = SSQ; float* RN2 = SSQ + MTOK;
    bf16_t* MEMN = (bf16_t*)(ws + WS_MEMN); bf16_t* MK = (bf16_t*)(ws + WS_MK); bf16_t* MVT = (bf16_t*)(ws + WS_MVT);
    bf16_t* AB = (bf16_t*)(ws + WS_AB); bf16_t* ACT = (bf16_t*)(ws + WS_ACT); bf16_t* MIXED = (bf16_t*)(ws + WS_MIXED);
    bf16_t* Qb = (bf16_t*)(ws + WS_Q); bf16_t* Kb = (bf16_t*)(ws + WS_K); bf16_t* VT = (bf16_t*)(ws + WS_VT); bf16_t* Gb = (bf16_t*)(ws + WS_G); bf16_t* MQ = (bf16_t*)(ws + WS_MQ);

#ifndef P0_REPS
#define P0_REPS 1
#endif
    {
        LAS float* scr = (LAS float*)(lds + wave * 16384);
        constexpr int I_GU = (5632 / 32) * (DM / 64), I_D = DEFER_W ? 0 : (DM / 32) * (DFF / 64), I_IN = DEFER_W ? 0 : (INW / 32) * (DM / 64), I_MKV = DEFER_W ? 0 : (512 / 32) * (DM / 64);
        constexpr int NITEMS = I_GU + I_D + I_IN + I_MKV;
        for (int it = gw; it < NITEMS * P0_REPS; it += NGW) {
            int r = it % NITEMS;
            if (r < I_GU) {
                const int kb = r % (DM / 64), pb = r / (DM / 64), p0 = pb * 32, pn = p0 >> 8, bj = (p0 >> 7) & 1, j0 = p0 & 127;
                transpose_item(bj ? P.in[4] : P.in[3], DFF, 128 * pn + j0, nullptr, W_GU1, DM, p0, kb * 64, scr, lane); continue; }
            r -= I_GU;
            if (r < I_D) { const int kb = r % (DFF / 64), pb = r / (DFF / 64);
                transpose_item(P.in[5], DM, pb * 32, nullptr, W_D1, DFF, pb * 32, kb * 64, scr, lane); continue; }
            r -= I_D;
            if (r < I_IN) { const int kb = r % (DM / 64), pb = r / (DM / 64);
                transpose_item(P.in[8], INW, in_src_col(pb * 32), P.in[6], W_IN, DM, pb * 32, kb * 64, scr, lane); continue; }
            r -= I_IN;
            { const int kb = r % (DM / 64), pb = r / (DM / 64);
                transpose_item(P.in[18], 512, pb * 32, nullptr, W_MKV, DM, pb * 32, kb * 64, scr, lane); }
        }
#if !DEFER_W
        { constexpr int I_OUT = (DM / 32) * (DM / 64);
          for (int it = gw; it < I_GU + I_D + I_OUT; it += NGW) { int r = it;
            if (r < I_GU) { const int kb = r % (DM / 64), pb = r / (DM / 64), p0 = pb * 32, pn = p0 >> 8, bj = (p0 >> 7) & 1, j0 = p0 & 127;
                transpose_item(bj ? P.in[22] : P.in[21], DFF, 128 * pn + j0, P.in[20], W_GU2, DM, p0, kb * 64, scr, lane); continue; }
            r -= I_GU;
            if (r < I_D) { const int kb = r % (DFF / 64), pb = r / (DFF / 64);
                transpose_item(P.in[23], DM, pb * 32, nullptr, W_D2, DFF, pb * 32, kb * 64, scr, lane); continue; }
            r -= I_D;
            { const int kb = r % (DM / 64), pb = r / (DM / 64);
                transpose_item(P.in[19], DM, pb * 32, nullptr, W_OUT, DM, pb * 32, kb * 64, scr, lane); } } }
#endif
        for (int m = gw; m < MTOK; m += 2 * NGW) {
            if (m + NGW < MTOK) rms_row2_to_bf16(x + (size_t)m * DM, x + (size_t)(m + NGW) * DM, P.in[2], AB + (size_t)m * DM, AB + (size_t)(m + NGW) * DM, lane);
            else rms_row_to_bf16(x + (size_t)m * DM, P.in[2], AB + (size_t)m * DM, lane); }
        for (int m = gw; m < NB * NMEM; m += NGW) rms_row_to_bf16(P.in[1] + (size_t)m * DM, P.in[7], MEMN + (size_t)m * DM, lane);
        { float* SM = (float*)(ws + WS_SMALL);
          for (int e = blockIdx.x * 512 + tid; e < SM_END; e += G * 512) {
            float v;
            if (e < 64) v = P.in[9][e]; else if (e < 128) v = P.in[10][e - 64]; else if (e < 192) v = P.in[11][e - 128]; else if (e < SM_SUBLN) v = P.in[12][e - 192];
            else if (e < SM_DWW) v = P.in[13][e - SM_SUBLN];
            else if (e < SM_DWB) v = P.in[14][e - SM_DWW];
            else if (e < SM_LNG) v = P.in[15][e - SM_DWB];
            else if (e < SM_LNB) v = P.in[16][e - SM_LNG];
            else if (e < SM_FNG) v = P.in[17][e - SM_LNB];
            else v = P.in[24][e - SM_FNG];
            SM[e] = v; } }
        for (int e = blockIdx.x * 512 + tid; e < SEQ * 32; e += G * 512) {
            const int pos = e >> 5, i = e & 31;
            const float invf = (float)exp2(-(double)(2 * i) / 64.0 * 13.287712379549449);
            const float ang = (float)pos * invf;
            const double xd = (double)ang, kd = rint(xd * 0.63661977236758134), rr = fma(-kd, 1.5707963267948966, xd) - kd * 6.123233995736766e-17, r2 = rr * rr;
            const double sn = rr * (1.0 + r2 * (-1.0 / 6 + r2 * (1.0 / 120 + r2 * (-1.0 / 5040 + r2 * (1.0 / 362880 + r2 * (-1.0 / 39916800 + r2 * (1.0 / 6227020800.0)))))));
            const double cs = 1.0 + r2 * (-0.5 + r2 * (1.0 / 24 + r2 * (-1.0 / 720 + r2 * (1.0 / 40320 + r2 * (-1.0 / 3628800 + r2 * (1.0 / 479001600.0 + r2 * (-1.0 / 87178291200.0)))))));
            const int qd = ((int)kd) & 3;
            const double sv = (qd == 0) ? sn : (qd == 1) ? cs : (qd == 2) ? -sn : -cs;
            const double cv = (qd == 0) ? cs : (qd == 1) ? -sn : (qd == 2) ? -cs : sn;
            ROPEC[e] = (float)cv; ROPES[e] = (float)sv;
        }
    }
    GRID_BAR();
#ifndef NO_P1
    { pg8::Gemm g{AB, W_GU1, MTOK, 2 * DFF, DM}; pg8::StaticOrder S; S.init(MTOK, 2 * DFF, G, (int)blockIdx.x); EpiSwiGLU E{ACT, nullptr};
      pg8::gemm_phase<EpiSwiGLU, pg8::StaticOrder, true, true>(lds, g, S, E, wave);
#ifdef P1_TWICE
      pg8::gemm_phase<EpiSwiGLU, pg8::StaticOrder, true, true>(lds, g, S, E, wave);
#endif
    }
#if DEFER_W
    if ((int)blockIdx.x >= G / 2) {
        int lane_t = LANE_ID(); asm volatile("" : "+v"(lane_t)); const int lane = lane_t;
        LAS float* scr = (LAS float*)(lds + wave * 16384);
        constexpr int I_D1 = (DM / 32) * (DFF / 64), I_IN1 = (INW / 32) * (DM / 64), I_MKV1 = (512 / 32) * (DM / 64);
        for (int r0 = ((int)blockIdx.x - G / 2) * 8 + wave; r0 < I_D1 + I_IN1 + I_MKV1; r0 += (G - G / 2) * 8) {
            int r = r0;
            if (r < I_D1) { const int kb = r % (DFF / 64), pb = r / (DFF / 64);
                transpose_item(P.in[5], DM, pb * 32, nullptr, W_D1, DFF, pb * 32, kb * 64, scr, lane); continue; }
            r -= I_D1;
            if (r < I_IN1) { const int kb = r % (DM / 64), pb = r / (DM / 64);
                transpose_item(P.in[8], INW, in_src_col(pb * 32), P.in[6], W_IN, DM, pb * 32, kb * 64, scr, lane); continue; }
            r -= I_IN1;
            { const int kb = r % (DM / 64), pb = r / (DM / 64);
                transpose_item(P.in[18], 512, pb * 32, nullptr, W_MKV, DM, pb * 32, kb * 64, scr, lane); }
        }
    }
#endif
#endif
    GRID_BAR();
#ifdef SYNC_EXTRA
    for (int i = 0; i < SYNC_EXTRA; ++i) GRID_BAR();
#endif
#ifndef NO_P2
    { pg8::Gemm g{ACT, W_D1, MTOK, DM, DFF}; pg8::StaticOrder S; S.init(MTOK, DM, G, (int)blockIdx.x);
      EpiExch<true> E{x, nullptr, nullptr, 0.5f, nullptr, nullptr, AB, RN1, (float*)(ws + WS_XBUF), (unsigned*)(ws + WS_CTL + CTL_CNT)};
      pg8::gemm_phase<EpiExch<true>, pg8::StaticOrder, false, true>(lds, g, S, E, wave);
    }
#endif
    GRID_BAR();
#ifndef NO_P3
    { pg8::Gemm g{AB, W_IN, MTOK, INW, DM}; pg8::StaticOrder S; S.init(MTOK, INW, G, (int)blockIdx.x); EpiInProj E{nullptr, ROPEC, ROPES, Qb, Kb, VT, Gb, MQ};
      pg8::gemm_phase<EpiInProj, pg8::StaticOrder, true, true>(lds, g, S, E, wave);
#ifdef P3_TWICE
      pg8::gemm_phase<EpiInProj, pg8::StaticOrder, true, true>(lds, g, S, E, wave);
#endif
      pg8::Gemm g2{MEMN, W_MKV, NB * NMEM, 512, DM}; pg8::StaticOrder S2; S2.init(NB * NMEM, 512, G, ((int)blockIdx.x >= G - 4) ? (int)blockIdx.x - (G - 4) : 1 << 20); EpiMemKV E2{MK, MVT};
      pg8::gemm_phase<EpiMemKV, pg8::StaticOrder, true, true>(lds, g2, S2, E2, wave); }
#if DEFER_W
    if ((int)blockIdx.x >= G / 4 && (int)blockIdx.x < G - 4) {
        int lane_t = LANE_ID(); asm volatile("" : "+v"(lane_t)); const int lane = lane_t;
        LAS float* scr = (LAS float*)(lds + wave * 16384);
        constexpr int I_D = (DM / 32) * (DFF / 64), I_OUT = (DM / 32) * (DM / 64), I_GUH = (5632 / 32) * (DM / 64);
        for (int r0 = ((int)blockIdx.x - G / 4) * 8 + wave; r0 < I_D + I_OUT + I_GUH; r0 += (G - 4 - G / 4) * 8) {
            int r = r0;
            if (r < I_GUH) {
                const int kb = r % (DM / 64), pb = r / (DM / 64), p0 = pb * 32, pn = p0 >> 8, bj = (p0 >> 7) & 1, j0 = p0 & 127;
                transpose_item(bj ? P.in[22] : P.in[21], DFF, 128 * pn + j0, P.in[20], W_GU2, DM, p0, kb * 64, scr, lane); continue; }
            r -= I_GUH;
            if (r < I_OUT) { const int kb = r % (DM / 64), pb = r / (DM / 64);
                transpose_item(P.in[19], DM, pb * 32, nullptr, W_OUT, DM, pb * 32, kb * 64, scr, lane); continue; }
            r -= I_OUT;
            { const int kb = r % (DFF / 64), pb = r / (DFF / 64);
                transpose_item(P.in[23], DM, pb * 32, nullptr, W_D2, DFF, pb * 32, kb * 64, scr, lane); }
        }
    }
#endif
#endif
    GRID_BAR();
#ifndef NO_P4
    {
        const float* SM = (const float*)(ws + WS_SMALL);
#define LAM_COMPUTE(lamv) do { const int ll_ = LANE_ID(); const float a_ = SM[ll_] * SM[64 + ll_], b_ = SM[128 + ll_] * SM[192 + ll_]; lamv = __expf(wave_sum(a_)) - __expf(wave_sum(b_)) + 0.2f; } while (0)
#ifdef NAIVE_ATT
        float lam; LAM_COMPUTE(lam);
        {
            const int qi = lane >> 2, dq = lane & 3;
            for (int item = gw, rnd = 0; item < 4096; item += NGW, ++rnd) {
                const int bh = item & 7, rest = item >> 3, qsub = rest & 3; int ch = rest >> 2; if ((rnd & 1) && NGW == 2048) ch = 191 - ch;
                const int b = bh >> 2, h = bh & 3, row = b * SEQ + ch * 64 + qsub * 16 + qi, nkeys = (ch + 1) * 64;
                float o1[32], o2[32];
                naive_stream<32>(Qb + (size_t)row * 512 + h * 128, Kb + (size_t)b * SEQ * 512 + h * 128, 512, VT + ((size_t)(bh) * 128 + dq * 32) * SEQ, SEQ, nkeys, o1);
                naive_stream<32>(Qb + (size_t)row * 512 + h * 128 + 64, Kb + (size_t)b * SEQ * 512 + h * 128 + 64, 512, VT + ((size_t)(bh) * 128 + dq * 32) * SEQ, SEQ, nkeys, o2);
                float ss = 0.f;
#pragma unroll
                for (int j = 0; j < 32; ++j) { o1[j] -= lam * o2[j]; ss += o1[j] * o1[j]; }
                ss += sxor<1>(ss); ss += sxor<2>(ss);
                const float rs = 0.8f / sqrtf(ss * (1.0f / 128) + EPS);
                bf16_t* dst = MIXED + (size_t)row * DM + h * 128 + dq * 32;
#pragma unroll
                for (int j = 0; j < 32; j += 8) { u32x4 w;
                    w.x = pk2(o1[j] * rs * SM[SM_SUBLN + dq * 32 + j], o1[j + 1] * rs * SM[SM_SUBLN + dq * 32 + j + 1]); w.y = pk2(o1[j + 2] * rs * SM[SM_SUBLN + dq * 32 + j + 2], o1[j + 3] * rs * SM[SM_SUBLN + dq * 32 + j + 3]);
                    w.z = pk2(o1[j + 4] * rs * SM[SM_SUBLN + dq * 32 + j + 4], o1[j + 5] * rs * SM[SM_SUBLN + dq * 32 + j + 5]); w.w = pk2(o1[j + 6] * rs * SM[SM_SUBLN + dq * 32 + j + 6], o1[j + 7] * rs * SM[SM_SUBLN + dq * 32 + j + 7]);
                    *(u32x4*)(dst + j) = w; }
            }
        }
        {
            const int qi = lane >> 2, dq = lane & 3;
            for (int item = gw; item < MTOK / 16 * 4; item += NGW) {
                const int hm = item & 3, rb = item >> 2, row = rb * 16 + qi, b = row >> 13;
                float o[16];
                naive_stream<16>(MQ + (size_t)row * 256 + hm * 64, MK + (size_t)b * NMEM * 256 + hm * 64, 256, MVT + ((size_t)(b * 4 + hm) * 64 + dq * 16) * NMEM, NMEM, NMEM, o);
                bf16_t* dst = MIXED + (size_t)row * DM + 768 + hm * 64 + dq * 16;
                u32x4 w; w.x = pk2(o[0], o[1]); w.y = pk2(o[2], o[3]); w.z = pk2(o[4], o[5]); w.w = pk2(o[6], o[7]); *(u32x4*)dst = w;
                w.x = pk2(o[8], o[9]); w.y = pk2(o[10], o[11]); w.z = pk2(o[12], o[13]); w.w = pk2(o[14], o[15]); *(u32x4*)(dst + 8) = w;
            }
        }
#else
        {
            int lane_d = LANE_ID(); asm volatile("" : "+v"(lane_d)); const int lane = lane_d;
            const int r32 = lane & 31, hi = lane >> 5, c = wave >> 2, wq = wave & 3;
            LAS float* wsf = (LAS float*)(lds + DA_WSF) + wave * 32;
            unsigned swo[4];
            { const int sw = (r32 >> 1) & 7;
#pragma unroll
              for (int x = 0; x < 4; ++x) swo[x] = (unsigned)(r32 * 128 + (((2 * x + hi) ^ sw) << 4)); }
            const int rin = 8 * wave + (lane >> 3), lc = (lane & 7) ^ ((rin >> 1) & 7);
            const unsigned kvoff = (unsigned)((rin * 512 + lc * 8) * 2), vvoff = (unsigned)((rin * SEQ + lc * 8) * 2);
            const unsigned qoff = (unsigned)(((wq * 32 + r32) * 512 + c * 64 + hi * 8) * 2);
            const unsigned ldsb = (unsigned)(size_t)lds_raw + (unsigned)wave * 1024u;
#ifndef DA_REPS
#define DA_REPS 1
#endif
            for (int pair_ = blockIdx.x; pair_ < 256 * DA_REPS; pair_ += G)
            for (int half = 0; half < 2; ++half) {
                const int pair = pair_ & 255, bh = pair & 7, sidx = pair >> 3, qb = half ? 63 - sidx : sidx, b = bh >> 2, h = bh & 3;
                const int q0 = qb * 128, NT = 2 * qb + 2;
                const char* kbase = (const char*)(Kb + (size_t)b * SEQ * 512 + h * 128);
                const char* vbase = (const char*)(VT + (size_t)bh * 128 * SEQ);
#define DA_GLDS(voff, sbase, dst, imm) do { unsigned keep_; const char* ga_ = (sbase) + (voff); asm volatile("s_mov_b32 %0, m0\n\ts_mov_b32 m0, %2\n\ts_nop 0\n\tglobal_load_lds_dwordx4 %1, off\n\ts_mov_b32 m0, %0" \
                    : "=&s"(keep_) : "v"(ga_), "s"(dst) : "memory"); } while (0)
#define DA_DMA_K(tt, sl) do { const int tt_ = (tt) < NT ? (tt) : NT - 1; const char* kb_ = kbase + (size_t)tt_ * (64 * 512 * 2); const unsigned d_ = (unsigned)__builtin_amdgcn_readfirstlane(ldsb + (sl) * DA_KSLOT); \
                    DA_GLDS(kvoff, kb_, d_, 0); const unsigned d2_ = d_ + 8192u; const char* kb2_ = kb_ + 128; DA_GLDS(kvoff, kb2_, d2_, 0); } while (0)
#define DA_DMA_V(tt, sl) do { const int tt_ = (tt) < NT ? (tt) : NT - 1; const char* vb_ = vbase + (size_t)tt_ * 128; const char* vb2_ = vb_ + (size_t)64 * SEQ * 2; const unsigned d_ = (unsigned)__builtin_amdgcn_readfirstlane(ldsb + DA_V0 + (sl) * DA_VSLOT); \
                    DA_GLDS(vvoff, vb_, d_, 0); const unsigned d2_ = d_ + 8192u; DA_GLDS(vvoff, vb2_, d2_, 0); } while (0)
#define DA_BAR(N) asm volatile("s_waitcnt vmcnt(" #N ") lgkmcnt(0)\n\ts_barrier" ::: "memory")
#define DA_KB(t) (lds + ((t) % 3) * DA_KSLOT + c * 8192)
#define DA_VB(t) (lds + DA_V0 + ((t) % 3) * DA_VSLOT)
#define DA_SHIFTCHK(N0, N1) do { if (__any(rmn > 8.0f)) da_shift((rmn > 8.0f) ? rmn : 0.f, N0, N1, o, m, l, wsf, r32, hi); } while (0)
                DA_DMA_K(0, 0); DA_DMA_V(0, 0); DA_DMA_K(1, 1);
                bf16x8 qr[4];
                { const char* qbase = (const char*)(Qb + ((size_t)(b * SEQ + q0)) * 512 + h * 128);
                  asm volatile("global_load_dwordx4 %0, %4, %5 offset:0\n\tglobal_load_dwordx4 %1, %4, %5 offset:32\n\tglobal_load_dwordx4 %2, %4, %5 offset:64\n\tglobal_load_dwordx4 %3, %4, %5 offset:96"
                               : "=&v"(qr[0]), "=&v"(qr[1]), "=&v"(qr[2]), "=&v"(qr[3]) : "v"(qoff), "s"(qbase) : "memory"); }
                f32x16 o[4];
#pragma unroll
                for (int blk = 0; blk < 4; ++blk)
#pragma unroll
                    for (int r = 0; r < 16; ++r) o[blk][r] = 0.f;
                float m = 0.f, l = 0.f;
                DA_BAR(0);
                DA_DMA_K(2, 2); DA_DMA_V(1, 1);
                f32x16 pA0, pA1, pB0, pB1; float rmn;
                qk_tile_sw(DA_KB(0), swo, qr, pA0, pA1);
                { const float rm0 = row_max32(pA0, pA1); m = rm0;
#pragma unroll
                  for (int r = 0; r < 16; ++r) { pA0[r] -= rm0; pA1[r] -= rm0; } }
                DA_BAR(4);
                const bool masklast = (wq < 2);
                int t = 0;
                for (; t + 2 < NT; t += 2) {
                    DA_DMA_K(t + 3, t % 3); DA_DMA_V(t + 2, (t + 2) % 3);
                    da_step<true>(DA_KB(t + 1), DA_VB(t), swo, qr, pA0, pA1, pB0, pB1, -m, o, l, rmn); DA_SHIFTCHK(pB0, pB1);
                    DA_BAR(4);
                    DA_DMA_K(t + 4, (t + 1) % 3); DA_DMA_V(t + 3, (t + 3) % 3);
                    da_step<true>(DA_KB(t + 2), DA_VB(t + 1), swo, qr, pB0, pB1, pA0, pA1, -m, o, l, rmn); DA_SHIFTCHK(pA0, pA1);
                    DA_BAR(4);
                }
                DA_DMA_K(t + 3, t % 3); DA_DMA_V(t + 2, (t + 2) % 3);
                da_step<true>(DA_KB(t + 1), DA_VB(t), swo, qr, pA0, pA1, pB0, pB1, masklast ? -INFINITY : -m, o, l, rmn); DA_SHIFTCHK(pB0, pB1);
                DA_BAR(4);
                da_step<false>(DA_KB(t), DA_VB(t + 1), swo, qr, pB0, pB1, pA0, pA1, 0.f, o, l, rmn);
                DA_BAR(0);
#undef DA_GLDS
#undef DA_DMA_K
#undef DA_DMA_V
#undef DA_BAR
#undef DA_KB
#undef DA_VB
#undef DA_SHIFTCHK
                int r32f = r32, lanef = lane; asm volatile("" : "+v"(r32f), "+v"(lanef));
                { float inv = 1.0f / half_sum(l); if (c) { float lam; LAM_COMPUTE(lam); inv *= lam; }
                  asm volatile("" ::: "memory");
                  if (hi == 0) wsf[r32] = inv;
                  asm volatile("" ::: "memory");
                  float sc[16];
#pragma unroll
                  for (int r = 0; r < 16; ++r) sc[r] = wsf[crow(r, hi)];
#pragma unroll
                  for (int blk = 0; blk < 4; ++blk)
#pragma unroll
                      for (int r = 0; r < 16; ++r) o[blk][r] *= sc[r]; }
                LAS float* cb = (LAS float*)lds + wq * 4096 + lanef;
                if (c) {
#pragma unroll
                    for (int blk = 0; blk < 4; ++blk)
#pragma unroll
                        for (int r = 0; r < 16; ++r) cb[(blk * 16 + r) * 64] = o[blk][r];
                }
                __syncthreads();
                if (!c) {
                    float ss[16];
#pragma unroll
                    for (int r = 0; r < 16; ++r) ss[r] = 0.f;
#pragma unroll
                    for (int blk = 0; blk < 4; ++blk)
#pragma unroll
                        for (int r = 0; r < 16; ++r) { o[blk][r] -= cb[(blk * 16 + r) * 64]; ss[r] += o[blk][r] * o[blk][r]; }
#pragma unroll
                    for (int r = 0; r < 16; ++r) {
                        ss[r] += sxor<1>(ss[r]); ss[r] += sxor<2>(ss[r]); ss[r] += sxor<4>(ss[r]); ss[r] += sxor<8>(ss[r]); ss[r] += sxor<16>(ss[r]);
                        ss[r] = 0.8f / sqrtf(ss[r] * (1.0f / 128) + EPS); }
                    unsigned voffm = (unsigned)((4 * hi * DM + r32f) * 2); asm volatile("" : "+v"(voffm));
                    const char* mbase = (const char*)(MIXED + ((size_t)(b * SEQ + q0 + wq * 32)) * DM + h * 128);
#pragma unroll
                    for (int blk = 0; blk < 4; ++blk) { const float gsub = SM[SM_SUBLN + blk * 32 + r32f];
#pragma unroll
                        for (int r = 0; r < 16; ++r) *(bf16_t*)(mbase + (size_t)(((r & 3) + 8 * (r >> 2)) * DM + blk * 32) * 2 + voffm) = (bf16_t)f2bf(o[blk][r] * ss[r] * gsub); }
                }
                __syncthreads();
            }
        }
        {
            int tidm = wave * 64 + LANE_ID(); asm volatile("" : "+v"(tidm));
            const int tid = tidm, lane = tid & 63, r32 = lane & 31, hi = lane >> 5;
            LAS float* wsf = (LAS float*)(lds + DA_WSF) + wave * 32;
#ifndef MEM_REPS
#define MEM_REPS 1
#endif
            for (int u_ = blockIdx.x; u_ < 256 * MEM_REPS; u_ += G) {
                const int u = u_ & 255, hm = u & 3, b = (u >> 2) & 1, qb = u >> 3;
#pragma unroll
                for (int i = 0; i < 4; ++i) { const int idx = tid + 512 * i;
                    { const int row = idx >> 3, ch = idx & 7; *(LAS u32x4*)(lds + row * KST + ch * 16) = *(const u32x4*)(MK + ((size_t)(b * NMEM + row)) * 256 + hm * 64 + ch * 8); }
                    { const int d = idx >> 5, ch = idx & 31; *(LAS u32x4*)(lds + MA_VT + d * MA_VST + ch * 16) = *(const u32x4*)(MVT + ((size_t)((b * 4 + hm) * 64 + d)) * NMEM + ch * 8); } }
                const int row0 = b * SEQ + qb * 256 + wave * 32;
                bf16x8 qr[4];
                { const bf16_t* qp = MQ + ((size_t)(row0 + r32)) * 256 + hm * 64 + hi * 8;
#pragma unroll
                  for (int ds = 0; ds < 4; ++ds) qr[ds] = *(const bf16x8*)(qp + ds * 16); }
                f32x16 o[2];
#pragma unroll
                for (int blk = 0; blk < 2; ++blk)
#pragma unroll
                    for (int r = 0; r < 16; ++r) o[blk][r] = 0.f;
                float m = -INFINITY, l = 0.f;
                __syncthreads();
                for (int t = 0; t < 4; ++t) attn_tile<2>(lds + t * 64 * KST, KST, lds + MA_VT + t * 128, MA_VST, qr, o, m, l, wsf, r32, hi);
                { const float inv = 1.0f / half_sum(l);
                  asm volatile("" ::: "memory");
                  if (hi == 0) wsf[r32] = inv;
                  asm volatile("" ::: "memory");
                  unsigned voffm = (unsigned)((4 * hi * DM + r32) * 2); asm volatile("" : "+v"(voffm));
                  const char* mbase = (const char*)(MIXED + (size_t)row0 * DM + 768 + hm * 64);
#pragma unroll
                  for (int r = 0; r < 16; ++r) { const float sc = wsf[crow(r, hi)]; const char* rb = mbase + (size_t)(((r & 3) + 8 * (r >> 2)) * DM) * 2;
                      *(bf16_t*)(rb + voffm) = (bf16_t)f2bf(o[0][r] * sc); *(bf16_t*)(rb + 64 + voffm) = (bf16_t)f2bf(o[1][r] * sc); } }
                __syncthreads();
            }
        }
#endif
        {
            int tidc = wave * 64 + LANE_ID(); asm volatile("" : "+v"(tidc));
            const int tid = tidc, lane = tid & 63;
            bf16_t* Gs = (bf16_t*)lds_raw;
            float* Y = (float*)(lds_raw + 49152);
            const float* dw_w = SM + SM_DWW; const float* dw_b = SM + SM_DWB; const float* ln_g = SM + SM_LNG; const float* ln_b = SM + SM_LNB;
            #ifndef CONV_REPS
#define CONV_REPS 1
#endif
            for (int unit_ = blockIdx.x; unit_ < MTOK / 64 * CONV_REPS; unit_ += G) {
                const int unit = unit_ & (MTOK / 64 - 1), t0 = unit * 64, bstart = t0 & ~(SEQ - 1);
                __syncthreads();
                for (int c = tid; c < 94 * 32; c += 512) { const int r = c >> 5, cc = c & 31, t = t0 - 30 + r;
                    u32x4 v = {0u, 0u, 0u, 0u}; if (t >= bstart) v = *(const u32x4*)(Gb + (size_t)t * 256 + cc * 8);
                    *(u32x4*)(Gs + r * 256 + cc * 8) = v; }
                __syncthreads();
                { const int cp = tid & 127, tq = tid >> 7; float w0[31], w1[31];
#pragma unroll
                    for (int j = 0; j < 31; ++j) { w0[j] = dw_w[j * 256 + 2 * cp]; w1[j] = dw_w[j * 256 + 2 * cp + 1]; }
                    const float bias0 = dw_b[2 * cp], bias1 = dw_b[2 * cp + 1];
                    const unsigned* Gs32 = (const unsigned*)Gs;
                    for (int tt = 0; tt < 16; ++tt) { const int t = tq * 16 + tt; float a0 = bias0, a1 = bias1;
#pragma unroll
                        for (int j = 0; j < 31; ++j) { const unsigned g2 = Gs32[(t + j) * 128 + cp];
                            a0 += __builtin_bit_cast(float, g2 << 16) * w0[j]; a1 += __builtin_bit_cast(float, g2 & 0xffff0000u) * w1[j]; }
                        *(f32x2_t*)(Y + t * 256 + 2 * cp) = (f32x2_t){a0, a1}; } }
                __syncthreads();
                { f32x4 v[8]; float sm[8], sq[8];
#pragma unroll
                  for (int tt = 0; tt < 8; ++tt) { v[tt] = *(const f32x4*)(Y + (wave * 8 + tt) * 256 + lane * 4); sm[tt] = (v[tt].x + v[tt].y) + (v[tt].z + v[tt].w); }
#define RED8(a) do { _Pragma("unroll") for (int tt = 0; tt < 8; ++tt) a[tt] += sxor<1>(a[tt]); _Pragma("unroll") for (int tt = 0; tt < 8; ++tt) a[tt] += sxor<2>(a[tt]); \
                     _Pragma("unroll") for (int tt = 0; tt < 8; ++tt) a[tt] += sxor<4>(a[tt]); _Pragma("unroll") for (int tt = 0; tt < 8; ++tt) a[tt] += sxor<8>(a[tt]); \
                     _Pragma("unroll") for (int tt = 0; tt < 8; ++tt) a[tt] += sxor<16>(a[tt]); _Pragma("unroll") for (int tt = 0; tt < 8; ++tt) a[tt] = hsum32(a[tt]); } while (0)
                  RED8(sm);
#pragma unroll
                  for (int tt = 0; tt < 8; ++tt) { v[tt] = v[tt] - sm[tt] * (1.0f / 256); sq[tt] = (v[tt].x * v[tt].x + v[tt].y * v[tt].y) + (v[tt].z * v[tt].z + v[tt].w * v[tt].w); }
                  RED8(sq);
#undef RED8
                  const f32x4 gg = *(const f32x4*)(ln_g + lane * 4), bb = *(const f32x4*)(ln_b + lane * 4);
#pragma unroll
                  for (int tt = 0; tt < 8; ++tt) { const float rstd = 1.0f / sqrtf(sq[tt] * (1.0f / 256) + EPS);
                      const f32x4 y = v[tt] * rstd * gg + bb;
                      u32x2 wv; wv.x = pk2(silu_f(y.x), silu_f(y.y)); wv.y = pk2(silu_f(y.z), silu_f(y.w));
                      *(u32x2*)(MIXED + (size_t)(t0 + wave * 8 + tt) * DM + 512 + lane * 4) = wv; } }
            }
            __syncthreads();
        }
    }
#endif
    GRID_BAR();
#ifndef NO_P5
    { pg8::Gemm g{MIXED, W_OUT, MTOK, DM, DM}; pg8::StaticOrder S; S.init(MTOK, DM, G, (int)blockIdx.x);
      EpiExch<false> E{nullptr, AB, RN1, 1.0f, nullptr, nullptr, AB, RN2, (float*)(ws + WS_XBUF) + (size_t)MTOK * 4, (unsigned*)(ws + WS_CTL + CTL_CNT) + CTL_BANK};
      pg8::gemm_phase<EpiExch<false>, pg8::StaticOrder, false, true>(lds, g, S, E, wave); }
#endif
    GRID_BAR();
#ifndef NO_P6
    { pg8::Gemm g{AB, W_GU2, MTOK, 2 * DFF, DM}; pg8::StaticOrder S; S.init(MTOK, 2 * DFF, G, (int)blockIdx.x); EpiSwiGLU E{ACT, nullptr};
      pg8::gemm_phase<EpiSwiGLU, pg8::StaticOrder, true, true>(lds, g, S, E, wave);
#ifdef P6_TWICE
      pg8::gemm_phase<EpiSwiGLU, pg8::StaticOrder, true, true>(lds, g, S, E, wave);
#endif
    }
#endif
    GRID_BAR();
#ifndef NO_P7
    { pg8::Gemm g{ACT, W_D2, MTOK, DM, DFF}; pg8::StaticOrder S; S.init(MTOK, DM, G, (int)blockIdx.x);
      EpiExch<false> E{nullptr, AB, RN2, 0.5f, H, (const float*)(ws + WS_SMALL) + SM_FNG, nullptr, nullptr, (float*)(ws + WS_XBUF) + (size_t)MTOK * 8, (unsigned*)(ws + WS_CTL + CTL_CNT) + 2 * CTL_BANK};
      pg8::gemm_phase<EpiExch<false>, pg8::StaticOrder, false, true>(lds, g, S, E, wave); }
#endif
#if defined(CG_SYNC_AT_END)
    grid.sync();
#endif
}

extern "C" void kernel_launch(void* const* d_in, const int* in_sizes, int n_in, void* d_out, int out_size, void* d_ws, size_t ws_size, hipStream_t stream) {
    static int grid_blocks = 0;
    if (grid_blocks == 0) {
        if (n_in != 25 || ws_size < WS_END) { fprintf(stderr, "kernel_launch: unexpected inputs (n_in %d, ws %zu)\n", n_in, ws_size); grid_blocks = -1; return; }
        int dev = 0, cus = 0, per_cu = 0;
        hipGetDevice(&dev); hipDeviceGetAttribute(&cus, hipDeviceAttributeMultiprocessorCount, dev);
        if (hipFuncSetAttribute((const void*)fwd_megakernel, hipFuncAttributeMaxDynamicSharedMemorySize, LDS_BYTES) != hipSuccess) fprintf(stderr, "kernel_launch: hipFuncSetAttribute failed\n");
        if (hipOccupancyMaxActiveBlocksPerMultiprocessor(&per_cu, (const void*)fwd_megakernel, 512, LDS_BYTES) != hipSuccess || per_cu < 1) { fprintf(stderr, "kernel_launch: occupancy query failed (%d)\n", per_cu); per_cu = 1; }
        (void)hipGetLastError();
        grid_blocks = cus * 1;
        if (grid_blocks != 256) { fprintf(stderr, "kernel_launch: built for a 256-CU device (one 256x256 unit per workgroup in the fused final phase), found %d CUs; nothing launched\n", cus); grid_blocks = -1; return; }
        fprintf(stderr, "kernel_launch: cus %d per_cu %d grid %d\n", cus, per_cu, grid_blocks);
    }
    if (grid_blocks < 0) return;
    if (hipMemsetAsync((char*)d_ws + WS_CTL, 0, CTL_BYTES, stream) != hipSuccess) { fprintf(stderr, "kernel_launch: memset failed\n"); return; }
    Params p{};
    for (int i = 0; i < 25; ++i) p.in[i] = (const float*)d_in[i];
    p.out = (float*)d_out; p.ws = (unsigned char*)d_ws;
    void* args[] = {&p};
    hipError_t e = hipLaunchCooperativeKernel((const void*)fwd_megakernel, dim3(grid_blocks), dim3(512), args, LDS_BYTES, stream);
    if (e != hipSuccess) fprintf(stderr, "cooperative launch failed: %s (grid %d)\n", hipGetErrorString(e), grid_blocks);
}
```

```cpp
#include <hip/hip_runtime.h>
#include <hip/hip_cooperative_groups.h>
#include <cstdio>
#include <cstdint>
namespace cg = cooperative_groups;
namespace pg8 {
#define PG8_LAS __attribute__((address_space(3)))
typedef unsigned short bf16_t;
typedef short bf16x8 __attribute__((ext_vector_type(8)));
typedef float f32x4 __attribute__((ext_vector_type(4)));
typedef unsigned u32x4 __attribute__((ext_vector_type(4)));
constexpr int BM = 256, BK = 64, HALF = 128, HTB = HALF * BK * 2  , STAGE_BYTES = 8 * HTB, NXCD = 8, WGM = 8;

__host__ __device__ __forceinline__ int lds_byte(int r, int c) { const int st = (r >> 4) * 2 + (c >> 5), rr = r & 15, cc = c & 31, ob = rr * 64 + cc * 2; return st * 1024 + (ob ^ (((ob >> 9) & 1) << 5)); }
__host__ __device__ __forceinline__ void stage_rc(int b, int& R, int& C) { const int st = b / 1024, sb = b % 1024, swz = sb ^ (((sb >> 9) & 1) << 5); R = (st >> 1) * 16 + swz / 64; C = (st & 1) * 32 + (swz % 64) / 2; }
__host__ __device__ __forceinline__ int perm32(int rho) { const int n = rho >> 4, i = rho & 15; return 8 * (i >> 2) + 4 * n + (i & 3); }

struct Unit { int pm, pn; };
struct Gemm { const bf16_t* A; const bf16_t* Bt; int M, N, K; };

struct StaticOrder {
    int nM, nN, nwg, G, c;
    __host__ __device__ void init(int M, int N, int G_, int c_) { nM = M / BM; nN = N / BM; nwg = nM * nN; G = G_; c = c_; }
    __host__ __device__ bool next(int i, Unit& u) const {
        const long L = (long)i * G + c; if (L >= nwg) return false;
        int wgid = (int)L; { const int q = nwg / NXCD, r = nwg % NXCD, xcd = wgid % NXCD, off = wgid / NXCD; wgid = (xcd < r ? xcd * (q + 1) : r * (q + 1) + (xcd - r) * q) + off; }
        const int nig = WGM * nN, gid = wgid / nig, fm = gid * WGM, gsz = (nM - fm) < WGM ? (nM - fm) : WGM;
        u.pm = fm + ((wgid % nig) % gsz); u.pn = (wgid % nig) / gsz; return true;
    }
    __device__ __forceinline__ void a_ready(const Unit&) const {}
    __device__ __forceinline__ void done(const Unit&) const {}
};

__device__ __forceinline__ unsigned cvt_pk_bf16(float lo, float hi) { unsigned r; asm volatile("v_cvt_pk_bf16_f32 %0, %1, %2" : "=v"(r) : "v"(lo), "v"(hi)); return r; }
typedef float f32x2 __attribute__((ext_vector_type(2)));
template <class Epi, class Sched, bool ALIGN_EPI = false, bool SP2 = false>
__device__ __forceinline__ void gemm_phase(PG8_LAS unsigned char* lds, const Gemm g, const Sched& S, const Epi& E, int wave_id) {
    int tid_; asm volatile("v_mbcnt_lo_u32_b32 %0, -1, 0\n\tv_mbcnt_hi_u32_b32 %0, -1, %0" : "=v"(tid_)); tid_ += wave_id * 64;
    const int tid = tid_, wid = __builtin_amdgcn_readfirstlane(tid >> 6), lane = tid & 63, wr = wid >> 2, wc = wid & 3, fr = lane & 15, fq = lane >> 4;
    const int K = g.K, nt = K / BK;
    unsigned voffA[2], voffB[2];
#pragma unroll
    for (int i = 0; i < 2; ++i) { int R, C; stage_rc(tid * 16 + i * 8192, R, C); const int Rb = Epi::PERM ? ((R & ~31) + perm32(R & 31)) : R;
        voffA[i] = (unsigned)(R * K + C) * 2u; voffB[i] = (unsigned)(Rb * K + C) * 2u; }
    const size_t kstep = (size_t)(BK * 2);
    const size_t hstep = (size_t)HALF * K * 2;
    const size_t tstep = 2 * hstep;
    const unsigned ldsw = (unsigned)wid * 1024u;
    const int aoff = lds_byte(wr * 64 + fr, fq * 8), boff = lds_byte(wc * 32 + fr, fq * 8);
#define PG8_SA(b, h) (((b) * 2 + (h)) * HTB)
#define PG8_SB(b, h) ((4 + (b) * 2 + (h)) * HTB)
#define PG8_STAGE(bufoff, gbase, voff) do { _Pragma("unroll") for (int _i = 0; _i < 2; ++_i) \
        __builtin_amdgcn_global_load_lds((const unsigned*)((const char*)(gbase) + (voff)[_i]), (PG8_LAS unsigned*)(lds + (bufoff) + ldsw + _i * 8192), 16, 0, 0); } while (0)
#define PG8_LDA(dst, b, h) do { _Pragma("unroll") for (int m = 0; m < 4; ++m) _Pragma("unroll") for (int k = 0; k < 2; ++k) dst[m][k] = *(const PG8_LAS bf16x8*)(lds + PG8_SA(b, h) + aoff + m * 2048 + k * 1024); } while (0)
#define PG8_LDB(dst, b, h) do { _Pragma("unroll") for (int n = 0; n < 2; ++n) _Pragma("unroll") for (int k = 0; k < 2; ++k) dst[n][k] = *(const PG8_LAS bf16x8*)(lds + PG8_SB(b, h) + boff + n * 2048 + k * 1024); } while (0)
#define PG8_MMA(ai, bj, At, Bt) do { __builtin_amdgcn_s_setprio(1); _Pragma("unroll") for (int m = 0; m < 4; ++m) _Pragma("unroll") for (int n = 0; n < 2; ++n) _Pragma("unroll") for (int k = 0; k < 2; ++k) \
        acc[ai][bj][m][n] = __builtin_amdgcn_mfma_f32_16x16x32_bf16(Bt[n][k], At[m][k], acc[ai][bj][m][n], 0, 0, 0); __builtin_amdgcn_s_setprio(0); } while (0)
#define PG8_WAIT_V(n) asm volatile("s_waitcnt vmcnt(" #n ")" ::: "memory")
#define PG8_WAIT_L(n) asm volatile("s_waitcnt lgkmcnt(" #n ")" ::: "memory")
#define PG8_BAR __builtin_amdgcn_s_barrier()
#define PG8_SCHED __builtin_amdgcn_sched_barrier(0)
    Unit cur, nxt; int ui = 0;
    if (!S.next(0, cur)) return;
    f32x4 acc[2][2][4][2];
#pragma unroll
    for (int a = 0; a < 2; ++a)
#pragma unroll
        for (int b = 0; b < 2; ++b)
#pragma unroll
            for (int m = 0; m < 4; ++m)
#pragma unroll
                for (int n = 0; n < 2; ++n) acc[a][b][m][n] = (f32x4){0.f, 0.f, 0.f, 0.f};
    bf16x8 At[4][2], B0[2][2], B1[2][2];
    const char* cA = (const char*)g.A + (size_t)cur.pm * tstep; const char* cB = (const char*)g.Bt + (size_t)cur.pn * tstep;
    S.a_ready(cur);
    if constexpr (SP2) {
        PG8_STAGE(PG8_SB(0, 0), cB, voffB); PG8_STAGE(PG8_SB(0, 1), cB + hstep, voffB); PG8_STAGE(PG8_SA(0, 0), cA, voffA); PG8_STAGE(PG8_SA(0, 1), cA + hstep, voffA);
        if (wr == 1) PG8_BAR;
        PG8_WAIT_V(2); PG8_BAR;
        PG8_STAGE(PG8_SB(1, 0), cB + kstep, voffB); PG8_STAGE(PG8_SA(1, 0), cA + kstep, voffA); PG8_STAGE(PG8_SB(1, 1), cB + hstep + kstep, voffB);
        PG8_WAIT_V(6); PG8_BAR;
    } else {
        PG8_STAGE(PG8_SB(0, 0), cB, voffB); PG8_STAGE(PG8_SA(0, 0), cA, voffA); PG8_STAGE(PG8_SB(0, 1), cB + hstep, voffB); PG8_STAGE(PG8_SA(0, 1), cA + hstep, voffA);
        if (wr == 1) PG8_BAR;
        PG8_WAIT_V(4); PG8_BAR;
        PG8_STAGE(PG8_SB(1, 0), cB + kstep, voffB); PG8_STAGE(PG8_SA(1, 0), cA + kstep, voffA); PG8_STAGE(PG8_SB(1, 1), cB + hstep + kstep, voffB);
        PG8_WAIT_V(6); PG8_BAR;
    }
    for (;;) {
        const bool has_next = S.next(ui + 1, nxt);
        const char* nA = has_next ? (const char*)g.A + (size_t)nxt.pm * tstep : cA; const char* nB = has_next ? (const char*)g.Bt + (size_t)nxt.pn * tstep : cB;
        for (int t = 0; t < nt; t += 2) {
            const bool last = (t == nt - 2);
            const char* a1 = cA + (size_t)(t + 1) * kstep;
            const char* a2 = last ? nA : cA + (size_t)(t + 2) * kstep; const char* b2 = last ? nB : cB + (size_t)(t + 2) * kstep;
            const char* a3 = a2 + kstep; const char* b3 = b2 + kstep;
            if (last && has_next) S.a_ready(nxt);
            if constexpr (SP2) {
            PG8_LDB(B0, 0, 0); PG8_LDB(B1, 0, 1); PG8_SCHED; PG8_LDA(At, 0, 0); PG8_STAGE(PG8_SA(1, 1), a1 + hstep, voffA);
            PG8_WAIT_V(8); PG8_WAIT_L(0); PG8_BAR; PG8_MMA(0, 0, At, B0); PG8_MMA(0, 1, At, B1); PG8_BAR; PG8_SCHED;
            PG8_LDA(At, 0, 1); PG8_STAGE(PG8_SB(0, 0), b2, voffB); PG8_STAGE(PG8_SB(0, 1), b2 + hstep, voffB); PG8_STAGE(PG8_SA(0, 0), a2, voffA);
            PG8_WAIT_V(8); PG8_WAIT_L(0); PG8_BAR; PG8_MMA(1, 0, At, B0); PG8_MMA(1, 1, At, B1); PG8_BAR; PG8_SCHED;
            PG8_LDB(B0, 1, 0); PG8_LDB(B1, 1, 1); PG8_SCHED; PG8_LDA(At, 1, 0); PG8_STAGE(PG8_SA(0, 1), a2 + hstep, voffA);
            PG8_WAIT_V(8); PG8_WAIT_L(0); PG8_BAR; PG8_MMA(0, 0, At, B0); PG8_MMA(0, 1, At, B1); PG8_BAR; PG8_SCHED;
            PG8_LDA(At, 1, 1); PG8_STAGE(PG8_SB(1, 0), b3, voffB); PG8_STAGE(PG8_SB(1, 1), b3 + hstep, voffB); PG8_STAGE(PG8_SA(1, 0), a3, voffA);
            PG8_WAIT_V(8); PG8_WAIT_L(0); PG8_BAR; PG8_MMA(1, 0, At, B0); PG8_MMA(1, 1, At, B1); PG8_BAR; PG8_SCHED;
            } else {
            PG8_LDB(B0, 0, 0); PG8_SCHED; PG8_LDA(At, 0, 0); PG8_STAGE(PG8_SA(1, 1), a1 + hstep, voffA);
            PG8_WAIT_L(8); PG8_BAR; PG8_WAIT_L(0); PG8_MMA(0, 0, At, B0); PG8_BAR; PG8_SCHED;
            PG8_LDB(B1, 0, 1); PG8_STAGE(PG8_SB(0, 0), b2, voffB);
            PG8_BAR; PG8_WAIT_L(0); PG8_MMA(0, 1, At, B1); PG8_BAR;
            PG8_LDA(At, 0, 1); PG8_STAGE(PG8_SA(0, 0), a2, voffA);
            PG8_BAR; PG8_WAIT_L(0); PG8_MMA(1, 0, At, B0); PG8_BAR; PG8_SCHED;
            PG8_STAGE(PG8_SB(0, 1), b2 + hstep, voffB);
            PG8_WAIT_V(6); PG8_BAR; PG8_MMA(1, 1, At, B1); PG8_BAR;
            PG8_LDB(B0, 1, 0); PG8_SCHED; PG8_LDA(At, 1, 0); PG8_STAGE(PG8_SA(0, 1), a2 + hstep, voffA);
            PG8_WAIT_L(8); PG8_BAR; PG8_WAIT_L(0); PG8_MMA(0, 0, At, B0); PG8_BAR; PG8_SCHED;
            PG8_LDB(B1, 1, 1); PG8_STAGE(PG8_SB(1, 0), b3, voffB);
            PG8_BAR; PG8_WAIT_L(0); PG8_MMA(0, 1, At, B1); PG8_BAR;
            PG8_LDA(At, 1, 1); PG8_STAGE(PG8_SA(1, 0), a3, voffA);
            PG8_BAR; PG8_WAIT_L(0); PG8_MMA(1, 0, At, B0); PG8_BAR; PG8_SCHED;
            PG8_STAGE(PG8_SB(1, 1), b3 + hstep, voffB);
            PG8_WAIT_V(6); PG8_BAR; PG8_MMA(1, 1, At, B1); PG8_BAR;
            }
        }
        if constexpr (ALIGN_EPI) { if (wr == 0) PG8_BAR; }
        if constexpr (!Epi::AFTER_DRAIN) { E(acc, cur, wr, wc, fr, fq); S.done(cur); }
        if (!has_next) break;
#pragma unroll
        for (int a = 0; a < 2; ++a)
#pragma unroll
            for (int b = 0; b < 2; ++b)
#pragma unroll
                for (int m = 0; m < 4; ++m)
#pragma unroll
                    for (int n = 0; n < 2; ++n) acc[a][b][m][n] = (f32x4){0.f, 0.f, 0.f, 0.f};
        cur = nxt; cA = nA; cB = nB; ++ui;
        if constexpr (ALIGN_EPI) { if (wr == 1) PG8_BAR; }
    }
    PG8_WAIT_V(0);
    if constexpr (!ALIGN_EPI) { if (wr == 0) PG8_BAR; }
    PG8_BAR;
    if constexpr (Epi::AFTER_DRAIN) { E.fused(acc, cur, wr, wc, fr, fq, lds, wid, lane); S.done(cur); }
#undef PG8_SA
#undef PG8_SB
#undef PG8_STAGE
#undef PG8_LDA
#undef PG8_LDB
#undef PG8_MMA
#undef PG8_WAIT_V
#undef PG8_WAIT_L
#undef PG8_BAR
#undef PG8_SCHED
}
}

#define LAS __attribute__((address_space(3)))
__device__ __forceinline__ int lane_id_v() { int l; asm volatile("v_mbcnt_lo_u32_b32 %0, -1, 0\n\tv_mbcnt_hi_u32_b32 %0, -1, %0" : "=v"(l)); return l; }
#define LANE_ID() lane_id_v()
template <int M> __device__ __forceinline__ float sxor(float v) { return __builtin_bit_cast(float, __builtin_amdgcn_ds_swizzle(__builtin_bit_cast(int, v), (M << 10) | 0x1f)); }
__device__ __forceinline__ void swap32(float& a, float& b) { asm volatile("s_nop 1\n\tv_permlane32_swap_b32 %0, %1\n\ts_nop 3" : "+v"(a), "+v"(b)); }
__device__ __forceinline__ float hsum32(float v) { float a = v, b = v; swap32(a, b); return a + b; }
typedef unsigned short bf16_t;
typedef pg8::f32x4 f32x4;
typedef pg8::u32x4 u32x4;
typedef unsigned u32x2 __attribute__((ext_vector_type(2)));
constexpr int SEQ = 8192, NB = 2, MTOK = NB * SEQ, DM = 1024, DFF = 2816, NMEM = 256, INW = 2304;
constexpr float EPS = 1e-5f;
constexpr float QSCALE = 0.125f * 1.4426950408889634f;
constexpr size_t MiB = 1u << 20;
constexpr size_t WS_WGU1 = 0, WS_WD1 = 11 * MiB, WS_WIN = 16 * MiB + MiB / 2, WS_WMKV = 21 * MiB, WS_WOUT = 22 * MiB, WS_WGU2 = 24 * MiB, WS_WD2 = 35 * MiB;
constexpr size_t WS_ROPE = 41 * MiB, WS_SSQ = 43 * MiB, WS_MEMN = 44 * MiB, WS_MK = 45 * MiB, WS_MVT = 45 * MiB + MiB / 4;
constexpr size_t WS_SMALL = 45 * MiB + MiB / 2;
constexpr int SM_LAM = 0, SM_SUBLN = 256, SM_DWW = 384, SM_DWB = SM_DWW + 31 * 256, SM_LNG = SM_DWB + 256, SM_LNB = SM_LNG + 256, SM_FNG = SM_LNB + 256, SM_END = SM_FNG + 1024;
constexpr size_t WS_CTL = 45 * MiB + 3 * MiB / 4, CTL_BYTES = 65536, CTL_CNT = 16384, CTL_BANK = 4096;
constexpr size_t WS_AB = 46 * MiB, WS_ACT = 78 * MiB, WS_MIXED = 166 * MiB, WS_XBUF = 198 * MiB  , WS_END = 199 * MiB;
constexpr size_t WS_Q = WS_ACT, WS_K = WS_ACT + 16 * MiB, WS_VT = WS_ACT + 32 * MiB, WS_G = WS_ACT + 48 * MiB, WS_MQ = WS_ACT + 56 * MiB;
constexpr int LDS_BYTES = 131072 + 1024;

#ifndef DEFER_W
#define DEFER_W 1
#endif
struct Params { const float* in[25]; float* out; unsigned char* ws; };

__device__ __forceinline__ unsigned f2bf(float f) { unsigned u = __builtin_bit_cast(unsigned, f); return (u + 0x7fffu + ((u >> 16) & 1u)) >> 16; }
__device__ __forceinline__ float bf2f(unsigned short h) { return __builtin_bit_cast(float, (unsigned)h << 16); }
__device__ __forceinline__ unsigned pk2(float lo, float hi) { return pg8::cvt_pk_bf16(lo, hi); }
__device__ __forceinline__ int perm16(int k) { return (k & 3) | (((k >> 3) & 1) << 2) | (((k >> 2) & 1) << 3); }
__device__ __forceinline__ float wave_sum(float v) {
    v += sxor<1>(v); v += sxor<2>(v); v += sxor<4>(v); v += sxor<8>(v); v += sxor<16>(v); v = hsum32(v);
    return v;
}
__device__ __forceinline__ float row_rstd(const float* ssq, int row) {
    const f32x4* p = (const f32x4*)(ssq + (size_t)row * 16);
    const f32x4 a = p[0], b = p[1], c = p[2], d = p[3];
    const float s = ((a.x + a.y) + (a.z + a.w)) + ((b.x + b.y) + (b.z + b.w)) + ((c.x + c.y) + (c.z + c.w)) + ((d.x + d.y) + (d.z + d.w));
    return 1.0f / sqrtf(s * (1.0f / DM) + EPS);
}
__device__ __forceinline__ float row_rstd_q(const float* ssq, int row, int fq) {
    const f32x4 a = ((const f32x4*)(ssq + (size_t)row * 16))[fq];
    float s = (a.x + a.y) + (a.z + a.w);
    s += sxor<16>(s); s = hsum32(s);
    return __builtin_amdgcn_rsqf(s * (1.0f / DM) + EPS);
}
__device__ __forceinline__ float silu_f(float g) { return g * __builtin_amdgcn_rcpf(1.0f + __expf(-g)); }

__device__ __forceinline__ void rows_rstd8(const float* ssq, int row0, int fq, float (&rs)[8]) {
    f32x4 pv[8];
#pragma unroll
    for (int i = 0; i < 8; ++i) pv[i] = ((const f32x4*)(ssq + (size_t)(row0 + (i >> 2) * 128 + (i & 3) * 16) * 16))[fq];
#pragma unroll
    for (int i = 0; i < 8; ++i) { float t = (pv[i].x + pv[i].y) + (pv[i].z + pv[i].w); t += sxor<16>(t); t = hsum32(t); rs[i] = __builtin_amdgcn_rsqf(t * (1.0f / DM) + EPS); }
}

#ifndef EPI_FENCE
#define EPI_FENCE(m) ((m) == 3)
#endif
struct EpiSwiGLU {
    static constexpr bool PERM = true, AFTER_DRAIN = false;
    bf16_t* O; const float* ssq;
    __device__ __forceinline__ void operator()(const f32x4 (&acc)[2][2][4][2], const pg8::Unit& u, int wr, int wc, int fr, int fq) const {
        asm volatile("" : "+v"(fr), "+v"(fq));
        const int row0 = u.pm * 256 + wr * 64 + fr, col0 = u.pn * 128 + wc * 32 + fq * 8;
        float rs8[8];
        if (ssq) rows_rstd8(ssq, row0, fq, rs8); else {
#pragma unroll
            for (int i = 0; i < 8; ++i) rs8[i] = 1.0f; }
#pragma unroll
        for (int ai = 0; ai < 2; ++ai)
#pragma unroll
            for (int m = 0; m < 4; ++m) {
                const int row = row0 + ai * 128 + m * 16;
                const float rs = rs8[ai * 4 + m];
                float v[8];
#pragma unroll
                for (int n = 0; n < 2; ++n)
#pragma unroll
                    for (int i = 0; i < 4; ++i) v[n * 4 + i] = silu_f(acc[ai][0][m][n][i] * rs) * (acc[ai][1][m][n][i] * rs);
                u32x4 w; w.x = pk2(v[0], v[1]); w.y = pk2(v[2], v[3]); w.z = pk2(v[4], v[5]); w.w = pk2(v[6], v[7]);
                *(u32x4*)(O + (size_t)row * DFF + col0) = w;
                if (EPI_FENCE(m)) asm volatile("" ::: "memory");
            }
    }
};
struct EpiResid {
    static constexpr bool PERM = true, AFTER_DRAIN = false;
    const float* basef; const bf16_t* baseb; float* H; bf16_t* HB; float* ssq; float alpha;
    __device__ __forceinline__ void row_part(const f32x4& a0, const f32x4& a1, const f32x4& b0, const f32x4& b1, size_t off, float& ss) const {
        const f32x4 h0 = b0 + a0 * alpha, h1 = b1 + a1 * alpha;
        if (H) { *(f32x4*)(H + off) = h0; *(f32x4*)(H + off + 4) = h1; }
        if (HB) { u32x4 w; w.x = pk2(h0.x, h0.y); w.y = pk2(h0.z, h0.w); w.z = pk2(h1.x, h1.y); w.w = pk2(h1.z, h1.w); *(u32x4*)(HB + off) = w; }
        ss += (h0.x * h0.x + h0.y * h0.y) + (h0.z * h0.z + h0.w * h0.w) + (h1.x * h1.x + h1.y * h1.y) + (h1.z * h1.z + h1.w * h1.w);
    }
    __device__ __forceinline__ void row_end(float ss, int row, int pn, int wc, int fq) const {
        if (ssq) { ss += sxor<16>(ss); ss = hsum32(ss); if (fq == 0) ssq[(size_t)row * 16 + pn * 4 + wc] = ss; }
    }
    __device__ __forceinline__ void operator()(const f32x4 (&acc)[2][2][4][2], const pg8::Unit& u, int wr, int wc, int fr, int fq) const {
        asm volatile("" : "+v"(fr), "+v"(fq));
        const int row0 = u.pm * 256 + wr * 64 + fr, col0 = u.pn * 256 + wc * 32 + fq * 8;
        if (basef) {
#pragma unroll
            for (int g = 0; g < 4; ++g) {
                f32x4 pre[2][2][2];
#pragma unroll
                for (int k = 0; k < 2; ++k)
#pragma unroll
                    for (int bj = 0; bj < 2; ++bj) { const size_t off = (size_t)(row0 + (g >> 1) * 128 + ((g & 1) * 2 + k) * 16) * DM + col0 + bj * 128;
                        pre[k][bj][0] = *(const f32x4*)(basef + off); pre[k][bj][1] = *(const f32x4*)(basef + off + 4); }
#pragma unroll
                for (int k = 0; k < 2; ++k) { const int ai = g >> 1, m = (g & 1) * 2 + k, row = row0 + ai * 128 + m * 16; float ss = 0.f;
#pragma unroll
                    for (int bj = 0; bj < 2; ++bj) row_part(acc[ai][bj][m][0], acc[ai][bj][m][1], pre[k][bj][0], pre[k][bj][1], (size_t)row * DM + col0 + bj * 128, ss);
                    row_end(ss, row, u.pn, wc, fq); }
                asm volatile("" ::: "memory");
            }
        } else {
#pragma unroll
            for (int ai = 0; ai < 2; ++ai) {
                u32x4 pre[4][2];
#pragma unroll
                for (int m = 0; m < 4; ++m)
#pragma unroll
                    for (int bj = 0; bj < 2; ++bj) pre[m][bj] = *(const u32x4*)(baseb + (size_t)(row0 + ai * 128 + m * 16) * DM + col0 + bj * 128);
#pragma unroll
                for (int m = 0; m < 4; ++m) { const int row = row0 + ai * 128 + m * 16; float ss = 0.f;
#pragma unroll
                    for (int bj = 0; bj < 2; ++bj) { const u32x4 w = pre[m][bj];
                        const f32x4 b0 = (f32x4){__builtin_bit_cast(float, w.x << 16), __builtin_bit_cast(float, w.x & 0xffff0000u), __builtin_bit_cast(float, w.y << 16), __builtin_bit_cast(float, w.y & 0xffff0000u)};
                        const f32x4 b1 = (f32x4){__builtin_bit_cast(float, w.z << 16), __builtin_bit_cast(float, w.z & 0xffff0000u), __builtin_bit_cast(float, w.w << 16), __builtin_bit_cast(float, w.w & 0xffff0000u)};
                        row_part(acc[ai][bj][m][0], acc[ai][bj][m][1], b0, b1, (size_t)row * DM + col0 + bj * 128, ss); }
                    row_end(ss, row, u.pn, wc, fq); }
                asm volatile("" ::: "memory");
            }
        }
    }
};
template <bool F32BASE> struct EpiExch {
    static constexpr bool PERM = true, AFTER_DRAIN = true;
    const float* basef; const bf16_t* baseb; const float* rnin; float alpha; float* OUT; const float* gfin; bf16_t* HBN; float* rnout; float* xbuf; unsigned* cnt;
    __device__ __forceinline__ void fused(f32x4 (&acc)[2][2][4][2], const pg8::Unit& u, int wr, int wc, int fr, int fq, LAS unsigned char* lds, int wid, int lane) const {
        asm volatile("" : "+v"(fr), "+v"(fq), "+v"(lane));
        LAS float* Pp = (LAS float*)lds;
        LAS float* S = (LAS float*)(lds + 4096);
        const int col0 = u.pn * 256 + wc * 32 + fq * 8;
        const int rowl0 = wr * 64 + fr;
        if constexpr (F32BASE) {
            unsigned vofff = (unsigned)((rowl0 * DM + col0) * 4); asm volatile("" : "+v"(vofff));
#pragma unroll
            for (int g = 0; g < 8; ++g) {
                const int ai = g >> 2, m = g & 3; f32x4 pre[2][2];
#pragma unroll
                for (int bj = 0; bj < 2; ++bj) { const char* sb = (const char*)(basef + (size_t)(u.pm * 256 + ai * 128 + m * 16) * DM + bj * 128);
                    pre[bj][0] = __builtin_nontemporal_load((const f32x4*)(sb + vofff)); pre[bj][1] = __builtin_nontemporal_load((const f32x4*)(sb + vofff + 16)); }
                float ss = 0.f;
#pragma unroll
                for (int bj = 0; bj < 2; ++bj) { const f32x4 h0 = pre[bj][0] + acc[ai][bj][m][0] * alpha, h1 = pre[bj][1] + acc[ai][bj][m][1] * alpha;
                    acc[ai][bj][m][0] = h0; acc[ai][bj][m][1] = h1;
                    ss += (h0.x * h0.x + h0.y * h0.y) + (h0.z * h0.z + h0.w * h0.w) + (h1.x * h1.x + h1.y * h1.y) + (h1.z * h1.z + h1.w * h1.w); }
                ss += sxor<16>(ss); ss = hsum32(ss);
                if (fq == 0) Pp[(rowl0 + ai * 128 + m * 16) * 4 + wc] = ss;
                if (g & 1) asm volatile("" ::: "memory");
            }
        } else {
#pragma unroll
            for (int ai = 0; ai < 2; ++ai) {
                u32x4 pre[4][2]; float rn[4];
#pragma unroll
                for (int m = 0; m < 4; ++m) { const int row = u.pm * 256 + rowl0 + ai * 128 + m * 16; rn[m] = rnin ? rnin[row] : 1.0f;
#pragma unroll
                    for (int bj = 0; bj < 2; ++bj) pre[m][bj] = *(const u32x4*)(baseb + (size_t)row * DM + col0 + bj * 128); }
#pragma unroll
                for (int m = 0; m < 4; ++m) { float ss = 0.f;
#pragma unroll
                    for (int bj = 0; bj < 2; ++bj) {
                        const u32x4 w = pre[m][bj];
                        const f32x4 b0 = (f32x4){__builtin_bit_cast(float, w.x << 16), __builtin_bit_cast(float, w.x & 0xffff0000u), __builtin_bit_cast(float, w.y << 16), __builtin_bit_cast(float, w.y & 0xffff0000u)};
                        const f32x4 b1 = (f32x4){__builtin_bit_cast(float, w.z << 16), __builtin_bit_cast(float, w.z & 0xffff0000u), __builtin_bit_cast(float, w.w << 16), __builtin_bit_cast(float, w.w & 0xffff0000u)};
                        const f32x4 h0 = b0 * rn[m] + acc[ai][bj][m][0] * alpha, h1 = b1 * rn[m] + acc[ai][bj][m][1] * alpha;
                        acc[ai][bj][m][0] = h0; acc[ai][bj][m][1] = h1;
                        ss += (h0.x * h0.x + h0.y * h0.y) + (h0.z * h0.z + h0.w * h0.w) + (h1.x * h1.x + h1.y * h1.y) + (h1.z * h1.z + h1.w * h1.w);
                    }
                    ss += sxor<16>(ss); ss = hsum32(ss);
                    if (fq == 0) Pp[(rowl0 + ai * 128 + m * 16) * 4 + wc] = ss;
                }
                asm volatile("" ::: "memory");
            }
        }
        asm volatile("s_waitcnt lgkmcnt(0)" ::: "memory"); __builtin_amdgcn_s_barrier(); asm volatile("" ::: "memory");
        const int t = wid * 64 + lane;
        if (t < 256) { const f32x4 p = *(const LAS f32x4*)(Pp + t * 4);
            __hip_atomic_store(xbuf + (size_t)(u.pm * 256 + t) * 4 + u.pn, (p.x + p.y) + (p.z + p.w), __ATOMIC_RELAXED, __HIP_MEMORY_SCOPE_AGENT); }
        asm volatile("s_waitcnt vmcnt(0)" ::: "memory");
        if (lane == 0) __hip_atomic_fetch_add(cnt + 64 * u.pm, 1u, __ATOMIC_RELAXED, __HIP_MEMORY_SCOPE_AGENT);
        if (wid == 0) {
            unsigned spins = 0;
            while ((unsigned)__builtin_amdgcn_readfirstlane(__hip_atomic_load(cnt + 64 * u.pm, __ATOMIC_RELAXED, __HIP_MEMORY_SCOPE_AGENT)) < 32u) { __builtin_amdgcn_s_sleep(2); if (++spins > (1u << 22)) break; }
            __builtin_amdgcn_fence(__ATOMIC_ACQUIRE, "agent");
        }
        asm volatile("s_waitcnt vmcnt(0) lgkmcnt(0)" ::: "memory"); __builtin_amdgcn_s_barrier(); asm volatile("" ::: "memory");
        if (t < 256) { const float* sl = xbuf + (size_t)(u.pm * 256 + t) * 4; float q = 0.f;
#pragma unroll
            for (int k = 0; k < 4; ++k) q += __hip_atomic_load(sl + k, __ATOMIC_RELAXED, __HIP_MEMORY_SCOPE_AGENT);
            const float ms = q * (1.0f / DM) + EPS;
            S[t] = __builtin_amdgcn_rsqf(ms);
            if (rnout && u.pn == 0) rnout[u.pm * 256 + t] = sqrtf(ms); }
        asm volatile("s_waitcnt lgkmcnt(0)" ::: "memory"); __builtin_amdgcn_s_barrier(); asm volatile("" ::: "memory");
        if (OUT) {
#pragma unroll
            for (int bj = 0; bj < 2; ++bj) { const f32x4 g0 = *(const f32x4*)(gfin + col0 + bj * 128), g1 = *(const f32x4*)(gfin + col0 + bj * 128 + 4);
#pragma unroll
                for (int ai = 0; ai < 2; ++ai)
#pragma unroll
                    for (int m = 0; m < 4; ++m) { const int rl = rowl0 + ai * 128 + m * 16; const float rs = S[rl];
                        float* op = OUT + (size_t)(u.pm * 256 + rl) * DM + col0 + bj * 128;
                        *(f32x4*)op = acc[ai][bj][m][0] * rs * g0; *(f32x4*)(op + 4) = acc[ai][bj][m][1] * rs * g1; }
                asm volatile("" ::: "memory"); }
        } else {
#pragma unroll
            for (int ai = 0; ai < 2; ++ai)
#pragma unroll
                for (int m = 0; m < 4; ++m) { const int rl = rowl0 + ai * 128 + m * 16; const float rs = S[rl];
#pragma unroll
                    for (int bj = 0; bj < 2; ++bj) { const f32x4 a0 = acc[ai][bj][m][0] * rs, a1 = acc[ai][bj][m][1] * rs;
                        u32x4 w; w.x = pk2(a0.x, a0.y); w.y = pk2(a0.z, a0.w); w.z = pk2(a1.x, a1.y); w.w = pk2(a1.z, a1.w);
                        *(u32x4*)(HBN + (size_t)(u.pm * 256 + rl) * DM + col0 + bj * 128) = w; }
                    if (m & 1) asm volatile("" ::: "memory"); }
        }
    }
};
struct EpiInProj {
    static constexpr bool PERM = true, AFTER_DRAIN = false;
    const float* ssq; const float* ropec; const float* ropes; bf16_t *Q, *K, *VT, *G, *MQ;
    __device__ __forceinline__ void operator()(const f32x4 (&acc)[2][2][4][2], const pg8::Unit& u, int wr, int wc, int fr, int fq) const {
        asm volatile("" : "+v"(fr), "+v"(fq));
        const int row0 = u.pm * 256 + wr * 64 + fr; const int pn = u.pn;
        float rs8[8];
        if (ssq) rows_rstd8(ssq, row0, fq, rs8); else {
#pragma unroll
            for (int i = 0; i < 8; ++i) rs8[i] = 1.0f; }
        f32x4 rc[2][2], rsn[2][2];
#pragma unroll
        for (int ai = 0; ai < 2; ++ai)
#pragma unroll
            for (int m = 0; m < 4; ++m) {
                const int row = row0 + ai * 128 + m * 16;
                const float rs = rs8[ai * 4 + m];
                if (pn < 4) {
                    const int pos = row & (SEQ - 1);
                    const float sc = (pn < 2) ? QSCALE : 1.0f;
                    if ((m & 1) == 0) {
#pragma unroll
                        for (int k = 0; k < 2; ++k)
#pragma unroll
                            for (int n = 0; n < 2; ++n) { rc[k][n] = *(const f32x4*)(ropec + (pos + 16 * k) * 32 + fq * 8 + n * 4); rsn[k][n] = *(const f32x4*)(ropes + (pos + 16 * k) * 32 + fq * 8 + n * 4); } }
                    float o1[8], o2[8];
#pragma unroll
                    for (int n = 0; n < 2; ++n) {
                        const f32x4 c = rc[m & 1][n], s = rsn[m & 1][n];
#pragma unroll
                        for (int i = 0; i < 4; ++i) { const float x1 = acc[ai][0][m][n][i] * rs, x2 = acc[ai][1][m][n][i] * rs;
                            o1[n * 4 + i] = (x1 * c[i] - x2 * s[i]) * sc; o2[n * 4 + i] = (x2 * c[i] + x1 * s[i]) * sc; }
                    }
                    bf16_t* dst = ((pn < 2) ? Q : K) + (size_t)row * 512 + (pn & 1) * 256 + wc * 64 + fq * 8;
                    u32x4 w; w.x = pk2(o1[0], o1[1]); w.y = pk2(o1[2], o1[3]); w.z = pk2(o1[4], o1[5]); w.w = pk2(o1[6], o1[7]); *(u32x4*)dst = w;
                    w.x = pk2(o2[0], o2[1]); w.y = pk2(o2[2], o2[3]); w.z = pk2(o2[4], o2[5]); w.w = pk2(o2[6], o2[7]); *(u32x4*)(dst + 32) = w;
                } else if (pn < 6) {
                    const int b = u.pm >> 5, t = row & (SEQ - 1);
                    unsigned voff = (unsigned)((wc * 32 + fq * 8) * SEQ + ((t & ~15) | perm16(t & 15))); asm volatile("" : "+v"(voff));
#pragma unroll
                    for (int bj = 0; bj < 2; ++bj)
#pragma unroll
                        for (int n = 0; n < 2; ++n)
#pragma unroll
                            for (int i = 0; i < 4; ++i) { bf16_t* bp = VT + (size_t)((b * 4 + (pn - 4) * 2 + bj) * 128 + n * 4 + i) * SEQ;
                                bp[voff] = (bf16_t)f2bf(acc[ai][bj][m][n][i] * rs); }
                } else if (pn < 8) {
                    float v[8];
#pragma unroll
                    for (int n = 0; n < 2; ++n)
#pragma unroll
                        for (int i = 0; i < 4; ++i) { const float a = acc[ai][0][m][n][i] * rs, g = acc[ai][1][m][n][i] * rs; v[n * 4 + i] = a * __builtin_amdgcn_rcpf(1.0f + __expf(-g)); }
                    u32x4 w; w.x = pk2(v[0], v[1]); w.y = pk2(v[2], v[3]); w.z = pk2(v[4], v[5]); w.w = pk2(v[6], v[7]);
                    *(u32x4*)(G + (size_t)row * 256 + (pn - 6) * 128 + wc * 32 + fq * 8) = w;
                } else {
#pragma unroll
                    for (int bj = 0; bj < 2; ++bj) { const f32x4 a0 = acc[ai][bj][m][0] * (rs * QSCALE), a1 = acc[ai][bj][m][1] * (rs * QSCALE);
                        u32x4 w; w.x = pk2(a0.x, a0.y); w.y = pk2(a0.z, a0.w); w.z = pk2(a1.x, a1.y); w.w = pk2(a1.z, a1.w);
                        *(u32x4*)(MQ + (size_t)row * 256 + bj * 128 + wc * 32 + fq * 8) = w; }
                }
                if (EPI_FENCE(m)) asm volatile("" ::: "memory");
            }
    }
};
struct EpiMemKV {
    static constexpr bool PERM = true, AFTER_DRAIN = false;
    bf16_t *MK, *MVT;
    __device__ __forceinline__ void operator()(const f32x4 (&acc)[2][2][4][2], const pg8::Unit& u, int wr, int wc, int fr, int fq) const {
        asm volatile("" : "+v"(fr), "+v"(fq));
        const int row0 = u.pm * 256 + wr * 64 + fr;
#pragma unroll
        for (int ai = 0; ai < 2; ++ai)
#pragma unroll
            for (int m = 0; m < 4; ++m) {
                const int row = row0 + ai * 128 + m * 16;
                if (u.pn == 0) {
#pragma unroll
                    for (int bj = 0; bj < 2; ++bj) { const f32x4 a0 = acc[ai][bj][m][0], a1 = acc[ai][bj][m][1];
                        u32x4 w; w.x = pk2(a0.x, a0.y); w.y = pk2(a0.z, a0.w); w.z = pk2(a1.x, a1.y); w.w = pk2(a1.z, a1.w);
                        *(u32x4*)(MK + (size_t)row * 256 + bj * 128 + wc * 32 + fq * 8) = w; }
                } else {
                    const int b = u.pm, mi = row & 255;
                    unsigned voff = (unsigned)((wc * 32 + fq * 8) * NMEM + ((mi & ~15) | perm16(mi & 15))); asm volatile("" : "+v"(voff));
#pragma unroll
                    for (int bj = 0; bj < 2; ++bj)
#pragma unroll
                        for (int n = 0; n < 2; ++n)
#pragma unroll
                            for (int i = 0; i < 4; ++i) { bf16_t* bp = MVT + (size_t)((b * 4 + bj * 2) * 64 + n * 4 + i) * NMEM;
                                bp[voff] = (bf16_t)f2bf(acc[ai][bj][m][n][i]); }
                }
                if (EPI_FENCE(m)) asm volatile("" ::: "memory");
            }
    }
};

__device__ __forceinline__ void transpose_item(const float* W, int ldw, int s0, const float* gain, bf16_t* WT, int K, int p0, int k0, LAS float* scr, int lane) {
    float v[32];
    const float* wp = W + (size_t)(k0 + (lane >> 5)) * ldw + s0 + (lane & 31);
#pragma unroll
    for (int i = 0; i < 32; ++i) v[i] = __builtin_nontemporal_load(wp + (size_t)(2 * i) * ldw);
    const int c = lane & 7;
    f32x4 g0 = {1.f, 1.f, 1.f, 1.f}, g1 = g0;
    if (gain) { g0 = *(const f32x4*)(gain + k0 + 8 * c); g1 = *(const f32x4*)(gain + k0 + 8 * c + 4); }
#pragma unroll
    for (int i = 0; i < 32; ++i) scr[(2 * i + (lane >> 5)) * 33 + (lane & 31)] = v[i];
    asm volatile("s_waitcnt lgkmcnt(0)" ::: "memory");
#pragma unroll
    for (int j = 0; j < 4; ++j) { const int n = (lane >> 3) + 8 * j; const LAS float* s = scr + (8 * c) * 33 + n;
        u32x4 o; o.x = pk2(s[0 * 33] * g0.x, s[1 * 33] * g0.y); o.y = pk2(s[2 * 33] * g0.z, s[3 * 33] * g0.w); o.z = pk2(s[4 * 33] * g1.x, s[5 * 33] * g1.y); o.w = pk2(s[6 * 33] * g1.z, s[7 * 33] * g1.w);
        *(u32x4*)(WT + (size_t)(p0 + n) * K + k0 + 8 * c) = o; }
    asm volatile("s_waitcnt lgkmcnt(0)" ::: "memory");
}
__device__ __forceinline__ int in_src_col(int p0) {
    const int pn = p0 >> 8, p = p0 & 255, bj = p >> 7, wc = (p >> 5) & 3;
    if (pn < 4) return 256 * pn + 64 * wc + 32 * bj;
    if (pn == 6 || pn == 7) return (bj ? 1792 : 1536) + 128 * (pn - 6) + (p & 127);
    return p0;
}
__device__ __forceinline__ void rms_row_to_bf16(const float* xrow, const float* g, bf16_t* orow, int lane) {
    const f32x4* xr = (const f32x4*)xrow + lane; const f32x4* gr = (const f32x4*)g + lane;
    f32x4 v[4]; float s = 0.f;
#pragma unroll
    for (int j = 0; j < 4; ++j) { v[j] = __builtin_nontemporal_load(&xr[64 * j]); s += (v[j].x * v[j].x + v[j].y * v[j].y) + (v[j].z * v[j].z + v[j].w * v[j].w); }
    const float rstd = 1.0f / sqrtf(wave_sum(s) * (1.0f / DM) + EPS);
    u32x2* o8 = (u32x2*)orow + lane;
#pragma unroll
    for (int j = 0; j < 4; ++j) { const f32x4 gg = gr[64 * j]; u32x2 w; w.x = pk2(v[j].x * rstd * gg.x, v[j].y * rstd * gg.y); w.y = pk2(v[j].z * rstd * gg.z, v[j].w * rstd * gg.w); o8[64 * j] = w; }
}
__device__ __forceinline__ void rms_row2_to_bf16(const float* xa, const float* xb, const float* g, bf16_t* oa, bf16_t* ob, int lane) {
    const f32x4* ra = (const f32x4*)xa + lane; const f32x4* rb = (const f32x4*)xb + lane; const f32x4* gr = (const f32x4*)g + lane;
    f32x4 va[4], vb[4]; float sa = 0.f, sb = 0.f;
#pragma unroll
    for (int j = 0; j < 4; ++j) { va[j] = __builtin_nontemporal_load(&ra[64 * j]); vb[j] = __builtin_nontemporal_load(&rb[64 * j]); }
#pragma unroll
    for (int j = 0; j < 4; ++j) { sa += (va[j].x * va[j].x + va[j].y * va[j].y) + (va[j].z * va[j].z + va[j].w * va[j].w); sb += (vb[j].x * vb[j].x + vb[j].y * vb[j].y) + (vb[j].z * vb[j].z + vb[j].w * vb[j].w); }
    sa += sxor<1>(sa); sb += sxor<1>(sb); sa += sxor<2>(sa); sb += sxor<2>(sb); sa += sxor<4>(sa); sb += sxor<4>(sb); sa += sxor<8>(sa); sb += sxor<8>(sb); sa += sxor<16>(sa); sb += sxor<16>(sb);
    sa = hsum32(sa); sb = hsum32(sb);
    const float rsa = 1.0f / sqrtf(sa * (1.0f / DM) + EPS), rsb = 1.0f / sqrtf(sb * (1.0f / DM) + EPS);
    u32x2* pa = (u32x2*)oa + lane; u32x2* pb = (u32x2*)ob + lane;
#pragma unroll
    for (int j = 0; j < 4; ++j) { const f32x4 gg = gr[64 * j]; u32x2 w;
        w.x = pk2(va[j].x * rsa * gg.x, va[j].y * rsa * gg.y); w.y = pk2(va[j].z * rsa * gg.z, va[j].w * rsa * gg.w); pa[64 * j] = w;
        w.x = pk2(vb[j].x * rsb * gg.x, vb[j].y * rsb * gg.y); w.y = pk2(vb[j].z * rsb * gg.z, vb[j].w * rsb * gg.w); pb[64 * j] = w; }
}

template <int NJ>
__device__ __forceinline__ void naive_stream(const bf16_t* qp, const bf16_t* Kb, int kpitch, const bf16_t* Vt, int vpitch, int nkeys, float (&o)[NJ]) {
    u32x4 q[8];
#pragma unroll
    for (int j = 0; j < 8; ++j) q[j] = *(const u32x4*)(qp + 8 * j);
#define BLO(w) __builtin_bit_cast(float, (w) << 16)
#define BHI(w) __builtin_bit_cast(float, (w) & 0xffff0000u)
    float mx = -INFINITY, l = 0.f; int zoff = 0; asm volatile("" : "+v"(zoff));
#pragma unroll
    for (int j = 0; j < NJ; ++j) o[j] = 0.f;
    for (int kb = 0; kb < nkeys; kb += 16) {
        float s[16];
#pragma unroll
        for (int kk = 0; kk < 16; ++kk) {
            const bf16_t* kp = Kb + (size_t)(kb + kk) * kpitch + zoff; float a = 0.f;
#pragma unroll
            for (int j = 0; j < 8; ++j) { const u32x4 w = *(const u32x4*)(kp + 8 * j);
                a += BLO(q[j].x) * BLO(w.x) + BHI(q[j].x) * BHI(w.x); a += BLO(q[j].y) * BLO(w.y) + BHI(q[j].y) * BHI(w.y);
                a += BLO(q[j].z) * BLO(w.z) + BHI(q[j].z) * BHI(w.z); a += BLO(q[j].w) * BLO(w.w) + BHI(q[j].w) * BHI(w.w); }
            s[kk] = a;
        }
        float bm = s[0];
#pragma unroll
        for (int kk = 1; kk < 16; ++kk) bm = fmaxf(bm, s[kk]);
        const float mn = fmaxf(mx, bm), sc = exp2f(mx - mn); mx = mn;
        float ps = 0.f;
#pragma unroll
        for (int kk = 0; kk < 16; ++kk) { s[kk] = exp2f(s[kk] - mn); ps += s[kk]; }
        l = l * sc + ps;
#pragma unroll
        for (int j = 0; j < NJ; ++j) {
            const bf16_t* vp = Vt + (size_t)j * vpitch + kb;
            const u32x4 w0 = *(const u32x4*)vp, w1 = *(const u32x4*)(vp + 8);
            float a = 0.f;
            a += s[0] * __builtin_bit_cast(float, w0.x << 16) + s[1] * __builtin_bit_cast(float, w0.x & 0xffff0000u);
            a += s[2] * __builtin_bit_cast(float, w0.y << 16) + s[3] * __builtin_bit_cast(float, w0.y & 0xffff0000u);
            a += s[8] * __builtin_bit_cast(float, w0.z << 16) + s[9] * __builtin_bit_cast(float, w0.z & 0xffff0000u);
            a += s[10] * __builtin_bit_cast(float, w0.w << 16) + s[11] * __builtin_bit_cast(float, w0.w & 0xffff0000u);
            a += s[4] * __builtin_bit_cast(float, w1.x << 16) + s[5] * __builtin_bit_cast(float, w1.x & 0xffff0000u);
            a += s[6] * __builtin_bit_cast(float, w1.y << 16) + s[7] * __builtin_bit_cast(float, w1.y & 0xffff0000u);
            a += s[12] * __builtin_bit_cast(float, w1.z << 16) + s[13] * __builtin_bit_cast(float, w1.z & 0xffff0000u);
            a += s[14] * __builtin_bit_cast(float, w1.w << 16) + s[15] * __builtin_bit_cast(float, w1.w & 0xffff0000u);
            o[j] = o[j] * sc + a;
        }
    }
    const float rl = 1.0f / l;
#pragma unroll
    for (int j = 0; j < NJ; ++j) o[j] *= rl;
}


typedef short bf16x8 __attribute__((ext_vector_type(8)));
typedef float f32x16 __attribute__((ext_vector_type(16)));
typedef float f32x2_t __attribute__((ext_vector_type(2)));
typedef __bf16 bf16x2_t __attribute__((ext_vector_type(2)));
__device__ __forceinline__ unsigned cvtpk_s(float lo, float hi) { f32x2_t v = {lo, hi}; bf16x2_t b = __builtin_convertvector(v, bf16x2_t); return __builtin_bit_cast(unsigned, b); }
__device__ __forceinline__ int crow(int r, int hi) { return (r & 3) + 8 * (r >> 2) + 4 * hi; }
#define MFMA32(a, b, c) __builtin_amdgcn_mfma_f32_32x32x16_bf16((a), (b), (c), 0, 0, 0)
constexpr int KST = 144;
constexpr int DA_KSLOT = 16384, DA_VSLOT = 16384, DA_V0 = 3 * DA_KSLOT;
constexpr int DA_WSF = DA_V0 + 3 * DA_VSLOT;
constexpr int MA_VST = 528, MA_VT = 256 * KST;
static_assert(DA_WSF >= 65536 && DA_WSF + 1024 <= 131072 && MA_VT + 64 * MA_VST <= DA_WSF, "attention LDS map");

__device__ __forceinline__ void qk_tile(const LAS unsigned char* Kt, int kst, const bf16x8 (&qr)[4], f32x16& p0, f32x16& p1, int r32, int hi) {
#pragma unroll
    for (int r = 0; r < 16; ++r) { p0[r] = 0.f; p1[r] = 0.f; }
    const LAS unsigned char* ka = Kt + r32 * kst + hi * 16;
#pragma unroll
    for (int ds = 0; ds < 4; ++ds) {
        const bf16x8 a0 = *(const LAS bf16x8*)(ka + ds * 32), a1 = *(const LAS bf16x8*)(ka + 32 * kst + ds * 32);
        p0 = MFMA32(a0, qr[ds], p0); p1 = MFMA32(a1, qr[ds], p1);
    }
}
__device__ __forceinline__ float half_max(float v) { float a = v, b = v; swap32(a, b); return fmaxf(a, b); }
__device__ __forceinline__ float half_sum(float v) { return hsum32(v); }
template <int NDB>
__device__ __forceinline__ void soft_max_rescale(const f32x16& p0, const f32x16& p1, f32x16 (&o)[NDB], float& m, float& l, LAS float* wsf, int r32, int hi) {
    float ra = fmaxf(p0[0], p1[0]), rb = fmaxf(p0[1], p1[1]);
#pragma unroll
    for (int r = 2; r < 16; r += 2) { ra = fmaxf(ra, fmaxf(p0[r], p1[r])); rb = fmaxf(rb, fmaxf(p0[r + 1], p1[r + 1])); }
    const float rm = half_max(fmaxf(ra, rb));
    if (__any(rm > m + 8.0f)) {
        const float mn = (rm > m + 8.0f) ? rm : m;
        const float alpha = __builtin_amdgcn_exp2f(m - mn); l *= alpha; m = mn;
        asm volatile("" ::: "memory");
        if (hi == 0) wsf[r32] = alpha;
        asm volatile("" ::: "memory");
        float al[16];
#pragma unroll
        for (int r = 0; r < 16; ++r) al[r] = wsf[crow(r, hi)];
#pragma unroll
        for (int blk = 0; blk < NDB; ++blk)
#pragma unroll
            for (int r = 0; r < 16; ++r) o[blk][r] *= al[r];
        asm volatile("" ::: "memory");
    }
}
__device__ __forceinline__ void soft_exp_pack(f32x16& p0, f32x16& p1, float m, float& l, bf16x8 (&pa)[4]) {
    float ps0 = 0.f, ps1 = 0.f;
#pragma unroll
    for (int r = 0; r < 16; ++r) { p0[r] = __builtin_amdgcn_exp2f(p0[r] - m); p1[r] = __builtin_amdgcn_exp2f(p1[r] - m); ps0 += p0[r]; ps1 += p1[r]; }
    l += ps0 + ps1;
    u32x4 w;
    w.x = cvtpk_s(p0[0], p0[1]); w.y = cvtpk_s(p0[2], p0[3]); w.z = cvtpk_s(p0[4], p0[5]); w.w = cvtpk_s(p0[6], p0[7]); pa[0] = __builtin_bit_cast(bf16x8, w);
    w.x = cvtpk_s(p0[8], p0[9]); w.y = cvtpk_s(p0[10], p0[11]); w.z = cvtpk_s(p0[12], p0[13]); w.w = cvtpk_s(p0[14], p0[15]); pa[1] = __builtin_bit_cast(bf16x8, w);
    w.x = cvtpk_s(p1[0], p1[1]); w.y = cvtpk_s(p1[2], p1[3]); w.z = cvtpk_s(p1[4], p1[5]); w.w = cvtpk_s(p1[6], p1[7]); pa[2] = __builtin_bit_cast(bf16x8, w);
    w.x = cvtpk_s(p1[8], p1[9]); w.y = cvtpk_s(p1[10], p1[11]); w.z = cvtpk_s(p1[12], p1[13]); w.w = cvtpk_s(p1[14], p1[15]); pa[3] = __builtin_bit_cast(bf16x8, w);
}
template <int NDB>
__device__ __forceinline__ void pv_tile(const LAS unsigned char* Vt, int vst, const bf16x8 (&pa)[4], f32x16 (&o)[NDB], int r32, int hi) {
    const LAS unsigned char* va = Vt + r32 * vst + hi * 16;
#pragma unroll
    for (int st = 0; st < 4; ++st)
#pragma unroll
        for (int blk = 0; blk < NDB; ++blk) {
            const bf16x8 vb = *(const LAS bf16x8*)(va + blk * 32 * vst + st * 32);
            o[blk] = MFMA32(pa[st], vb, o[blk]);
        }
}
template <int NDB>
__device__ __forceinline__ void attn_tile(const LAS unsigned char* Kt, int kst, const LAS unsigned char* Vt, int vst, const bf16x8 (&qr)[4], f32x16 (&o)[NDB], float& m, float& l, LAS float* wsf, int r32, int hi) {
    f32x16 p0, p1; bf16x8 pa[4];
    qk_tile(Kt, kst, qr, p0, p1, r32, hi);
    soft_max_rescale<NDB>(p0, p1, o, m, l, wsf, r32, hi);
    soft_exp_pack(p0, p1, m, l, pa);
    pv_tile<NDB>(Vt, vst, pa, o, r32, hi);
}

#define SB() __builtin_amdgcn_sched_barrier(0)
#define LDF(p) (*(const LAS bf16x8*)(p))
__device__ __forceinline__ float row_max32(const f32x16& p0, const f32x16& p1) {
    float ra = fmaxf(fmaxf(p0[0], p0[1]), p1[0]), rb = fmaxf(fmaxf(p0[2], p0[3]), p1[1]); ra = fmaxf(fmaxf(ra, p1[2]), p1[3]);
#pragma unroll
    for (int r = 4; r < 16; r += 4) { ra = fmaxf(fmaxf(ra, p0[r]), p0[r + 1]); rb = fmaxf(fmaxf(rb, p0[r + 2]), p0[r + 3]); ra = fmaxf(fmaxf(ra, p1[r]), p1[r + 1]); rb = fmaxf(fmaxf(rb, p1[r + 2]), p1[r + 3]); }
    return half_max(fmaxf(ra, rb));
}
__device__ __forceinline__ void da_shift(float d, f32x16& n0, f32x16& n1, f32x16 (&o)[4], float& m, float& l, LAS float* wsf, int r32, int hi) {
    m += d;
#pragma unroll
    for (int r = 0; r < 16; ++r) { n0[r] -= d; n1[r] -= d; }
    const float alpha = __builtin_amdgcn_exp2f(-d); l *= alpha;
    asm volatile("" ::: "memory");
    if (hi == 0) wsf[r32] = alpha;
    asm volatile("" ::: "memory");
    float al[16];
#pragma unroll
    for (int r = 0; r < 16; ++r) al[r] = wsf[crow(r, hi)];
#pragma unroll
    for (int blk = 0; blk < 4; ++blk)
#pragma unroll
        for (int r = 0; r < 16; ++r) o[blk][r] *= al[r];
    asm volatile("" ::: "memory");
}
__device__ __forceinline__ bf16x8 pack8(const f32x16& p, int b) { u32x4 w; w.x = cvtpk_s(p[b], p[b + 1]); w.y = cvtpk_s(p[b + 2], p[b + 3]); w.z = cvtpk_s(p[b + 4], p[b + 5]); w.w = cvtpk_s(p[b + 6], p[b + 7]); return __builtin_bit_cast(bf16x8, w); }
template <bool DOQK>
__device__ __forceinline__ void da_step(const LAS unsigned char* Kt, const LAS unsigned char* Vt, const unsigned (&swo)[4], const bf16x8 (&qr)[4], f32x16& c0, f32x16& c1, f32x16& n0, f32x16& n1, float ninit,
                                        f32x16 (&o)[4], float& l, float& rmn) {
    constexpr int VPF = 3;
    bf16x8 kf[2][2], vf[VPF + 1], pa[4];
    float psa = 0.f, psb = 0.f, one = 1.0f; asm volatile("" : "+v"(one));
    if (DOQK) { kf[0][0] = LDF(Kt + swo[0]); kf[0][1] = LDF(Kt + swo[0] + 32 * 128);
#pragma unroll
        for (int r = 0; r < 16; ++r) { n0[r] = ninit; n1[r] = ninit; } }
    SB();
#define VFA(j) (Vt + swo[(j) >> 2] + ((j) & 3) * 32 * 128)
#pragma unroll
    for (int ds = 0; ds < 4; ++ds) {
        if (DOQK && ds < 3) { kf[(ds + 1) & 1][0] = LDF(Kt + swo[ds + 1]); kf[(ds + 1) & 1][1] = LDF(Kt + swo[ds + 1] + 32 * 128); }
        if (ds + VPF >= 4) vf[ds + VPF - 4] = LDF(VFA(ds + VPF - 4));
        if (DOQK) n0 = MFMA32(kf[ds & 1][0], qr[ds], n0);
        c0[4 * ds + 0] = __builtin_amdgcn_exp2f(c0[4 * ds + 0]); c0[4 * ds + 1] = __builtin_amdgcn_exp2f(c0[4 * ds + 1]);
        if (DOQK) n1 = MFMA32(kf[ds & 1][1], qr[ds], n1);
        c0[4 * ds + 2] = __builtin_amdgcn_exp2f(c0[4 * ds + 2]); c0[4 * ds + 3] = __builtin_amdgcn_exp2f(c0[4 * ds + 3]);
        psa = __builtin_fmaf(c0[4 * ds + 0], one, psa); psb += c0[4 * ds + 1]; psa = __builtin_fmaf(c0[4 * ds + 2], one, psa); psb += c0[4 * ds + 3];
        if (ds == 1) pa[0] = pack8(c0, 0);
        if (ds == 3) pa[1] = pack8(c0, 8);
        SB();
    }
    float ra = -INFINITY;
#pragma unroll
    for (int j = 0; j < 16; ++j) {
        const int st = j >> 2, blk = j & 3;
        if (j + VPF < 16) vf[(j + VPF) % (VPF + 1)] = LDF(VFA(j + VPF));
        o[blk] = MFMA32(pa[st], vf[j % (VPF + 1)], o[blk]);
        if (st < 2) { const int e = 8 * st + 2 * blk;
            c1[e] = __builtin_amdgcn_exp2f(c1[e]); c1[e + 1] = __builtin_amdgcn_exp2f(c1[e + 1]); psa = __builtin_fmaf(c1[e], one, psa); psb += c1[e + 1];
            if (blk == 3) pa[2 + st] = pack8(c1, 8 * st);
        } else if (DOQK) {
            if (st == 2) ra = fmaxf(fmaxf(fmaxf(ra, n0[4 * blk]), fmaxf(n0[4 * blk + 1], n0[4 * blk + 2])), n0[4 * blk + 3]);
            else         ra = fmaxf(fmaxf(fmaxf(ra, n1[4 * blk]), fmaxf(n1[4 * blk + 1], n1[4 * blk + 2])), n1[4 * blk + 3]);
        }
        SB();
    }
#undef VFA
    l += psa + psb;
    if (DOQK) rmn = half_max(ra);
}
__device__ __forceinline__ void qk_tile_sw(const LAS unsigned char* Kt, const unsigned (&swo)[4], const bf16x8 (&qr)[4], f32x16& p0, f32x16& p1) {
#pragma unroll
    for (int r = 0; r < 16; ++r) { p0[r] = 0.f; p1[r] = 0.f; }
#pragma unroll
    for (int ds = 0; ds < 4; ++ds) {
        const bf16x8 a0 = LDF(Kt + swo[ds]), a1 = LDF(Kt + swo[ds] + 32 * 128);
        p0 = MFMA32(a0, qr[ds], p0); p1 = MFMA32(a1, qr[ds], p1);
    }
}

#define XB_TMO      128
#define XB_XCNT(j)  (256  + 64 * (j))
#define XB_XSUB(j)  (1280 + 64 * (j))
#define XB_XGEN(j)  (2304 + 64 * (j))
#define XB_TOP      3328
#define XB_TOPGEN   3392
#define XCD_BAR_WORDS 3456
#define XB_SPIN_CAP (1u << 18)

__device__ __forceinline__ unsigned xb_ld(unsigned* p)              { return __hip_atomic_load(p, __ATOMIC_RELAXED, __HIP_MEMORY_SCOPE_AGENT); }
__device__ __forceinline__ unsigned xb_add(unsigned* p, unsigned v) { return __hip_atomic_fetch_add(p, v, __ATOMIC_RELAXED, __HIP_MEMORY_SCOPE_AGENT); }
__device__ __forceinline__ unsigned xb_xcc_id() { return (unsigned)__builtin_amdgcn_s_getreg((3 << 11) | 20) & 0xFu; }
#define XB_SPIN(cond, bar) do { unsigned _sp = 0; while (cond) { __builtin_amdgcn_s_sleep(1); \
    if ((++_sp & 255u) == 0u) { if (xb_ld(&(bar)[XB_TMO])) break; if (_sp > XB_SPIN_CAP) { atomicAdd(&(bar)[XB_TMO], 1u); break; } } } } while (0)

struct XcdBarrier {
    unsigned* bar; unsigned x; bool w0;
    volatile LAS unsigned* st;
};

__device__ __forceinline__ XcdBarrier xcd_barrier_post(unsigned* bar, volatile LAS unsigned* st) {
    XcdBarrier b; b.bar = bar; b.x = xb_xcc_id(); b.st = st;
    if (threadIdx.x == 0) (void)xb_add(&bar[XB_XCNT(b.x)], 1u);
    return b;
}
__device__ __forceinline__ void xcd_barrier_complete(unsigned* bar, unsigned x, unsigned& nloc, unsigned& nx) {
    const unsigned G = gridDim.x * gridDim.y * gridDim.z;
    unsigned sum, cnt, mine, sp = 0u;
    for (;;) {
        sum = 0u; cnt = 0u; mine = 0u;
#pragma unroll
        for (unsigned j = 0; j < 16; ++j) { const unsigned c = xb_ld(&bar[XB_XCNT(j)]); sum += c; cnt += (c > 0u) ? 1u : 0u; mine = (j == x) ? c : mine; }
        if (sum == G) break;
        __builtin_amdgcn_s_sleep(1);
        if ((++sp & 255u) == 0u) { if (xb_ld(&bar[XB_TMO])) break; if (sp > XB_SPIN_CAP) { atomicAdd(&bar[XB_TMO], 1u); break; } }
    }
    nloc = mine > 0u ? mine : 1u; nx = cnt > 0u ? cnt : 1u;
}

__device__ __forceinline__ void xcd_barrier(const XcdBarrier& b) {
    asm volatile("s_waitcnt vmcnt(0)" ::: "memory");
    __syncthreads();
    if (b.w0 && LANE_ID() == 0) {
        unsigned* bar = b.bar;
        __builtin_amdgcn_s_waitcnt(0);
        unsigned nloc = b.st[0], nx = b.st[1];
        if (nloc == 0u) { xcd_barrier_complete(bar, b.x, nloc, nx); b.st[0] = nloc; b.st[1] = nx; }
        const unsigned old = xb_add(&bar[XB_XSUB(b.x)], 1u);
        const unsigned gen = old / nloc;
        if (old + 1u == (gen + 1u) * nloc) {
            __builtin_amdgcn_fence(__ATOMIC_RELEASE, "agent");
            asm volatile("s_waitcnt vmcnt(0)" ::: "memory");
            const unsigned og = xb_add(&bar[XB_TOP], 1u);
            const unsigned tg = og / nx;
            if (og + 1u == (tg + 1u) * nx) xb_add(&bar[XB_TOPGEN], 1u);
            else XB_SPIN(xb_ld(&bar[XB_TOPGEN]) == tg, bar);
            __builtin_amdgcn_fence(__ATOMIC_ACQUIRE, "agent");
            xb_add(&bar[XB_XGEN(b.x)], 1u);
            asm volatile("s_waitcnt vmcnt(0)" ::: "memory");
        } else {
            XB_SPIN(xb_ld(&bar[XB_XGEN(b.x)]) == gen, bar);
            __builtin_amdgcn_fence(__ATOMIC_ACQUIRE, "agent");
            asm volatile("s_waitcnt vmcnt(0)" ::: "memory");
        }
    }
    __syncthreads();
}

__global__ void __launch_bounds__(512, 2) fwd_megakernel(Params P) {
    extern __shared__ __attribute__((aligned(16))) unsigned char lds_raw[];
    LAS unsigned char* lds = (LAS unsigned char*)lds_raw;
    cg::grid_group grid = cg::this_grid();
    const int tid = threadIdx.x, lane = tid & 63, wave = __builtin_amdgcn_readfirstlane(tid >> 6);
    const int G = gridDim.x, gw = blockIdx.x * 8 + wave, NGW = G * 8;
    unsigned char* ws = P.ws;
    const float* x = P.in[0]; float* H = P.out;
    volatile LAS unsigned* bst = (volatile LAS unsigned*)(lds + 131072);
    if (tid < 2) bst[tid] = 0u;
    __syncthreads();
    XcdBarrier xbar = xcd_barrier_post((unsigned*)(ws + WS_CTL), bst); xbar.w0 = (wave == 0);
#if !defined(NO_CG_SYNC) && !defined(CG_SYNC_AT_END)
    grid.sync();
#endif
#define GRID_BAR() xcd_barrier(xbar)
    bf16_t* W_GU1 = (bf16_t*)(ws + WS_WGU1); bf16_t* W_D1 = (bf16_t*)(ws + WS_WD1); bf16_t* W_IN = (bf16_t*)(ws + WS_WIN); bf16_t* W_MKV = (bf16_t*)(ws + WS_WMKV);
    bf16_t* W_OUT = (bf16_t*)(ws + WS_WOUT); bf16_t* W_GU2 = (bf16_t*)(ws + WS_WGU2); bf16_t* W_D2 = (bf16_t*)(ws + WS_WD2);
    float* ROPEC = (float*)(ws + WS_ROPE); float* ROPES = ROPEC + SEQ * 32; float* SSQ = (float*)(ws + WS_SSQ); float* RN1 = SSQ; float* RN2 = SSQ + MTOK;
    bf16_t* MEMN = (bf16_t*)(ws + WS_MEMN); bf16_t* MK = (bf16_t*)(ws + WS_MK); bf16_t* MVT = (bf16_t*)(ws + WS_MVT);
    bf16_t* AB = (bf16_t*)(ws + WS_AB); bf16_t* ACT = (bf16_t*)(ws + WS_ACT); bf16_t* MIXED = (bf16_t*)(ws + WS_MIXED);
    bf16_t* Qb = (bf16_t*)(ws + WS_Q); bf16_t* Kb = (bf16_t*)(ws + WS_K); bf16_t* VT = (bf16_t*)(ws + WS_VT); bf16_t* Gb = (bf16_t*)(ws + WS_G); bf16_t* MQ = (bf16_t*)(ws + WS_MQ);

#ifndef P0_REPS
#define P0_REPS 1
#endif
    {
        LAS float* scr = (LAS float*)(lds + wave * 16384);
        constexpr int I_GU = (5632 / 32) * (DM / 64), I_D = DEFER_W ? 0 : (DM / 32) * (DFF / 64), I_IN = DEFER_W ? 0 : (INW / 32) * (DM / 64), I_MKV = DEFER_W ? 0 : (512 / 32) * (DM / 64);
        constexpr int NITEMS = I_GU + I_D + I_IN + I_MKV;
        for (int it = gw; it < NITEMS * P0_REPS; it += NGW) {
            int r = it % NITEMS;
            if (r < I_GU) {
                const int kb = r % (DM / 64), pb = r / (DM / 64), p0 = pb * 32, pn = p0 >> 8, bj = (p0 >> 7) & 1, j0 = p0 & 127;
                transpose_item(bj ? P.in[4] : P.in[3], DFF, 128 * pn + j0, nullptr, W_GU1, DM, p0, kb * 64, scr, lane); continue; }
            r -= I_GU;
            if (r < I_D) { const int kb = r % (DFF / 64), pb = r / (DFF / 64);
                transpose_item(P.in[5], DM, pb * 32, nullptr, W_D1, DFF, pb * 32, kb * 64, scr, lane); continue; }
            r -= I_D;
            if (r < I_IN) { const int kb = r % (DM / 64), pb = r / (DM / 64);
                transpose_item(P.in[8], INW, in_src_col(pb * 32), P.in[6], W_IN, DM, pb * 32, kb * 64, scr, lane); continue; }
            r -= I_IN;
            { const int kb = r % (DM / 64), pb = r / (DM / 64);
                transpose_item(P.in[18], 512, pb * 32, nullptr, W_MKV, DM, pb * 32, kb * 64, scr, lane); }
        }
#if !DEFER_W
        { constexpr int I_OUT = (DM / 32) * (DM / 64);
          for (int it = gw; it < I_GU + I_D + I_OUT; it += NGW) { int r = it;
            if (r < I_GU) { const int kb = r % (DM / 64), pb = r / (DM / 64), p0 = pb * 32, pn = p0 >> 8, bj = (p0 >> 7) & 1, j0 = p0 & 127;
                transpose_item(bj ? P.in[22] : P.in[21], DFF, 128 * pn + j0, P.in[20], W_GU2, DM, p0, kb * 64, scr, lane); continue; }
            r -= I_GU;
            if (r < I_D) { const int kb = r % (DFF / 64), pb = r / (DFF / 64);
                transpose_item(P.in[23], DM, pb * 32, nullptr, W_D2, DFF, pb * 32, kb * 64, scr, lane); continue; }
            r -= I_D;
            { const int kb = r % (DM / 64), pb = r / (DM / 64);
                transpose_item(P.in[19], DM, pb * 32, nullptr, W_OUT, DM, pb * 32, kb * 64, scr, lane); } } }
#endif
        for (int m = gw; m < MTOK; m += 2 * NGW) {
            if (m + NGW < MTOK) rms_row2_to_bf16(x + (size_t)m * DM, x + (size_t)(m + NGW) * DM, P.in[2], AB + (size_t)m * DM, AB + (size_t)(m + NGW) * DM, lane);
            else rms_row_to_bf16(x + (size_t)m * DM, P.in[2], AB + (size_t)m * DM, lane); }
        for (int m = gw; m < NB * NMEM; m += NGW) rms_row_to_bf16(P.in[1] + (size_t)m * DM, P.in[7], MEMN + (size_t)m * DM, lane);
        { float* SM = (float*)(ws + WS_SMALL);
          for (int e = blockIdx.x * 512 + tid; e < SM_END; e += G * 512) {
            float v;
            if (e < 64) v = P.in[9][e]; else if (e < 128) v = P.in[10][e - 64]; else if (e < 192) v = P.in[11][e - 128]; else if (e < SM_SUBLN) v = P.in[12][e - 192];
            else if (e < SM_DWW) v = P.in[13][e - SM_SUBLN];
            else if (e < SM_DWB) v = P.in[14][e - SM_DWW];
            else if (e < SM_LNG) v = P.in[15][e - SM_DWB];
            else if (e < SM_LNB) v = P.in[16][e - SM_LNG];
            else if (e < SM_FNG) v = P.in[17][e - SM_LNB];
            else v = P.in[24][e - SM_FNG];
            SM[e] = v; } }
        for (int e = blockIdx.x * 512 + tid; e < SEQ * 32; e += G * 512) {
            const int pos = e >> 5, i = e & 31;
            const float invf = (float)exp2(-(double)(2 * i) / 64.0 * 13.287712379549449);
            const float ang = (float)pos * invf;
            const double xd = (double)ang, kd = rint(xd * 0.63661977236758134), rr = fma(-kd, 1.5707963267948966, xd) - kd * 6.123233995736766e-17, r2 = rr * rr;
            const double sn = rr * (1.0 + r2 * (-1.0 / 6 + r2 * (1.0 / 120 + r2 * (-1.0 / 5040 + r2 * (1.0 / 362880 + r2 * (-1.0 / 39916800 + r2 * (1.0 / 6227020800.0)))))));
            const double cs = 1.0 + r2 * (-0.5 + r2 * (1.0 / 24 + r2 * (-1.0 / 720 + r2 * (1.0 / 40320 + r2 * (-1.0 / 3628800 + r2 * (1.0 / 479001600.0 + r2 * (-1.0 / 87178291200.0)))))));
            const int qd = ((int)kd) & 3;
            const double sv = (qd == 0) ? sn : (qd == 1) ? cs : (qd == 2) ? -sn : -cs;
            const double cv = (qd == 0) ? cs : (qd == 1) ? -sn : (qd == 2) ? -cs : sn;
            ROPEC[e] = (float)cv; ROPES[e] = (float)sv;
        }
    }
    GRID_BAR();
#ifndef NO_P1
    { pg8::Gemm g{AB, W_GU1, MTOK, 2 * DFF, DM}; pg8::StaticOrder S; S.init(MTOK, 2 * DFF, G, (int)blockIdx.x); EpiSwiGLU E{ACT, nullptr};
      pg8::gemm_phase<EpiSwiGLU, pg8::StaticOrder, true, true>(lds, g, S, E, wave);
#ifdef P1_TWICE
      pg8::gemm_phase<EpiSwiGLU, pg8::StaticOrder, true, true>(lds, g, S, E, wave);
#endif
    }
#if DEFER_W
    if ((int)blockIdx.x >= G / 2) {
        int lane_t = LANE_ID(); asm volatile("" : "+v"(lane_t)); const int lane = lane_t;
        LAS float* scr = (LAS float*)(lds + wave * 16384);
        constexpr int I_D1 = (DM / 32) * (DFF / 64), I_IN1 = (INW / 32) * (DM / 64), I_MKV1 = (512 / 32) * (DM / 64);
        for (int r0 = ((int)blockIdx.x - G / 2) * 8 + wave; r0 < I_D1 + I_IN1 + I_MKV1; r0 += (G - G / 2) * 8) {
            int r = r0;
            if (r < I_D1) { const int kb = r % (DFF / 64), pb = r / (DFF / 64);
                transpose_item(P.in[5], DM, pb * 32, nullptr, W_D1, DFF, pb * 32, kb * 64, scr, lane); continue; }
            r -= I_D1;
            if (r < I_IN1) { const int kb = r % (DM / 64), pb = r / (DM / 64);
                transpose_item(P.in[8], INW, in_src_col(pb * 32), P.in[6], W_IN, DM, pb * 32, kb * 64, scr, lane); continue; }
            r -= I_IN1;
            { const int kb = r % (DM / 64), pb = r / (DM / 64);
                transpose_item(P.in[18], 512, pb * 32, nullptr, W_MKV, DM, pb * 32, kb * 64, scr, lane); }
        }
    }
#endif
#endif
    GRID_BAR();
#ifdef SYNC_EXTRA
    for (int i = 0; i < SYNC_EXTRA; ++i) GRID_BAR();
#endif
#ifndef NO_P2
    { pg8::Gemm g{ACT, W_D1, MTOK, DM, DFF}; pg8::StaticOrder S; S.init(MTOK, DM, G, (int)blockIdx.x);
      EpiExch<true> E{x, nullptr, nullptr, 0.5f, nullptr, nullptr, AB, RN1, (float*)(ws + WS_XBUF), (unsigned*)(ws + WS_CTL + CTL_CNT)};
      pg8::gemm_phase<EpiExch<true>, pg8::StaticOrder, false, true>(lds, g, S, E, wave);
    }
#endif
    GRID_BAR();
#ifndef NO_P3
    { pg8::Gemm g{AB, W_IN, MTOK, INW, DM}; pg8::StaticOrder S; S.init(MTOK, INW, G, (int)blockIdx.x); EpiInProj E{nullptr, ROPEC, ROPES, Qb, Kb, VT, Gb, MQ};
      pg8::gemm_phase<EpiInProj, pg8::StaticOrder, true, true>(lds, g, S, E, wave);
#ifdef P3_TWICE
      pg8::gemm_phase<EpiInProj, pg8::StaticOrder, true, true>(lds, g, S, E, wave);
#endif
      pg8::Gemm g2{MEMN, W_MKV, NB * NMEM, 512, DM}; pg8::StaticOrder S2; S2.init(NB * NMEM, 512, G, ((int)blockIdx.x >= G - 4) ? (int)blockIdx.x - (G - 4) : 1 << 20); EpiMemKV E2{MK, MVT};
      pg8::gemm_phase<EpiMemKV, pg8::StaticOrder, true, true>(lds, g2, S2, E2, wave); }
#if DEFER_W
    if ((int)blockIdx.x >= G / 4 && (int)blockIdx.x < G - 4) {
        int lane_t = LANE_ID(); asm volatile("" : "+v"(lane_t)); const int lane = lane_t;
        LAS float* scr = (LAS float*)(lds + wave * 16384);
        constexpr int I_D = (DM / 32) * (DFF / 64), I_OUT = (DM / 32) * (DM / 64), I_GUH = (5632 / 32) * (DM / 64);
        for (int r0 = ((int)blockIdx.x - G / 4) * 8 + wave; r0 < I_D + I_OUT + I_GUH; r0 += (G - 4 - G / 4) * 8) {
            int r = r0;
            if (r < I_GUH) {
                const int kb = r % (DM / 64), pb = r / (DM / 64), p0 = pb * 32, pn = p0 >> 8, bj = (p0 >> 7) & 1, j0 = p0 & 127;
                transpose_item(bj ? P.in[22] : P.in[21], DFF, 128 * pn + j0, P.in[20], W_GU2, DM, p0, kb * 64, scr, lane); continue; }
            r -= I_GUH;
            if (r < I_OUT) { const int kb = r % (DM / 64), pb = r / (DM / 64);
                transpose_item(P.in[19], DM, pb * 32, nullptr, W_OUT, DM, pb * 32, kb * 64, scr, lane); continue; }
            r -= I_OUT;
            { const int kb = r % (DFF / 64), pb = r / (DFF / 64);
                transpose_item(P.in[23], DM, pb * 32, nullptr, W_D2, DFF, pb * 32, kb * 64, scr, lane); }
        }
    }
#endif
#endif
    GRID_BAR();
#ifndef NO_P4
    {
        const float* SM = (const float*)(ws + WS_SMALL);
#define LAM_COMPUTE(lamv) do { const int ll_ = LANE_ID(); const float a_ = SM[ll_] * SM[64 + ll_], b_ = SM[128 + ll_] * SM[192 + ll_]; lamv = __expf(wave_sum(a_)) - __expf(wave_sum(b_)) + 0.2f; } while (0)
#ifdef NAIVE_ATT
        float lam; LAM_COMPUTE(lam);
        {
            const int qi = lane >> 2, dq = lane & 3;
            for (int item = gw, rnd = 0; item < 4096; item += NGW, ++rnd) {
                const int bh = item & 7, rest = item >> 3, qsub = rest & 3; int ch = rest >> 2; if ((rnd & 1) && NGW == 2048) ch = 191 - ch;
                const int b = bh >> 2, h = bh & 3, row = b * SEQ + ch * 64 + qsub * 16 + qi, nkeys = (ch + 1) * 64;
                float o1[32], o2[32];
                naive_stream<32>(Qb + (size_t)row * 512 + h * 128, Kb + (size_t)b * SEQ * 512 + h * 128, 512, VT + ((size_t)(bh) * 128 + dq * 32) * SEQ, SEQ, nkeys, o1);
                naive_stream<32>(Qb + (size_t)row * 512 + h * 128 + 64, Kb + (size_t)b * SEQ * 512 + h * 128 + 64, 512, VT + ((size_t)(bh) * 128 + dq * 32) * SEQ, SEQ, nkeys, o2);
                float ss = 0.f;
#pragma unroll
                for (int j = 0; j < 32; ++j) { o1[j] -= lam * o2[j]; ss += o1[j] * o1[j]; }
                ss += sxor<1>(ss); ss += sxor<2>(ss);
                const float rs = 0.8f / sqrtf(ss * (1.0f / 128) + EPS);
                bf16_t* dst = MIXED + (size_t)row * DM + h * 128 + dq * 32;
#pragma unroll
                for (int j = 0; j < 32; j += 8) { u32x4 w;
                    w.x = pk2(o1[j] * rs * SM[SM_SUBLN + dq * 32 + j], o1[j + 1] * rs * SM[SM_SUBLN + dq * 32 + j + 1]); w.y = pk2(o1[j + 2] * rs * SM[SM_SUBLN + dq * 32 + j + 2], o1[j + 3] * rs * SM[SM_SUBLN + dq * 32 + j + 3]);
                    w.z = pk2(o1[j + 4] * rs * SM[SM_SUBLN + dq * 32 + j + 4], o1[j + 5] * rs * SM[SM_SUBLN + dq * 32 + j + 5]); w.w = pk2(o1[j + 6] * rs * SM[SM_SUBLN + dq * 32 + j + 6], o1[j + 7] * rs * SM[SM_SUBLN + dq * 32 + j + 7]);
                    *(u32x4*)(dst + j) = w; }
            }
        }
        {
            const int qi = lane >> 2, dq = lane & 3;
            for (int item = gw; item < MTOK / 16 * 4; item += NGW) {
                const int hm = item & 3, rb = item >> 2, row = rb * 16 + qi, b = row >> 13;
                float o[16];
                naive_stream<16>(MQ + (size_t)row * 256 + hm * 64, MK + (size_t)b * NMEM * 256 + hm * 64, 256, MVT + ((size_t)(b * 4 + hm) * 64 + dq * 16) * NMEM, NMEM, NMEM, o);
                bf16_t* dst = MIXED + (size_t)row * DM + 768 + hm * 64 + dq * 16;
                u32x4 w; w.x = pk2(o[0], o[1]); w.y = pk2(o[2], o[3]); w.z = pk2(o[4], o[5]); w.w = pk2(o[6], o[7]); *(u32x4*)dst = w;
                w.x = pk2(o[8], o[9]); w.y = pk2(o[10], o[11]); w.z = pk2(o[12], o[13]); w.w = pk2(o[14], o[15]); *(u32x4*)(dst + 8) = w;
            }
        }
#else
        {
            int lane_d = LANE_ID(); asm volatile("" : "+v"(lane_d)); const int lane = lane_d;
            const int r32 = lane & 31, hi = lane >> 5, c = wave >> 2, wq = wave & 3;
            LAS float* wsf = (LAS float*)(lds + DA_WSF) + wave * 32;
            unsigned swo[4];
            { const int sw = (r32 >> 1) & 7;
#pragma unroll
              for (int x = 0; x < 4; ++x) swo[x] = (unsigned)(r32 * 128 + (((2 * x + hi) ^ sw) << 4)); }
            const int rin = 8 * wave + (lane >> 3), lc = (lane & 7) ^ ((rin >> 1) & 7);
            const unsigned kvoff = (unsigned)((rin * 512 + lc * 8) * 2), vvoff = (unsigned)((rin * SEQ + lc * 8) * 2);
            const unsigned qoff = (unsigned)(((wq * 32 + r32) * 512 + c * 64 + hi * 8) * 2);
            const unsigned ldsb = (unsigned)(size_t)lds_raw + (unsigned)wave * 1024u;
#ifndef DA_REPS
#define DA_REPS 1
#endif
            for (int pair_ = blockIdx.x; pair_ < 256 * DA_REPS; pair_ += G)
            for (int half = 0; half < 2; ++half) {
                const int pair = pair_ & 255, bh = pair & 7, sidx = pair >> 3, qb = half ? 63 - sidx : sidx, b = bh >> 2, h = bh & 3;
                const int q0 = qb * 128, NT = 2 * qb + 2;
                const char* kbase = (const char*)(Kb + (size_t)b * SEQ * 512 + h * 128);
                const char* vbase = (const char*)(VT + (size_t)bh * 128 * SEQ);
#define DA_GLDS(voff, sbase, dst, imm) do { unsigned keep_; const char* ga_ = (sbase) + (voff); asm volatile("s_mov_b32 %0, m0\n\ts_mov_b32 m0, %2\n\ts_nop 0\n\tglobal_load_lds_dwordx4 %1, off\n\ts_mov_b32 m0, %0" \
                    : "=&s"(keep_) : "v"(ga_), "s"(dst) : "memory"); } while (0)
#define DA_DMA_K(tt, sl) do { const int tt_ = (tt) < NT ? (tt) : NT - 1; const char* kb_ = kbase + (size_t)tt_ * (64 * 512 * 2); const unsigned d_ = (unsigned)__builtin_amdgcn_readfirstlane(ldsb + (sl) * DA_KSLOT); \
                    DA_GLDS(kvoff, kb_, d_, 0); const unsigned d2_ = d_ + 8192u; const char* kb2_ = kb_ + 128; DA_GLDS(kvoff, kb2_, d2_, 0); } while (0)
#define DA_DMA_V(tt, sl) do { const int tt_ = (tt) < NT ? (tt) : NT - 1; const char* vb_ = vbase + (size_t)tt_ * 128; const char* vb2_ = vb_ + (size_t)64 * SEQ * 2; const unsigned d_ = (unsigned)__builtin_amdgcn_readfirstlane(ldsb + DA_V0 + (sl) * DA_VSLOT); \
                    DA_GLDS(vvoff, vb_, d_, 0); const unsigned d2_ = d_ + 8192u; DA_GLDS(vvoff, vb2_, d2_, 0); } while (0)
#define DA_BAR(N) asm volatile("s_waitcnt vmcnt(" #N ") lgkmcnt(0)\n\ts_barrier" ::: "memory")
#define DA_KB(t) (lds + ((t) % 3) * DA_KSLOT + c * 8192)
#define DA_VB(t) (lds + DA_V0 + ((t) % 3) * DA_VSLOT)
#define DA_SHIFTCHK(N0, N1) do { if (__any(rmn > 8.0f)) da_shift((rmn > 8.0f) ? rmn : 0.f, N0, N1, o, m, l, wsf, r32, hi); } while (0)
                DA_DMA_K(0, 0); DA_DMA_V(0, 0); DA_DMA_K(1, 1);
                bf16x8 qr[4];
                { const char* qbase = (const char*)(Qb + ((size_t)(b * SEQ + q0)) * 512 + h * 128);
                  asm volatile("global_load_dwordx4 %0, %4, %5 offset:0\n\tglobal_load_dwordx4 %1, %4, %5 offset:32\n\tglobal_load_dwordx4 %2, %4, %5 offset:64\n\tglobal_load_dwordx4 %3, %4, %5 offset:96"
                               : "=&v"(qr[0]), "=&v"(qr[1]), "=&v"(qr[2]), "=&v"(qr[3]) : "v"(qoff), "s"(qbase) : "memory"); }
                f32x16 o[4];
#pragma unroll
                for (int blk = 0; blk < 4; ++blk)
#pragma unroll
                    for (int r = 0; r < 16; ++r) o[blk][r] = 0.f;
                float m = 0.f, l = 0.f;
                DA_BAR(0);
                DA_DMA_K(2, 2); DA_DMA_V(1, 1);
                f32x16 pA0, pA1, pB0, pB1; float rmn;
                qk_tile_sw(DA_KB(0), swo, qr, pA0, pA1);
                { const float rm0 = row_max32(pA0, pA1); m = rm0;
#pragma unroll
                  for (int r = 0; r < 16; ++r) { pA0[r] -= rm0; pA1[r] -= rm0; } }
                DA_BAR(4);
                const bool masklast = (wq < 2);
                int t = 0;
                for (; t + 2 < NT; t += 2) {
                    DA_DMA_K(t + 3, t % 3); DA_DMA_V(t + 2, (t + 2) % 3);
                    da_step<true>(DA_KB(t + 1), DA_VB(t), swo, qr, pA0, pA1, pB0, pB1, -m, o, l, rmn); DA_SHIFTCHK(pB0, pB1);
                    DA_BAR(4);
                    DA_DMA_K(t + 4, (t + 1) % 3); DA_DMA_V(t + 3, (t + 3) % 3);
                    da_step<true>(DA_KB(t + 2), DA_VB(t + 1), swo, qr, pB0, pB1, pA0, pA1, -m, o, l, rmn); DA_SHIFTCHK(pA0, pA1);
                    DA_BAR(4);
                }
                DA_DMA_K(t + 3, t % 3); DA_DMA_V(t + 2, (t + 2) % 3);
                da_step<true>(DA_KB(t + 1), DA_VB(t), swo, qr, pA0, pA1, pB0, pB1, masklast ? -INFINITY : -m, o, l, rmn); DA_SHIFTCHK(pB0, pB1);
                DA_BAR(4);
                da_step<false>(DA_KB(t), DA_VB(t + 1), swo, qr, pB0, pB1, pA0, pA1, 0.f, o, l, rmn);
                DA_BAR(0);
#undef DA_GLDS
#undef DA_DMA_K
#undef DA_DMA_V
#undef DA_BAR
#undef DA_KB
#undef DA_VB
#undef DA_SHIFTCHK
                int r32f = r32, lanef = lane; asm volatile("" : "+v"(r32f), "+v"(lanef));
                { float inv = 1.0f / half_sum(l); if (c) { float lam; LAM_COMPUTE(lam); inv *= lam; }
                  asm volatile("" ::: "memory");
                  if (hi == 0) wsf[r32] = inv;
                  asm volatile("" ::: "memory");
                  float sc[16];
#pragma unroll
                  for (int r = 0; r < 16; ++r) sc[r] = wsf[crow(r, hi)];
#pragma unroll
                  for (int blk = 0; blk < 4; ++blk)
#pragma unroll
                      for (int r = 0; r < 16; ++r) o[blk][r] *= sc[r]; }
                LAS float* cb = (LAS float*)lds + wq * 4096 + lanef;
                if (c) {
#pragma unroll
                    for (int blk = 0; blk < 4; ++blk)
#pragma unroll
                        for (int r = 0; r < 16; ++r) cb[(blk * 16 + r) * 64] = o[blk][r];
                }
                __syncthreads();
                if (!c) {
                    float ss[16];
#pragma unroll
                    for (int r = 0; r < 16; ++r) ss[r] = 0.f;
#pragma unroll
                    for (int blk = 0; blk < 4; ++blk)
#pragma unroll
                        for (int r = 0; r < 16; ++r) { o[blk][r] -= cb[(blk * 16 + r) * 64]; ss[r] += o[blk][r] * o[blk][r]; }
#pragma unroll
                    for (int r = 0; r < 16; ++r) {
                        ss[r] += sxor<1>(ss[r]); ss[r] += sxor<2>(ss[r]); ss[r] += sxor<4>(ss[r]); ss[r] += sxor<8>(ss[r]); ss[r] += sxor<16>(ss[r]);
                        ss[r] = 0.8f / sqrtf(ss[r] * (1.0f / 128) + EPS); }
                    unsigned voffm = (unsigned)((4 * hi * DM + r32f) * 2); asm volatile("" : "+v"(voffm));
                    const char* mbase = (const char*)(MIXED + ((size_t)(b * SEQ + q0 + wq * 32)) * DM + h * 128);
#pragma unroll
                    for (int blk = 0; blk < 4; ++blk) { const float gsub = SM[SM_SUBLN + blk * 32 + r32f];
#pragma unroll
                        for (int r = 0; r < 16; ++r) *(bf16_t*)(mbase + (size_t)(((r & 3) + 8 * (r >> 2)) * DM + blk * 32) * 2 + voffm) = (bf16_t)f2bf(o[blk][r] * ss[r] * gsub); }
                }
                __syncthreads();
            }
        }
        {
            int tidm = wave * 64 + LANE_ID(); asm volatile("" : "+v"(tidm));
            const int tid = tidm, lane = tid & 63, r32 = lane & 31, hi = lane >> 5;
            LAS float* wsf = (LAS float*)(lds + DA_WSF) + wave * 32;
#ifndef MEM_REPS
#define MEM_REPS 1
#endif
            for (int u_ = blockIdx.x; u_ < 256 * MEM_REPS; u_ += G) {
                const int u = u_ & 255, hm = u & 3, b = (u >> 2) & 1, qb = u >> 3;
                { u32x4 kv[4], vv[4];
#pragma unroll
                  for (int i = 0; i < 4; ++i) { const int idx = tid + 512 * i;
                      kv[i] = *(const u32x4*)(MK + ((size_t)(b * NMEM + (idx >> 3))) * 256 + hm * 64 + (idx & 7) * 8);
                      vv[i] = *(const u32x4*)(MVT + ((size_t)((b * 4 + hm) * 64 + (idx >> 5))) * NMEM + (idx & 31) * 8); }
#pragma unroll
                  for (int i = 0; i < 4; ++i) { const int idx = tid + 512 * i;
                      *(LAS u32x4*)(lds + (idx >> 3) * KST + (idx & 7) * 16) = kv[i];
                      *(LAS u32x4*)(lds + MA_VT + (idx >> 5) * MA_VST + (idx & 31) * 16) = vv[i]; } }
                const int row0 = b * SEQ + qb * 256 + wave * 32;
                bf16x8 qr[4];
                { const bf16_t* qp = MQ + ((size_t)(row0 + r32)) * 256 + hm * 64 + hi * 8;
#pragma unroll
                  for (int ds = 0; ds < 4; ++ds) qr[ds] = *(const bf16x8*)(qp + ds * 16); }
                f32x16 o[2];
#pragma unroll
                for (int blk = 0; blk < 2; ++blk)
#pragma unroll
                    for (int r = 0; r < 16; ++r) o[blk][r] = 0.f;
                float m = -INFINITY, l = 0.f;
                __syncthreads();
                for (int t = 0; t < 4; ++t) attn_tile<2>(lds + t * 64 * KST, KST, lds + MA_VT + t * 128, MA_VST, qr, o, m, l, wsf, r32, hi);
                { const float inv = 1.0f / half_sum(l);
                  asm volatile("" ::: "memory");
                  if (hi == 0) wsf[r32] = inv;
                  asm volatile("" ::: "memory");
                  unsigned voffm = (unsigned)((4 * hi * DM + r32) * 2); asm volatile("" : "+v"(voffm));
                  const char* mbase = (const char*)(MIXED + (size_t)row0 * DM + 768 + hm * 64);
#pragma unroll
                  for (int r = 0; r < 16; ++r) { const float sc = wsf[crow(r, hi)]; const char* rb = mbase + (size_t)(((r & 3) + 8 * (r >> 2)) * DM) * 2;
                      *(bf16_t*)(rb + voffm) = (bf16_t)f2bf(o[0][r] * sc); *(bf16_t*)(rb + 64 + voffm) = (bf16_t)f2bf(o[1][r] * sc); } }
                __syncthreads();
            }
        }
#endif
        {
            int tidc = wave * 64 + LANE_ID(); asm volatile("" : "+v"(tidc));
            const int tid = tidc, lane = tid & 63;
            bf16_t* Gs = (bf16_t*)lds_raw;
            float* Y = (float*)(lds_raw + 49152);
            const float* dw_w = SM + SM_DWW; const float* dw_b = SM + SM_DWB; const float* ln_g = SM + SM_LNG; const float* ln_b = SM + SM_LNB;
            #ifndef CONV_REPS
#define CONV_REPS 1
#endif
            for (int unit_ = blockIdx.x; unit_ < MTOK / 64 * CONV_REPS; unit_ += G) {
                const int unit = unit_ & (MTOK / 64 - 1), t0 = unit * 64, bstart = t0 & ~(SEQ - 1);
                __syncthreads();
                for (int c = tid; c < 94 * 32; c += 512) { const int r = c >> 5, cc = c & 31, t = t0 - 30 + r;
                    u32x4 v = {0u, 0u, 0u, 0u}; if (t >= bstart) v = *(const u32x4*)(Gb + (size_t)t * 256 + cc * 8);
                    *(u32x4*)(Gs + r * 256 + cc * 8) = v; }
                __syncthreads();
                { const int cp = tid & 127, tq = tid >> 7; float w0[31], w1[31];
#pragma unroll
                    for (int j = 0; j < 31; ++j) { w0[j] = dw_w[j * 256 + 2 * cp]; w1[j] = dw_w[j * 256 + 2 * cp + 1]; }
                    const float bias0 = dw_b[2 * cp], bias1 = dw_b[2 * cp + 1];
                    const unsigned* Gs32 = (const unsigned*)Gs;
                    for (int tt = 0; tt < 16; ++tt) { const int t = tq * 16 + tt; float a0 = bias0, a1 = bias1;
#pragma unroll
                        for (int j = 0; j < 31; ++j) { const unsigned g2 = Gs32[(t + j) * 128 + cp];
                            a0 += __builtin_bit_cast(float, g2 << 16) * w0[j]; a1 += __builtin_bit_cast(float, g2 & 0xffff0000u) * w1[j]; }
                        *(f32x2_t*)(Y + t * 256 + 2 * cp) = (f32x2_t){a0, a1}; } }
                __syncthreads();
                { f32x4 v[8]; float sm[8], sq[8];
#pragma unroll
                  for (int tt = 0; tt < 8; ++tt) { v[tt] = *(const f32x4*)(Y + (wave * 8 + tt) * 256 + lane * 4); sm[tt] = (v[tt].x + v[tt].y) + (v[tt].z + v[tt].w); }
#define RED8(a) do { _Pragma("unroll") for (int tt = 0; tt < 8; ++tt) a[tt] += sxor<1>(a[tt]); _Pragma("unroll") for (int tt = 0; tt < 8; ++tt) a[tt] += sxor<2>(a[tt]); \
                     _Pragma("unroll") for (int tt = 0; tt < 8; ++tt) a[tt] += sxor<4>(a[tt]); _Pragma("unroll") for (int tt = 0; tt < 8; ++tt) a[tt] += sxor<8>(a[tt]); \
                     _Pragma("unroll") for (int tt = 0; tt < 8; ++tt) a[tt] += sxor<16>(a[tt]); _Pragma("unroll") for (int tt = 0; tt < 8; ++tt) a[tt] = hsum32(a[tt]); } while (0)
                  RED8(sm);
#pragma unroll
                  for (int tt = 0; tt < 8; ++tt) { v[tt] = v[tt] - sm[tt] * (1.0f / 256); sq[tt] = (v[tt].x * v[tt].x + v[tt].y * v[tt].y) + (v[tt].z * v[tt].z + v[tt].w * v[tt].w); }
                  RED8(sq);
#undef RED8
                  const f32x4 gg = *(const f32x4*)(ln_g + lane * 4), bb = *(const f32x4*)(ln_b + lane * 4);
#pragma unroll
                  for (int tt = 0; tt < 8; ++tt) { const float rstd = 1.0f / sqrtf(sq[tt] * (1.0f / 256) + EPS);
                      const f32x4 y = v[tt] * rstd * gg + bb;
                      u32x2 wv; wv.x = pk2(silu_f(y.x), silu_f(y.y)); wv.y = pk2(silu_f(y.z), silu_f(y.w));
                      *(u32x2*)(MIXED + (size_t)(t0 + wave * 8 + tt) * DM + 512 + lane * 4) = wv; } }
            }
            __syncthreads();
        }
    }
#endif
    GRID_BAR();
#ifndef NO_P5
    { pg8::Gemm g{MIXED, W_OUT, MTOK, DM, DM}; pg8::StaticOrder S; S.init(MTOK, DM, G, (int)blockIdx.x);
      EpiExch<false> E{nullptr, AB, RN1, 1.0f, nullptr, nullptr, AB, RN2, (float*)(ws + WS_XBUF) + (size_t)MTOK * 4, (unsigned*)(ws + WS_CTL + CTL_CNT) + CTL_BANK};
      pg8::gemm_phase<EpiExch<false>, pg8::StaticOrder, false, true>(lds, g, S, E, wave); }
#endif
    GRID_BAR();
#ifndef NO_P6
    { pg8::Gemm g{AB, W_GU2, MTOK, 2 * DFF, DM}; pg8::StaticOrder S; S.init(MTOK, 2 * DFF, G, (int)blockIdx.x); EpiSwiGLU E{ACT, nullptr};
      pg8::gemm_phase<EpiSwiGLU, pg8::StaticOrder, true, true>(lds, g, S, E, wave);
#ifdef P6_TWICE
      pg8::gemm_phase<EpiSwiGLU, pg8::StaticOrder, true, true>(lds, g, S, E, wave);
#endif
    }
#endif
    GRID_BAR();
#ifndef NO_P7
    { pg8::Gemm g{ACT, W_D2, MTOK, DM, DFF}; pg8::StaticOrder S; S.init(MTOK, DM, G, (int)blockIdx.x);
      EpiExch<false> E{nullptr, AB, RN2, 0.5f, H, (const float*)(ws + WS_SMALL) + SM_FNG, nullptr, nullptr, (float*)(ws + WS_XBUF) + (size_t)MTOK * 8, (unsigned*)(ws + WS_CTL + CTL_CNT) + 2 * CTL_BANK};
      pg8::gemm_phase<EpiExch<false>, pg8::StaticOrder, false, true>(lds, g, S, E, wave); }
#endif
#if defined(CG_SYNC_AT_END)
    grid.sync();
#endif
}

extern "C" void kernel_launch(void* const* d_in, const int* in_sizes, int n_in, void* d_out, int out_size, void* d_ws, size_t ws_size, hipStream_t stream) {
    static int grid_blocks = 0;
    if (grid_blocks == 0) {
        if (n_in != 25 || ws_size < WS_END) { fprintf(stderr, "kernel_launch: unexpected inputs (n_in %d, ws %zu)\n", n_in, ws_size); grid_blocks = -1; return; }
        int dev = 0, cus = 0, per_cu = 0;
        hipGetDevice(&dev); hipDeviceGetAttribute(&cus, hipDeviceAttributeMultiprocessorCount, dev);
        if (hipFuncSetAttribute((const void*)fwd_megakernel, hipFuncAttributeMaxDynamicSharedMemorySize, LDS_BYTES) != hipSuccess) fprintf(stderr, "kernel_launch: hipFuncSetAttribute failed\n");
        if (hipOccupancyMaxActiveBlocksPerMultiprocessor(&per_cu, (const void*)fwd_megakernel, 512, LDS_BYTES) != hipSuccess || per_cu < 1) { fprintf(stderr, "kernel_launch: occupancy query failed (%d)\n", per_cu); per_cu = 1; }
        (void)hipGetLastError();
        grid_blocks = cus * 1;
        if (grid_blocks != 256) { fprintf(stderr, "kernel_launch: built for a 256-CU device (one 256x256 unit per workgroup in the fused final phase), found %d CUs; nothing launched\n", cus); grid_blocks = -1; return; }
        fprintf(stderr, "kernel_launch: cus %d per_cu %d grid %d\n", cus, per_cu, grid_blocks);
    }
    if (grid_blocks < 0) return;
    if (hipMemsetAsync((char*)d_ws + WS_CTL, 0, CTL_BYTES, stream) != hipSuccess) { fprintf(stderr, "kernel_launch: memset failed\n"); return; }
    Params p{};
    for (int i = 0; i < 25; ++i) p.in[i] = (const float*)d_in[i];
    p.out = (float*)d_out; p.ws = (unsigned char*)d_ws;
    void* args[] = {&p};
    hipError_t e = hipLaunchCooperativeKernel((const void*)fwd_megakernel, dim3(grid_blocks), dim3(512), args, LDS_BYTES, stream);
    if (e != hipSuccess) fprintf(stderr, "cooperative launch failed: %s (grid %d)\n", hipGetErrorString(e), grid_blocks);
}
```
